# Optimizing an MI355X kernel written in HIP

```python
import math
import jax, jax.numpy as jnp
from jax import lax
import numpy as np

D_MODEL = 1024
BATCH = 4
SEQ = 8192
DEPTH = 2

GRID_W = 64
CTX_LEN = 256
HY_CH = 512
HY_ORDER = 2
HY_EMB = 33
HY_BANDS = (HY_EMB - 1) // 2
HY_FFN = 64
HY_SHORT = 3
HY_DECAY_MIN = math.log(100.0) / 1.5
HY_DECAY_MAX = math.log(100.0) / 0.3
NA_HEADS = 8
NA_HD = 64
NA_WIN_R = 8
NA_WIN_C = 16
NA_QCB = 16
NA_KCB = 32
MLA_HEADS = 8
MLA_Q_RANK = 384
MLA_KV_RANK = 256
MLA_NOPE = 64
MLA_ROPE = 32
MLA_V = 96
ROPE_THETA = 10000.0
Q_BLOCK = 128
FN_CH = 256
FN_GROUPS = 4
FN_GD = FN_CH // FN_GROUPS
D_FF = 4 * D_MODEL
N_EVEN = (DEPTH + 1) // 2
N_ODD = DEPTH // 2
ALPHA = (2.0 * DEPTH) ** 0.25
OUT_SCALE = (8.0 * DEPTH) ** -0.25
LN_EPS = 1e-5

kernel_name = 'hybrid_hyena_natten_mla_fnet_dit'


def _norm_stats(x):
    xf = x.astype(jnp.float32)
    mu = jnp.mean(xf, -1, keepdims=True)
    var = jnp.mean(jnp.square(xf - mu), -1, keepdims=True)
    return (xf - mu) * lax.rsqrt(var + LN_EPS)


def _layer_norm(x, g, b):
    return (_norm_stats(x) * g + b).astype(x.dtype)


def _modulate(x, shift, scale):
    return (_norm_stats(x) * (1.0 + scale) + shift).astype(x.dtype)


def _rms_norm(x, g):
    xf = x.astype(jnp.float32)
    y = xf * lax.rsqrt(jnp.mean(jnp.square(xf), -1, keepdims=True) + LN_EPS)
    return (y * g).astype(x.dtype)


def _mlp(h, w1, w2):
    return jnp.square(jax.nn.relu(h @ w1)) @ w2


def _dense_attention(q, k, v, scale):
    s = jnp.einsum('bhqd,bhkd->bhqk', q, k).astype(jnp.float32) * scale
    p = jax.nn.softmax(s, axis=-1).astype(v.dtype)
    return jnp.einsum('bhqk,bhkd->bhqd', p, v)


def _short_conv(u, w):
    L = u.shape[1]
    up = jnp.pad(u, ((0, 0), (1, 1), (0, 0)))
    return up[:, :L] * w[0] + up[:, 1:L + 1] * w[1] + up[:, 2:] * w[2]


def _hyena_filters(L, w1, b1, freq, w2, b2, w3, log_decay):
    pos = jnp.arange(L, dtype=jnp.float32)
    t = pos / max(L - 1, 1)
    w = 2.0 * math.pi * pos / L
    f = jnp.linspace(1e-4, HY_BANDS - 1, HY_BANDS, dtype=jnp.float32)
    ang = w[:, None] * f[None, :]
    z = jnp.concatenate([t[:, None], jnp.cos(ang), -jnp.sin(ang)], -1).astype(w1.dtype)
    hid = jnp.sin(freq * (z @ w1 + b1))
    hid = jnp.sin(freq * (hid @ w2 + b2))
    h = hid @ w3
    decay = jnp.exp(-t[:, None] * jnp.exp(log_decay.astype(jnp.float32)))
    return h * decay.astype(h.dtype)


def _bidir_long_conv(z, h_fwd, h_bwd, skip):
    L = z.shape[1]
    filt = jnp.concatenate([h_fwd, jnp.zeros_like(h_fwd[:1]), h_bwd[:0:-1]], 0)
    zf = jnp.fft.rfft(z.astype(jnp.float32), n=2 * L, axis=1)
    hf = jnp.fft.rfft(filt.astype(jnp.float32), n=2 * L, axis=0)
    y = jnp.fft.irfft(zf * hf[None], n=2 * L, axis=1)[:, :L]
    return (y + z.astype(jnp.float32) * skip.astype(jnp.float32)).astype(z.dtype)


def _hyena(u, conv_w, w1, b1, freq, w2, b2, w3, log_decay, skip):
    L = u.shape[1]
    x1, x2, v = jnp.split(_short_conv(u, conv_w), 3, axis=-1)
    h = _hyena_filters(L, w1, b1, freq, w2, b2, w3, log_decay).reshape(L, HY_ORDER, 2, HY_CH)
    z = x1 * _bidir_long_conv(v, h[:, 0, 0], h[:, 0, 1], skip[0])
    return x2 * _bidir_long_conv(z, h[:, 1, 0], h[:, 1, 1], skip[1])


def _natten(q, k, v, kc, vc, rpb):
    B, L, _ = q.shape
    rows = L // GRID_W
    kr = min(NA_WIN_R, rows)
    shp = (B, rows, GRID_W, NA_HEADS, NA_HD)
    qg, kg, vg = q.reshape(shp), k.reshape(shp), v.reshape(shp)
    ncb = GRID_W // NA_QCB
    qcol = np.arange(GRID_W).reshape(ncb, NA_QCB)
    cs = np.clip(qcol - NA_WIN_C // 2, 0, GRID_W - NA_WIN_C)
    kb = np.clip(np.arange(ncb) * NA_QCB - NA_WIN_C // 2, 0, GRID_W - NA_KCB)
    kcol = kb[:, None] + np.arange(NA_KCB)[None, :]
    col_mask = (kcol[:, None, :] >= cs[..., None]) & (kcol[:, None, :] < cs[..., None] + NA_WIN_C)
    dc_idx = np.clip(kcol[:, None, :] - qcol[..., None] + NA_WIN_C - 1, 0, 2 * NA_WIN_C - 2)
    rpb_c = rpb[:, :, dc_idx]
    scale = NA_HD ** -0.5
    nlat = kr * NA_KCB

    def row_fn(r):
        rs = jnp.clip(r - kr // 2, 0, rows - kr)
        k_blk = lax.dynamic_slice_in_dim(kg, rs, kr, axis=1)[:, :, kcol]
        v_blk = lax.dynamic_slice_in_dim(vg, rs, kr, axis=1)[:, :, kcol]
        q_row = qg[:, r].reshape(B, ncb, NA_QCB, NA_HEADS, NA_HD)
        s_lat = jnp.einsum('bjqhd,brjkhd->bhjqrk', q_row, k_blk).astype(jnp.float32) * scale
        dr = rs + jnp.arange(kr) - r + NA_WIN_R - 1
        bias = jnp.take(rpb_c, dr, axis=1).transpose(0, 2, 3, 1, 4).astype(jnp.float32)
        s_lat = jnp.where(col_mask[:, :, None, :], s_lat + bias, -jnp.inf)
        s_lat = s_lat.reshape(B, NA_HEADS, ncb, NA_QCB, nlat)
        s_ctx = jnp.einsum('bjqhd,bkhd->bhjqk', q_row, kc).astype(jnp.float32) * scale
        p = jax.nn.softmax(jnp.concatenate([s_lat, s_ctx], -1), axis=-1).astype(v.dtype)
        p_lat = p[..., :nlat].reshape(B, NA_HEADS, ncb, NA_QCB, kr, NA_KCB)
        o = jnp.einsum('bhjqrk,brjkhd->bjqhd', p_lat, v_blk) + jnp.einsum('bhjqk,bkhd->bjqhd', p[..., nlat:], vc)
        return o.reshape(B, GRID_W, NA_HEADS * NA_HD)

    out = lax.map(row_fn, jnp.arange(rows))
    return out.transpose(1, 0, 2, 3).reshape(B, L, NA_HEADS * NA_HD)


def _mixer_ab(h, hc, need_ctx, w_in, w_out, conv_w, w1, b1, freq, w2, b2, w3, log_decay, skip, rpb):
    B, L, _ = h.shape
    Lc = hc.shape[1]
    n_hy = 3 * HY_CH
    na_w = NA_HEADS * NA_HD
    hy_args = (conv_w, w1, b1, freq, w2, b2, w3, log_decay, skip)
    u = h @ w_in
    q, k, v = jnp.split(u[..., n_hy:], 3, axis=-1)
    if need_ctx:
        uc = hc @ w_in
        kvc = uc[..., n_hy + na_w:]
    else:
        kvc = hc @ w_in[:, n_hy + na_w:]
    kc, vc = jnp.split(kvc, 2, axis=-1)
    kc = kc.reshape(B, Lc, NA_HEADS, NA_HD)
    vc = vc.reshape(B, Lc, NA_HEADS, NA_HD)
    y_hy = _hyena(u[..., :n_hy], *hy_args)
    y_na = _natten(q, k, v, kc, vc, rpb)
    yl = jnp.concatenate([y_hy, y_na], -1) @ w_out
    if not need_ctx:
        return yl, None
    qc = uc[..., n_hy:n_hy + na_w].reshape(B, Lc, NA_HEADS, NA_HD).transpose(0, 2, 1, 3)
    yc_na = _dense_attention(qc, kc.transpose(0, 2, 1, 3), vc.transpose(0, 2, 1, 3), NA_HD ** -0.5)
    yc_na = yc_na.transpose(0, 2, 1, 3).reshape(B, Lc, na_w)
    yc_hy = _hyena(uc[..., :n_hy], *hy_args)
    yc = jnp.concatenate([yc_hy, yc_na], -1) @ w_out
    return yl, yc


def _axial_rope_tables(L):
    t = jnp.arange(L, dtype=jnp.int32)
    rows = (t // GRID_W).astype(jnp.float32)
    cols = (t % GRID_W).astype(jnp.float32)
    half = MLA_ROPE // 2
    inv = ROPE_THETA ** (-jnp.arange(0, half, 2, dtype=jnp.float32) / half)
    ar = rows[:, None] * inv[None, :]
    ac = cols[:, None] * inv[None, :]
    ang = jnp.concatenate([ar, ar, ac, ac], -1)
    return jnp.cos(ang), jnp.sin(ang)


def _rotate(x, cos, sin):
    qd = MLA_ROPE // 4
    xf = x.astype(jnp.float32)
    a, b, c2, d = xf[..., :qd], xf[..., qd:2 * qd], xf[..., 2 * qd:3 * qd], xf[..., 3 * qd:]
    rot = jnp.concatenate([-b, a, -d, c2], -1)
    return (xf * cos + rot * sin).astype(x.dtype)


def _mla_q(cq, g, w_uq, rope):
    B, L, _ = cq.shape
    q = (_rms_norm(cq, g) @ w_uq).reshape(B, L, MLA_HEADS, MLA_NOPE + MLA_ROPE)
    q_nope, q_pe = q[..., :MLA_NOPE], q[..., MLA_NOPE:]
    if rope is not None:
        q_pe = _rotate(q_pe, *rope)
    return jnp.concatenate([q_nope, q_pe], -1).transpose(0, 2, 1, 3)


def _mla_kv(ckv, kpe, g, w_ukv, rope):
    B, L, _ = ckv.shape
    kv = (_rms_norm(ckv, g) @ w_ukv).reshape(B, L, MLA_HEADS, MLA_NOPE + MLA_V)
    k_nope, v = kv[..., :MLA_NOPE], kv[..., MLA_NOPE:]
    if rope is not None:
        kpe = _rotate(kpe, *rope)
    k_pe = jnp.broadcast_to(kpe[:, :, None, :], (B, L, MLA_HEADS, MLA_ROPE))
    k = jnp.concatenate([k_nope, k_pe], -1)
    return k.transpose(0, 2, 1, 3), v.transpose(0, 2, 1, 3)


def _mla_blocked_attention(q, k, v, kc, vc):
    B, H, L, dq = q.shape
    nb = L // Q_BLOCK
    scale = dq ** -0.5
    qb = q.reshape(B, H, nb, Q_BLOCK, dq).transpose(2, 0, 1, 3, 4)

    def block(qi):
        s = jnp.concatenate([jnp.einsum('bhqd,bhkd->bhqk', qi, k), jnp.einsum('bhqd,bhkd->bhqk', qi, kc)], -1)
        p = jax.nn.softmax(s.astype(jnp.float32) * scale, axis=-1).astype(v.dtype)
        return jnp.einsum('bhqk,bhkd->bhqd', p[..., :L], v) + jnp.einsum('bhqk,bhkd->bhqd', p[..., L:], vc)

    o = lax.map(block, qb)
    return o.transpose(1, 0, 3, 2, 4).reshape(B, L, H * MLA_V)


def _fnet(u, g, b):
    B, L, _ = u.shape
    ug = _layer_norm(u.reshape(B, L, FN_GROUPS, FN_GD), g.reshape(FN_GROUPS, FN_GD), b.reshape(FN_GROUPS, FN_GD))
    y = jnp.fft.fft2(ug.astype(jnp.float32), axes=(1, 3), norm='ortho').real
    return y.astype(u.dtype).reshape(B, L, FN_CH)


def _mixer_cd(h, hc, need_ctx, w_in, w_out, q_norm, w_uq, kv_norm, w_ukv, fn_g, fn_b):
    B, L, _ = h.shape
    Lc = hc.shape[1]
    o_kv = MLA_Q_RANK
    o_pe = o_kv + MLA_KV_RANK
    o_fn = o_pe + MLA_ROPE
    cos, sin = _axial_rope_tables(L)
    u = h @ w_in
    q = _mla_q(u[..., :o_kv], q_norm, w_uq, (cos[:, None, :], sin[:, None, :]))
    k, v = _mla_kv(u[..., o_kv:o_pe], u[..., o_pe:o_fn], kv_norm, w_ukv, (cos, sin))
    kvc = hc @ w_in[:, o_kv:o_fn]
    kc, vc = _mla_kv(kvc[..., :MLA_KV_RANK], kvc[..., MLA_KV_RANK:], kv_norm, w_ukv, None)
    y_mla = _mla_blocked_attention(q, k, v, kc, vc)
    y_fn = _fnet(u[..., o_fn:], fn_g, fn_b)
    yl = jnp.concatenate([y_mla, y_fn], -1) @ w_out
    if not need_ctx:
        return yl, None
    qc = _mla_q(hc @ w_in[:, :o_kv], q_norm, w_uq, None)
    yc_mla = _dense_attention(qc, kc, vc, (MLA_NOPE + MLA_ROPE) ** -0.5)
    yc_mla = yc_mla.transpose(0, 2, 1, 3).reshape(B, Lc, MLA_HEADS * MLA_V)
    yc_fn = _fnet(hc @ w_in[:, o_fn:], fn_g, fn_b)
    yc = jnp.concatenate([yc_mla, yc_fn], -1) @ w_out
    return yl, yc


def setup_inputs(seed: int = 0) -> dict:
    key = jax.random.key(seed)
    ks = iter(jax.random.split(key, 40))
    f32 = jnp.float32

    def nrm(shape, s):
        return jax.random.normal(next(ks), shape, f32) * s

    D = D_MODEL
    ab_in = 3 * HY_CH + 3 * NA_HEADS * NA_HD
    ab_out = HY_CH + NA_HEADS * NA_HD
    cd_in = MLA_Q_RANK + MLA_KV_RANK + MLA_ROPE + FN_CH
    cd_out = MLA_HEADS * MLA_V + FN_CH
    return {
        'x': nrm((BATCH, SEQ, D), 1.0),
        'c': nrm((BATCH, D), 1.0),
        'ctx': nrm((BATCH, CTX_LEN, D), 1.0),
        'c_ctx': nrm((D,), 1.0),
        'mod_w': nrm((DEPTH, D, 6 * D), 0.5 * D ** -0.5),
        'mod_b': nrm((DEPTH, 6 * D), 0.02),
        'ln_g': 1.0 + nrm((DEPTH, 2, D), 0.02),
        'ln_b': nrm((DEPTH, 2, D), 0.02),
        'mlp_w1': nrm((DEPTH, D, D_FF), D ** -0.5),
        'mlp_w2': nrm((DEPTH, D_FF, D), OUT_SCALE * D_FF ** -0.5),
        'ab_w_in': nrm((N_EVEN, D, ab_in), D ** -0.5),
        'ab_w_out': nrm((N_EVEN, ab_out, D), OUT_SCALE * ab_out ** -0.5),
        'hy_conv_w': nrm((N_EVEN, HY_SHORT, 3 * HY_CH), HY_SHORT ** -0.5),
        'hy_w1': nrm((N_EVEN, HY_EMB, HY_FFN), HY_EMB ** -0.5),
        'hy_b1': nrm((N_EVEN, HY_FFN), 0.1),
        'hy_freq': 1.0 + nrm((N_EVEN, HY_FFN), 0.1),
        'hy_w2': nrm((N_EVEN, HY_FFN, HY_FFN), HY_FFN ** -0.5),
        'hy_b2': nrm((N_EVEN, HY_FFN), 0.1),
        'hy_w3': nrm((N_EVEN, HY_FFN, HY_ORDER * 2 * HY_CH), 0.01),
        'hy_log_decay': jnp.log(jax.random.uniform(next(ks), (N_EVEN, HY_ORDER * 2 * HY_CH), f32, HY_DECAY_MIN, HY_DECAY_MAX)),
        'hy_skip': nrm((N_EVEN, HY_ORDER, HY_CH), 0.5),
        'na_rpb': nrm((N_EVEN, NA_HEADS, 2 * NA_WIN_R - 1, 2 * NA_WIN_C - 1), 0.02),
        'cd_w_in': nrm((N_ODD, D, cd_in), D ** -0.5),
        'cd_w_out': nrm((N_ODD, cd_out, D), OUT_SCALE * cd_out ** -0.5),
        'mla_q_norm': 1.0 + nrm((N_ODD, MLA_Q_RANK), 0.02),
        'mla_w_uq': nrm((N_ODD, MLA_Q_RANK, MLA_HEADS * (MLA_NOPE + MLA_ROPE)), MLA_Q_RANK ** -0.5),
        'mla_kv_norm': 1.0 + nrm((N_ODD, MLA_KV_RANK), 0.02),
        'mla_w_ukv': nrm((N_ODD, MLA_KV_RANK, MLA_HEADS * (MLA_NOPE + MLA_V)), MLA_KV_RANK ** -0.5),
        'fn_norm_g': 1.0 + nrm((N_ODD, FN_CH), 0.02),
        'fn_norm_b': nrm((N_ODD, FN_CH), 0.02),
    }


def reference(x, c, ctx, c_ctx, mod_w, mod_b, ln_g, ln_b, mlp_w1, mlp_w2,
              ab_w_in, ab_w_out, hy_conv_w, hy_w1, hy_b1, hy_freq, hy_w2, hy_b2, hy_w3, hy_log_decay, hy_skip, na_rpb,
              cd_w_in, cd_w_out, mla_q_norm, mla_w_uq, mla_kv_norm, mla_w_ukv, fn_norm_g, fn_norm_b):
    xl, xc = x, ctx
    for l in range(DEPTH):
        need_ctx = l < DEPTH - 1
        i = l // 2
        m_lat = jax.nn.silu(c) @ mod_w[l] + mod_b[l]
        m_ctx = jax.nn.silu(c_ctx) @ mod_w[l] + mod_b[l]
        sh1, sc1, g1, sh2, sc2, g2 = jnp.split(m_lat[:, None, :], 6, axis=-1)
        sh1c, sc1c, g1c, sh2c, sc2c, g2c = jnp.split(m_ctx, 6, axis=-1)
        h = _modulate(xl, sh1, sc1)
        hc = _modulate(xc, sh1c, sc1c)
        if l % 2 == 0:
            yl, yc = _mixer_ab(h, hc, need_ctx, ab_w_in[i], ab_w_out[i], hy_conv_w[i], hy_w1[i], hy_b1[i],
                               hy_freq[i], hy_w2[i], hy_b2[i], hy_w3[i], hy_log_decay[i], hy_skip[i], na_rpb[i])
        else:
            yl, yc = _mixer_cd(h, hc, need_ctx, cd_w_in[i], cd_w_out[i], mla_q_norm[i], mla_w_uq[i],
                               mla_kv_norm[i], mla_w_ukv[i], fn_norm_g[i], fn_norm_b[i])
        xl = _layer_norm(ALPHA * xl + g1 * yl, ln_g[l, 0], ln_b[l, 0])
        xl = _layer_norm(ALPHA * xl + g2 * _mlp(_modulate(xl, sh2, sc2), mlp_w1[l], mlp_w2[l]), ln_g[l, 1], ln_b[l, 1])
        if need_ctx:
            xc = _layer_norm(ALPHA * xc + g1c * yc, ln_g[l, 0], ln_b[l, 0])
            xc = _layer_norm(ALPHA * xc + g2c * _mlp(_modulate(xc, sh2c, sc2c), mlp_w1[l], mlp_w2[l]), ln_g[l, 1], ln_b[l, 1])
    return xl
```

```cpp
#include <hip/hip_runtime.h>
#include <hip/hip_cooperative_groups.h>
#include <cstdio>
namespace cg = cooperative_groups;

#define DI __device__ __forceinline__
typedef unsigned short u16;
typedef unsigned int u32;
using bf16x8 = __attribute__((ext_vector_type(8))) short;
using f32x4 = __attribute__((ext_vector_type(4))) float;
using f32x16 = __attribute__((ext_vector_type(16))) float;
using U4 = __attribute__((ext_vector_type(4))) unsigned int;
using U2 = __attribute__((ext_vector_type(2))) unsigned int;
using F4 = __attribute__((ext_vector_type(4))) float;
#define mk4(a, b, c, d) (U4{(u32)(a), (u32)(b), (u32)(c), (u32)(d)})
#define mk2(a, b) (U2{(u32)(a), (u32)(b)})
#define mkf4(a, b, c, d) (F4{(a), (b), (c), (d)})

constexpr int NB = 4, SEQL = 8192, LC = 256;
constexpr int NLAT = NB * SEQL;
constexpr int NCTX = NB * LC;
constexpr int R = NLAT + NCTX;
constexpr int LT = SEQL + LC;
constexpr float ALPHA = 1.4142135623730951f;
constexpr float LN_EPS = 1e-5f;
constexpr float LOG2E = 1.4426950408889634f;

constexpr size_t O_WT_ABIN = 0;
constexpr size_t O_WT_ABOUT = O_WT_ABIN + 3072ull * 1024 * 2;
constexpr size_t O_WT_W1 = O_WT_ABOUT + 1024ull * 1024 * 2;
constexpr size_t O_WT_W2 = O_WT_W1 + 2ull * 4096 * 1024 * 2;
constexpr size_t O_WT_CDIN = O_WT_W2 + 2ull * 4096 * 1024 * 2;
constexpr size_t O_WT_CDOUT = O_WT_CDIN + 1024ull * 1024 * 2;
constexpr size_t O_WT_UQ = O_WT_CDOUT + 1024ull * 1024 * 2;
constexpr size_t O_WT_UKV = O_WT_UQ + 768ull * 384 * 2;
constexpr size_t O_MOD = O_WT_UKV + 1280ull * 256 * 2;
constexpr size_t O_TCTX = O_MOD + 2ull * 5 * 6144 * 4;
constexpr size_t O_S = (O_TCTX + 2ull * 512 * 512 * 2 + 255) & ~(size_t)255;
constexpr size_t O_D = O_S + (size_t)R * 1024 * 4;
constexpr size_t O_HBUF = O_D;
constexpr size_t O_UQK = O_D + (size_t)R * 1024 * 2;
constexpr size_t O_VT0 = O_UQK + (size_t)R * 1024 * 2;
constexpr size_t O_UHYT = O_VT0 + 4ull * 512 * LT * 2;
constexpr size_t O_TLAT = O_UHYT + 4ull * 1536 * LT * 2;
constexpr size_t O_ZT = O_D;
constexpr size_t O_YNA = O_D + 4ull * 512 * LT * 2;
constexpr size_t O_YHYT = O_UQK;
constexpr size_t O_A1 = O_UQK;
constexpr size_t O_U1 = O_UQK;
constexpr size_t O_Q = O_U1 + (size_t)R * 1024 * 2;
constexpr size_t O_KB = O_Q + (size_t)NLAT * 768 * 2;
constexpr size_t O_VT1 = O_KB + 32ull * LT * 96 * 2;
constexpr size_t O_XT = O_VT1 + 32ull * LT * 96 * 2;
constexpr size_t O_Y1 = O_D;
constexpr size_t WS_NEED = O_A1 + (size_t)R * 4096 * 2;
static_assert(WS_NEED <= 536870912ull, "ws too large");
static_assert(O_TLAT + 2ull * 512 * 16384 * 2 <= WS_NEED, "l0 region");
static_assert(O_XT + 1024ull * 16384 * 2 <= WS_NEED, "l1 region");

constexpr int SMEM_BYTES = 73728 + 1024;

struct Params {
  const float *x, *c, *ctx, *c_ctx, *mod_w, *mod_b, *ln_g, *ln_b, *mlp_w1, *mlp_w2, *ab_w_in, *ab_w_out, *hy_conv_w,
      *hy_w1, *hy_b1, *hy_freq, *hy_w2, *hy_b2, *hy_w3, *hy_log_decay, *hy_skip, *na_rpb, *cd_w_in, *cd_w_out,
      *mla_q_norm, *mla_w_uq, *mla_kv_norm, *mla_w_ukv, *fn_g, *fn_b;
  float* out;
  char* ws;
};

DI int tidx() { int t = __builtin_amdgcn_workitem_id_x(); asm volatile("" : "+v"(t)); return t; }
DI int bidx() { int b = __builtin_amdgcn_workgroup_id_x(); asm volatile("" : "+s"(b)); return b; }
DI char* wsp(const Params& p) { char* w = p.ws; asm volatile("" : "+s"(w)); return w; }

DI u16 f2bf(float x) {
  u32 u = __float_as_uint(x);
  u += 0x7fffu + ((u >> 16) & 1u);
  return (u16)(u >> 16);
}
DI float bf2f(u16 h) { return __uint_as_float(((u32)h) << 16); }
DI u32 pack2(float a, float b) { return (u32)f2bf(a) | ((u32)f2bf(b) << 16); }
DI float wave_sum(float v) {
#pragma unroll
  for (int o = 32; o >= 1; o >>= 1) v += __shfl_xor(v, o);
  return v;
}
DI f32x4 mfma16(bf16x8 a, bf16x8 b, f32x4 c) { return __builtin_amdgcn_mfma_f32_16x16x32_bf16(a, b, c, 0, 0, 0); }
DI f32x16 mfma32(bf16x8 a, bf16x8 b, f32x16 c) { return __builtin_amdgcn_mfma_f32_32x32x16_bf16(a, b, c, 0, 0, 0); }

DI const float* modp(const Params& p, int l, int bidx) { return (const float*)(wsp(p) + O_MOD) + ((size_t)l * 5 + bidx) * 6144; }
DI int bidx_of(int m) { return m < NLAT ? (m >> 13) : 4; }
DI void bs_of(int m, int& b, int& s) {
  if (m < NLAT) { b = m >> 13; s = m & 8191; }
  else { int t = m - NLAT; b = t >> 8; s = SEQL + (t & 255); }
}

constexpr int BK = 64, LROW = BK + 8;
constexpr int STAGE_U16 = 2 * 128 * LROW;

struct ALoadRow {
  const u16* A; int lda; U4 r0, r1, r2, r3;
  DI void fetch(int m0, int k0, int tid) {
    const u16* base = A + (size_t)(m0 + (tid >> 3)) * lda + k0 + (tid & 7) * 8;
    r0 = *(const U4*)(base);
    r1 = *(const U4*)(base + (size_t)32 * lda);
    r2 = *(const U4*)(base + (size_t)64 * lda);
    r3 = *(const U4*)(base + (size_t)96 * lda);
  }
  DI void commit(u16* sA, int tid) {
    u16* d = sA + (tid >> 3) * LROW + (tid & 7) * 8;
    *(U4*)(d) = r0; *(U4*)(d + 32 * LROW) = r1; *(U4*)(d + 64 * LROW) = r2; *(U4*)(d + 96 * LROW) = r3;
  }
};

struct ALoadMix {
  const u16* YT; const u16* YN; U4 r0, r1, r2, r3; bool tr;
  DI void fetch(int m0, int k0, int tid) {
    tr = (k0 < 512);
    if (tr) {
      int b, s; bs_of(m0, b, s);
      const u16* base = YT + ((size_t)(b * 512 + k0 + (tid >> 4))) * LT + s + (tid & 15) * 8;
      r0 = *(const U4*)(base);
      r1 = *(const U4*)(base + (size_t)16 * LT);
      r2 = *(const U4*)(base + (size_t)32 * LT);
      r3 = *(const U4*)(base + (size_t)48 * LT);
    } else {
      const u16* base = YN + (size_t)(m0 + (tid >> 3)) * 512 + (k0 - 512) + (tid & 7) * 8;
      r0 = *(const U4*)(base);
      r1 = *(const U4*)(base + (size_t)32 * 512);
      r2 = *(const U4*)(base + (size_t)64 * 512);
      r3 = *(const U4*)(base + (size_t)96 * 512);
    }
  }
  static DI void scat(u16* d, U4 q) {
    d[0 * LROW] = (u16)(q.x); d[1 * LROW] = (u16)(q.x >> 16);
    d[2 * LROW] = (u16)(q.y); d[3 * LROW] = (u16)(q.y >> 16);
    d[4 * LROW] = (u16)(q.z); d[5 * LROW] = (u16)(q.z >> 16);
    d[6 * LROW] = (u16)(q.w); d[7 * LROW] = (u16)(q.w >> 16);
  }
  DI void commit(u16* sA, int tid) {
    if (tr) {
      u16* d = sA + ((tid & 15) * 8) * LROW + (tid >> 4);
      scat(d, r0); scat(d + 16, r1); scat(d + 32, r2); scat(d + 48, r3);
    } else {
      u16* d = sA + (tid >> 3) * LROW + (tid & 7) * 8;
      *(U4*)(d) = r0; *(U4*)(d + 32 * LROW) = r1; *(U4*)(d + 64 * LROW) = r2; *(U4*)(d + 96 * LROW) = r3;
    }
  }
};

struct ALoadDFT {
  static DI U4 gen(int k, int kk) {
    int t0 = kk & 8191;
    int idx = k * t0 + (kk >= 8192 ? 2048 : 0);
    float v0 = __builtin_amdgcn_cosf((float)((idx) & 8191) * (1.f / 8192.f));
    float v1 = __builtin_amdgcn_cosf((float)((idx + k) & 8191) * (1.f / 8192.f));
    float v2 = __builtin_amdgcn_cosf((float)((idx + 2 * k) & 8191) * (1.f / 8192.f));
    float v3 = __builtin_amdgcn_cosf((float)((idx + 3 * k) & 8191) * (1.f / 8192.f));
    float v4 = __builtin_amdgcn_cosf((float)((idx + 4 * k) & 8191) * (1.f / 8192.f));
    float v5 = __builtin_amdgcn_cosf((float)((idx + 5 * k) & 8191) * (1.f / 8192.f));
    float v6 = __builtin_amdgcn_cosf((float)((idx + 6 * k) & 8191) * (1.f / 8192.f));
    float v7 = __builtin_amdgcn_cosf((float)((idx + 7 * k) & 8191) * (1.f / 8192.f));
    return mk4(pack2(v0, v1), pack2(v2, v3), pack2(v4, v5), pack2(v6, v7));
  }
  int k_, kk_;
  DI void fetch(int m0, int k0, int tid) { k_ = m0 + (tid >> 3); kk_ = k0 + (tid & 7) * 8; }
  DI void commit(u16* sA, int tid) {
    u16* d = sA + (tid >> 3) * LROW + (tid & 7) * 8;
    __builtin_amdgcn_sched_barrier(0);
    *(U4*)(d) = gen(k_, kk_);
    __builtin_amdgcn_sched_barrier(0);
    *(U4*)(d + 32 * LROW) = gen(k_ + 32, kk_);
    __builtin_amdgcn_sched_barrier(0);
    *(U4*)(d + 64 * LROW) = gen(k_ + 64, kk_);
    __builtin_amdgcn_sched_barrier(0);
    *(U4*)(d + 96 * LROW) = gen(k_ + 96, kk_);
    __builtin_amdgcn_sched_barrier(0);
  }
};

struct BLoadRow {
  const u16* B; int ldb; U4 r0, r1, r2, r3;
  DI void fetch(int n0, int k0, int tid) {
    const u16* base = B + (size_t)(n0 + (tid >> 3)) * ldb + k0 + (tid & 7) * 8;
    r0 = *(const U4*)(base);
    r1 = *(const U4*)(base + (size_t)32 * ldb);
    r2 = *(const U4*)(base + (size_t)64 * ldb);
    r3 = *(const U4*)(base + (size_t)96 * ldb);
  }
  DI void commit(u16* sB, int tid) {
    u16* d = sB + (tid >> 3) * LROW + (tid & 7) * 8;
    *(U4*)(d) = r0; *(U4*)(d + 32 * LROW) = r1; *(U4*)(d + 64 * LROW) = r2; *(U4*)(d + 96 * LROW) = r3;
  }
};

template <class AL, class EP>
DI void gemm_tile(AL& al, const u16* __restrict__ Bt, int ldb, int K, int m0, int n0, EP& ep, char* smem) {
  const int tid = tidx(), lane = tid & 63, w = tid >> 6, wm = w >> 1, wn = w & 1, r16 = lane & 15, g = lane >> 4;
  u16* sbase = (u16*)smem;
  f32x4 acc[4][4];
#pragma unroll
  for (int i = 0; i < 4; ++i)
#pragma unroll
    for (int j = 0; j < 4; ++j) acc[i][j] = f32x4{0.f, 0.f, 0.f, 0.f};
  BLoadRow bl; bl.B = Bt; bl.ldb = ldb;
  al.fetch(m0, 0, tid);
  bl.fetch(n0, 0, tid);
  __syncthreads();
  al.commit(sbase, tid);
  bl.commit(sbase + 128 * LROW, tid);
  __syncthreads();
  const int nk = K / BK;
  for (int kt = 0; kt < nk; ++kt) {
    u16* sA = sbase + (kt & 1) * STAGE_U16;
    u16* sB = sA + 128 * LROW;
    if (kt + 1 < nk) { al.fetch(m0, (kt + 1) * BK, tid); bl.fetch(n0, (kt + 1) * BK, tid); }
#pragma unroll
    for (int ks = 0; ks < 2; ++ks) {
      bf16x8 a[4], b[4];
#pragma unroll
      for (int i = 0; i < 4; ++i) a[i] = *(const bf16x8*)(sA + (wm * 64 + i * 16 + r16) * LROW + ks * 32 + g * 8);
#pragma unroll
      for (int j = 0; j < 4; ++j) b[j] = *(const bf16x8*)(sB + (wn * 64 + j * 16 + r16) * LROW + ks * 32 + g * 8);
#pragma unroll
      for (int i = 0; i < 4; ++i)
#pragma unroll
        for (int j = 0; j < 4; ++j) acc[i][j] = mfma16(a[i], b[j], acc[i][j]);
    }
    if (kt + 1 < nk) {
      u16* nA = sbase + ((kt + 1) & 1) * STAGE_U16;
      al.commit(nA, tid);
      bl.commit(nA + 128 * LROW, tid);
    }
    __syncthreads();
  }
#pragma unroll
  for (int i = 0; i < 4; ++i)
#pragma unroll
    for (int j = 0; j < 4; ++j) ep.apply(m0 + wm * 64 + i * 16 + g * 4, n0 + wn * 64 + j * 16 + r16, acc[i][j]);
}

struct EpWin0 {
  u16 *uhyT, *uqk, *vT;
  DI void apply(int mb, int n, f32x4 v) {
    int b, s; bs_of(mb, b, s);
    if (n < 1536) {
      U2 o = mk2(pack2(v[0], v[1]), pack2(v[2], v[3]));
      *(U2*)(uhyT + ((size_t)(b * 1536 + n)) * LT + s) = o;
    } else if (n < 2560) {
#pragma unroll
      for (int r = 0; r < 4; ++r) uqk[(size_t)(mb + r) * 1024 + (n - 1536)] = f2bf(v[r]);
    } else {
      U2 o = mk2(pack2(v[0], v[1]), pack2(v[2], v[3]));
      *(U2*)(vT + ((size_t)(b * 512 + (n - 2560))) * LT + s) = o;
    }
  }
};
struct EpResid {
  const float* xlat; const float* xctx; float* S; const float* mod; int goff;
  DI void apply(int mb, int n, f32x4 v) {
    float gt = mod[(size_t)bidx_of(mb) * 6144 + goff + n];
#pragma unroll
    for (int r = 0; r < 4; ++r) {
      int m = mb + r;
      float xi = (m < NLAT) ? xlat[(size_t)m * 1024 + n] : xctx[(size_t)(m - NLAT) * 1024 + n];
      S[(size_t)m * 1024 + n] = ALPHA * xi + gt * v[r];
    }
  }
};
struct EpRelu2 {
  u16* a1;
  DI void apply(int mb, int n, f32x4 v) {
#pragma unroll
    for (int r = 0; r < 4; ++r) { float t = fmaxf(v[r], 0.f); a1[(size_t)(mb + r) * 4096 + n] = f2bf(t * t); }
  }
};
struct EpPlain {
  u16* dst; int ld;
  DI void apply(int mb, int n, f32x4 v) {
#pragma unroll
    for (int r = 0; r < 4; ++r) dst[(size_t)(mb + r) * ld + n] = f2bf(v[r]);
  }
};
struct EpQ {
  u16* q; const float* srow; int m0;
  DI void apply(int mb, int n, f32x4 v) {
    int hc = n % 96;
    float val[4], par[4];
#pragma unroll
    for (int r = 0; r < 4; ++r) { val[r] = v[r] * srow[mb - m0 + r]; par[r] = __shfl_xor(val[r], 8); }
    if (hc >= 64) {
      int i = hc - 64, axis = i >> 4, second = (i >> 3) & 1, idx = i & 7;
      float inv = exp2f(-(float)idx * (13.287712379549449f / 8.f));
#pragma unroll
      for (int r = 0; r < 4; ++r) {
        int s = (mb + r) & 8191;
        float pos = (float)(axis ? (s & 63) : (s >> 6));
        float sn, cs; sincosf(pos * inv, &sn, &cs);
        val[r] = second ? (val[r] * cs + par[r] * sn) : (val[r] * cs - par[r] * sn);
      }
    }
    const float qs = 0.10206207261596575f * LOG2E;
#pragma unroll
    for (int r = 0; r < 4; ++r) q[(size_t)(mb + r) * 768 + n] = f2bf(val[r] * qs);
  }
};
struct EpKV {
  u16 *kb, *vT; const float* srow; int m0;
  DI void apply(int mb, int n, f32x4 v) {
    int hh = n / 160, cc = n % 160;
    int b, s; bs_of(mb, b, s);
    float val[4];
#pragma unroll
    for (int r = 0; r < 4; ++r) val[r] = v[r] * srow[mb - m0 + r];
    if (cc < 64) {
#pragma unroll
      for (int r = 0; r < 4; ++r) kb[((size_t)(b * 8 + hh) * LT + s + r) * 96 + cc] = f2bf(val[r]);
    } else {
      U2 o = mk2(pack2(val[0], val[1]), pack2(val[2], val[3]));
      *(U2*)(vT + ((size_t)((b * 8 + hh) * 96 + (cc - 64))) * LT + s) = o;
    }
  }
};
struct EpFnet {
  u16* y1;
  DI void apply(int mb, int n, f32x4 v) {
    int b = n >> 8, ch = n & 255;
    const float sc = 0.0013810679320049757f;
#pragma unroll
    for (int r = 0; r < 4; ++r) y1[((size_t)(b * 8192 + mb + r)) * 1024 + 768 + ch] = f2bf(v[r] * sc);
  }
};

DI void rms_rows(const u16* A, int lda, int K, int m0, float* srow) {
  int tid = tidx(), row = tid >> 1, half = tid & 1;
  const u16* a = A + (size_t)(m0 + row) * lda + half * (K / 2);
  float ss = 0.f;
  for (int k = 0; k < K / 2; k += 8) {
    U4 q = *(const U4*)(a + k);
    u32 w[4] = {q.x, q.y, q.z, q.w};
#pragma unroll
    for (int e = 0; e < 4; ++e) { float lo = __uint_as_float(w[e] << 16), hi = __uint_as_float(w[e] & 0xffff0000u); ss += lo * lo + hi * hi; }
  }
  ss += __shfl_xor(ss, 1);
  if (half == 0) srow[row] = rsqrtf(ss / (float)K + LN_EPS);
}

DI void tr_tile(const float* src, int K, int N, int Nvalid, u16* dst, const float* gk, int tile, char* smem) {
  float* t = (float*)smem;
  int ntn = N / 64, kt = tile / ntn, nt = tile % ntn, k0 = kt * 64, n0 = nt * 64, tid = tidx();
#pragma unroll
  for (int ps = 0; ps < 4; ++ps) {
    int i = ps * 16 + (tid >> 4), j = (tid & 15) * 4;
    F4 v = mkf4(0.f, 0.f, 0.f, 0.f);
    if (n0 + j < Nvalid) v = *(const F4*)(src + (size_t)(k0 + i) * Nvalid + n0 + j);
    float sc = gk ? gk[k0 + i] : 1.f;
    t[i * 65 + j] = v.x * sc; t[i * 65 + j + 1] = v.y * sc; t[i * 65 + j + 2] = v.z * sc; t[i * 65 + j + 3] = v.w * sc;
  }
  __syncthreads();
  int n = tid >> 2, kc = (tid & 3) * 16;
  u32 o[8];
#pragma unroll
  for (int e = 0; e < 8; ++e) o[e] = pack2(t[(kc + 2 * e) * 65 + n], t[(kc + 2 * e + 1) * 65 + n]);
  U4* d = (U4*)(dst + (size_t)(n0 + n) * K + k0 + kc);
  d[0] = mk4(o[0], o[1], o[2], o[3]);
  d[1] = mk4(o[4], o[5], o[6], o[7]);
}

DI void mod_item(const Params& p, int it, char* smem) {
  float* sc = (float*)smem;
  int l = it / 24, chunk = it % 24, tid = tidx();
  for (int e = tid; e < 5 * 1024; e += 256) {
    int r = e >> 10, k = e & 1023;
    float v = r < 4 ? p.c[r * 1024 + k] : p.c_ctx[k];
    sc[e] = v / (1.f + __expf(-v));
  }
  __syncthreads();
  int n = chunk * 256 + tid;
  const float* W = p.mod_w + (size_t)l * 1024 * 6144 + n;
  float a0 = 0, a1 = 0, a2 = 0, a3 = 0, a4 = 0;
#pragma unroll 8
  for (int k = 0; k < 1024; ++k) {
    float wv = W[(size_t)k * 6144];
    a0 += sc[k] * wv; a1 += sc[1024 + k] * wv; a2 += sc[2048 + k] * wv; a3 += sc[3072 + k] * wv; a4 += sc[4096 + k] * wv;
  }
  float bv = p.mod_b[l * 6144 + n];
  float* o = (float*)(wsp(p) + O_MOD) + (size_t)l * 5 * 6144 + n;
  o[0] = a0 + bv; o[6144] = a1 + bv; o[2 * 6144] = a2 + bv; o[3 * 6144] = a3 + bv; o[4 * 6144] = a4 + bv;
}

DI void filt_item(const Params& p, char* smem, int Lf, int p0, u16* Tg) {
  const int TgLen = 2 * Lf, tid = tidx();
  float* zf = (float*)smem;
  float* h1 = zf + 32 * 33;
  float* h2 = h1 + 32 * 64;
  u16* st = (u16*)(h2 + 32 * 64);
  for (int e = tid; e < 32 * 33; e += 256) {
    int pos = e / 33, f = e % 33; float pp = (float)(p0 + pos);
    float t = pp / (float)(Lf - 1), wv = 6.283185307179586f * pp / (float)Lf, val;
    if (f == 0) val = t;
    else {
      int fi = (f - 1) & 15;
      float fr = 1e-4f + (float)fi * ((15.f - 1e-4f) / 15.f);
      val = (f <= 16) ? cosf(wv * fr) : -sinf(wv * fr);
    }
    zf[e] = val;
  }
  __syncthreads();
  {
    int pos = tid >> 3, u0 = (tid & 7) * 8;
#pragma unroll 1
    for (int uu = 0; uu < 8; ++uu) {
      int u = u0 + uu; float s = p.hy_b1[u];
#pragma unroll 1
      for (int f = 0; f < 33; ++f) s += zf[pos * 33 + f] * p.hy_w1[f * 64 + u];
      h1[pos * 64 + u] = sinf(p.hy_freq[u] * s);
    }
  }
  __syncthreads();
  {
    int pos = tid >> 3, u0 = (tid & 7) * 8;
#pragma unroll 1
    for (int uu = 0; uu < 8; ++uu) {
      int u = u0 + uu; float s = p.hy_b2[u];
#pragma unroll 1
      for (int f = 0; f < 64; ++f) s += h1[pos * 64 + f] * p.hy_w2[f * 64 + u];
      h2[pos * 64 + u] = sinf(p.hy_freq[u] * s);
    }
  }
  __syncthreads();
#pragma unroll 1
  for (int cc = 0; cc < 8; ++cc) {
    int col = cc * 256 + tid;
    float w3r[64];
#pragma unroll
    for (int u = 0; u < 64; ++u) w3r[u] = p.hy_w3[u * 2048 + col];
    float ld = __expf(p.hy_log_decay[col]);
    int conv = col >> 10, dir = (col >> 9) & 1, c = col & 511;
    float skipv = p.hy_skip[conv * 512 + c];
#pragma unroll 1
    for (int pos = 0; pos < 32; ++pos) {
      float a = 0.f;
#pragma unroll
      for (int u = 0; u < 64; ++u) a += h2[pos * 64 + u] * w3r[u];
      int pp = p0 + pos;
      float t = (float)pp / (float)(Lf - 1);
      float val = a * __expf(-t * ld);
      if (pp == 0) val = (dir == 0) ? (val + skipv) : 0.f;
      st[pos * 256 + tid] = f2bf(val);
    }
    __syncthreads();
#pragma unroll 1
    for (int k = 0; k < 32; ++k) {
      int cl = (tid >> 5) + 8 * k, pos = tid & 31, colw = cc * 256 + cl, pp = p0 + pos;
      int conv2 = colw >> 10, dir2 = (colw >> 9) & 1, c2 = colw & 511;
      u16 v = st[pos * 256 + cl];
      u16* dstp = Tg + (size_t)(conv2 * 512 + c2) * TgLen;
      if (dir2 == 0) dstp[Lf - pp] = v;
      else if (pp > 0) dstp[Lf + pp] = v;
      else dstp[0] = 0;
    }
    __syncthreads();
  }
}

constexpr int NT_TR = 768 + 256 + 1024 + 1024 + 1024 + 1024 + 256 + 256 + 72 + 80;
constexpr int N_PREP = NT_TR + 48 + 256 + 8;

DI void phase_prep(const Params& p, char* smem) {
  char* ws = wsp(p);
  for (int it = bidx(); it < N_PREP; it += gridDim.x) {
    __syncthreads();
    int t = it;
    if (t < NT_TR) {
      const float* src; int K, N, Nv; u16* dst; const float* gk = nullptr;
      if (t < 768) { src = p.ab_w_in; K = 1024; N = 3072; Nv = 3072; dst = (u16*)(ws + O_WT_ABIN); }
      else if ((t -= 768) < 256) { src = p.ab_w_out; K = 1024; N = 1024; Nv = 1024; dst = (u16*)(ws + O_WT_ABOUT); }
      else if ((t -= 256) < 2048) { int l = t >> 10; t &= 1023; src = p.mlp_w1 + (size_t)l * 1024 * 4096; K = 1024; N = 4096; Nv = 4096; dst = (u16*)(ws + O_WT_W1) + (size_t)l * 4096 * 1024; }
      else if ((t -= 2048) < 2048) { int l = t >> 10; t &= 1023; src = p.mlp_w2 + (size_t)l * 1024 * 4096; K = 4096; N = 1024; Nv = 1024; dst = (u16*)(ws + O_WT_W2) + (size_t)l * 4096 * 1024; }
      else if ((t -= 2048) < 256) { src = p.cd_w_in; K = 1024; N = 1024; Nv = 928; dst = (u16*)(ws + O_WT_CDIN); }
      else if ((t -= 256) < 256) { src = p.cd_w_out; K = 1024; N = 1024; Nv = 1024; dst = (u16*)(ws + O_WT_CDOUT); }
      else if ((t -= 256) < 72) { src = p.mla_w_uq; K = 384; N = 768; Nv = 768; dst = (u16*)(ws + O_WT_UQ); gk = p.mla_q_norm; }
      else { t -= 72; src = p.mla_w_ukv; K = 256; N = 1280; Nv = 1280; dst = (u16*)(ws + O_WT_UKV); gk = p.mla_kv_norm; }
      tr_tile(src, K, N, Nv, dst, gk, t, smem);
      continue;
    }
    t -= NT_TR;
    if (t < 48) { mod_item(p, t, smem); continue; }
    t -= 48;
    int Lf = SEQL; u16* Tg = (u16*)(ws + O_TLAT);
    if (t >= 256) { t -= 256; Lf = LC; Tg = (u16*)(ws + O_TCTX); }
    filt_item(p, smem, Lf, t * 32, Tg);
  }
}

template <bool FROM_IN, bool AFFINE, bool MOD>
DI void phase_ln(const Params& p, int nrows, const float* g, const float* bb, float* dst, bool dst_is_S, int lmod, int shoff,
                 int scoff) {
  const int lane = tidx() & 63, wv = tidx() >> 6;
  const int gw = bidx() * 4 + wv, nw = gridDim.x * 4;
  float* S = (float*)(wsp(p) + O_S);
  u16* hbuf = (u16*)(wsp(p) + O_HBUF);
  for (int m = gw; m < nrows; m += nw) {
    const float* src;
    if (FROM_IN) src = (m < NLAT) ? p.x + (size_t)m * 1024 : p.ctx + (size_t)(m - NLAT) * 1024;
    else src = S + (size_t)m * 1024;
    float v[16];
#pragma unroll
    for (int i = 0; i < 4; ++i) {
      F4 q = *(const F4*)(src + i * 256 + lane * 4);
      v[4 * i] = q.x; v[4 * i + 1] = q.y; v[4 * i + 2] = q.z; v[4 * i + 3] = q.w;
    }
    if (AFFINE) {
      float s = 0.f;
#pragma unroll
      for (int i = 0; i < 16; ++i) s += v[i];
      float mu = wave_sum(s) * (1.f / 1024.f);
      float q2 = 0.f;
#pragma unroll
      for (int i = 0; i < 16; ++i) { float d = v[i] - mu; q2 += d * d; }
      float rstd = rsqrtf(wave_sum(q2) * (1.f / 1024.f) + LN_EPS);
      float* drow = dst_is_S ? (S + (size_t)m * 1024) : (dst + (size_t)m * 1024);
#pragma unroll
      for (int i = 0; i < 4; ++i) {
        int e = i * 256 + lane * 4;
        F4 gg = *(const F4*)(g + e), b4 = *(const F4*)(bb + e);
        v[4 * i] = (v[4 * i] - mu) * rstd * gg.x + b4.x;
        v[4 * i + 1] = (v[4 * i + 1] - mu) * rstd * gg.y + b4.y;
        v[4 * i + 2] = (v[4 * i + 2] - mu) * rstd * gg.z + b4.z;
        v[4 * i + 3] = (v[4 * i + 3] - mu) * rstd * gg.w + b4.w;
        *(F4*)(drow + e) = mkf4(v[4 * i], v[4 * i + 1], v[4 * i + 2], v[4 * i + 3]);
      }
    }
    if (MOD) {
      float s = 0.f;
#pragma unroll
      for (int i = 0; i < 16; ++i) s += v[i];
      float mu = wave_sum(s) * (1.f / 1024.f);
      float q2 = 0.f;
#pragma unroll
      for (int i = 0; i < 16; ++i) { float d = v[i] - mu; q2 += d * d; }
      float rstd = rsqrtf(wave_sum(q2) * (1.f / 1024.f) + LN_EPS);
      const float* md = modp(p, lmod, bidx_of(m));
#pragma unroll
      for (int i = 0; i < 4; ++i) {
        int e = i * 256 + lane * 4;
        F4 sh = *(const F4*)(md + shoff + e), sc = *(const F4*)(md + scoff + e);
        float o0 = (v[4 * i] - mu) * rstd * (1.f + sc.x) + sh.x;
        float o1 = (v[4 * i + 1] - mu) * rstd * (1.f + sc.y) + sh.y;
        float o2 = (v[4 * i + 2] - mu) * rstd * (1.f + sc.z) + sh.z;
        float o3 = (v[4 * i + 3] - mu) * rstd * (1.f + sc.w) + sh.w;
        *(U2*)(hbuf + (size_t)m * 1024 + e) = mk2(pack2(o0, o1), pack2(o2, o3));
      }
    }
  }
}

DI bf16x8 toep_frag(const u32* Tr32, int o) {
  int wd = o >> 1; u32 sh = (o & 1) * 16;
  u32 d0 = Tr32[wd], d1 = Tr32[wd + 1], d2 = Tr32[wd + 2], d3 = Tr32[wd + 3], d4 = Tr32[wd + 4];
  U4 q = mk4(__builtin_amdgcn_alignbit(d1, d0, sh), __builtin_amdgcn_alignbit(d2, d1, sh),
                       __builtin_amdgcn_alignbit(d3, d2, sh), __builtin_amdgcn_alignbit(d4, d3, sh));
  return __builtin_bit_cast(bf16x8, q);
}

DI void toep_item(const Params& p, char* smem, int cv, int c, int bp) {
  const int tid = tidx(), lane = tid & 63, w = tid >> 6, r16 = lane & 15, g = lane >> 4;
  u16* Tr = (u16*)smem;
  u16* Zs = Tr + 16384 + 16;
  const u16* uhyT = (const u16*)(wsp(p) + O_UHYT);
  u16* zT = (u16*)(wsp(p) + O_ZT);
  u16* yhyT = (u16*)(wsp(p) + O_YHYT);
  {
    const U4* Tg = (const U4*)((const u16*)(wsp(p) + O_TLAT) + (size_t)(cv * 512 + c) * 16384);
    for (int e = tid; e < 2048; e += 256) ((U4*)Tr)[e] = Tg[e];
    if (tid < 2) ((U4*)Tr)[2048 + tid] = mk4(0, 0, 0, 0);
  }
  for (int bb = 0; bb < 2; ++bb) {
    int b = 2 * bp + bb;
    if (cv == 0) {
      const u16* src = uhyT + ((size_t)(b * 1536 + 1024 + c)) * LT;
      float w0 = p.hy_conv_w[1024 + c], w1 = p.hy_conv_w[1536 + 1024 + c], w2 = p.hy_conv_w[2 * 1536 + 1024 + c];
      for (int e = tid; e < 1024; e += 256) {
        int s0 = e * 8;
        U4 q = *(const U4*)(src + s0);
        float u[10];
        u[0] = s0 > 0 ? bf2f(src[s0 - 1]) : 0.f;
        u[9] = s0 + 8 < SEQL ? bf2f(src[s0 + 8]) : 0.f;
        u32 ww[4] = {q.x, q.y, q.z, q.w};
#pragma unroll
        for (int k = 0; k < 4; ++k) { u[1 + 2 * k] = __uint_as_float(ww[k] << 16); u[2 + 2 * k] = __uint_as_float(ww[k] & 0xffff0000u); }
        float o[8];
#pragma unroll
        for (int k = 0; k < 8; ++k) o[k] = w0 * u[k] + w1 * u[k + 1] + w2 * u[k + 2];
        *(U4*)(Zs + bb * 8192 + s0) = mk4(pack2(o[0], o[1]), pack2(o[2], o[3]), pack2(o[4], o[5]), pack2(o[6], o[7]));
      }
    } else {
      const U4* src = (const U4*)(zT + ((size_t)(b * 512 + c)) * LT);
      for (int e = tid; e < 1024; e += 256) ((U4*)(Zs + bb * 8192))[e] = src[e];
    }
  }
  __syncthreads();
  const int bb = w >> 1, hw = w & 1;
  const u16* Zb = Zs + bb * 8192;
  const u32* Tr32 = (const u32*)Tr;
  f32x4 acc[4][4];
#pragma unroll
  for (int i = 0; i < 4; ++i)
#pragma unroll
    for (int j = 0; j < 4; ++j) acc[i][j] = f32x4{0.f, 0.f, 0.f, 0.f};
  const int obase = 8192 - r16 + 8 * g;
  for (int dl = -127; dl <= 127; ++dl) {
    int lo = dl > 0 ? dl : 0, hi = dl < 0 ? 127 + dl : 127;
    if (hi < 64 * hw || lo > 64 * hw + 63) continue;
    bf16x8 F[6];
#pragma unroll
    for (int e = 0; e < 6; ++e) F[e] = toep_frag(Tr32, obase - 16 * (4 * dl - 2 + e));
#pragma unroll
    for (int nt = 0; nt < 4; ++nt) {
      int t1lo = 64 * hw + 16 * nt;
      if (t1lo + 15 < lo || t1lo > hi) continue;
      int s1 = t1lo + r16 - dl;
      bool ok = (s1 >= 0) && (s1 < 128);
      int s1c = ok ? s1 : 0;
#pragma unroll
      for (int ks = 0; ks < 2; ++ks) {
        U4 q = *(const U4*)(Zb + 64 * s1c + 32 * ks + 8 * g);
        if (!ok) q = mk4(0, 0, 0, 0);
        bf16x8 bfr = __builtin_bit_cast(bf16x8, q);
#pragma unroll
        for (int mt = 0; mt < 4; ++mt) acc[mt][nt] = mfma16(F[mt - 2 * ks + 2], bfr, acc[mt][nt]);
      }
    }
  }
  {
    int b = 2 * bp + bb, choff = (cv == 0) ? 0 : 512;
    const u16* xr = uhyT + ((size_t)(b * 1536 + choff + c)) * LT;
    float w0 = p.hy_conv_w[choff + c], w1 = p.hy_conv_w[1536 + choff + c], w2 = p.hy_conv_w[2 * 1536 + choff + c];
    u16* dst = (cv == 0 ? zT : yhyT) + ((size_t)(b * 512 + c)) * LT;
#pragma unroll
    for (int mt = 0; mt < 4; ++mt)
#pragma unroll
      for (int nt = 0; nt < 4; ++nt) {
        int t = 64 * (64 * hw + 16 * nt + r16) + 16 * mt + 4 * g;
        U2 q = *(const U2*)(xr + t);
        float u[6];
        u[0] = t > 0 ? bf2f(xr[t - 1]) : 0.f;
        u[5] = t + 4 < SEQL ? bf2f(xr[t + 4]) : 0.f;
        u[1] = __uint_as_float(q.x << 16); u[2] = __uint_as_float(q.x & 0xffff0000u);
        u[3] = __uint_as_float(q.y << 16); u[4] = __uint_as_float(q.y & 0xffff0000u);
        float o[4];
#pragma unroll
        for (int r = 0; r < 4; ++r) o[r] = (w0 * u[r] + w1 * u[r + 1] + w2 * u[r + 2]) * acc[mt][nt][r];
        *(U2*)(dst + t) = mk2(pack2(o[0], o[1]), pack2(o[2], o[3]));
      }
  }
}

DI void toep_ctx_item(const Params& p, char* smem, int cv, int c) {
  const int tid = tidx();
  float* Tf = (float*)smem;
  float* zf = Tf + 512;
  const u16* uhyT = (const u16*)(wsp(p) + O_UHYT);
  u16* zT = (u16*)(wsp(p) + O_ZT);
  u16* yhyT = (u16*)(wsp(p) + O_YHYT);
  const u16* Tg = (const u16*)(wsp(p) + O_TCTX) + (size_t)(cv * 512 + c) * 512;
  Tf[tid] = bf2f(Tg[tid]); Tf[tid + 256] = bf2f(Tg[tid + 256]);
  if (tid == 0) Tf[0] = 0.f;
  for (int b = 0; b < 4; ++b) {
    float zv;
    if (cv == 0) {
      const u16* src = uhyT + ((size_t)(b * 1536 + 1024 + c)) * LT + SEQL;
      float w0 = p.hy_conv_w[1024 + c], w1 = p.hy_conv_w[1536 + 1024 + c], w2 = p.hy_conv_w[2 * 1536 + 1024 + c];
      float um = tid > 0 ? bf2f(src[tid - 1]) : 0.f, u0 = bf2f(src[tid]), up = tid < 255 ? bf2f(src[tid + 1]) : 0.f;
      zv = bf2f(f2bf(w0 * um + w1 * u0 + w2 * up));
    } else {
      zv = bf2f(zT[((size_t)(b * 512 + c)) * LT + SEQL + tid]);
    }
    zf[b * 256 + tid] = zv;
  }
  __syncthreads();
  int choff = (cv == 0) ? 0 : 512;
  float w0 = p.hy_conv_w[choff + c], w1 = p.hy_conv_w[1536 + choff + c], w2 = p.hy_conv_w[2 * 1536 + choff + c];
  for (int b = 0; b < 4; ++b) {
    float y = 0.f;
    for (int s = 0; s < 256; ++s) y += Tf[256 - (tid - s)] * zf[b * 256 + s];
    const u16* xr = uhyT + ((size_t)(b * 1536 + choff + c)) * LT + SEQL;
    float um = tid > 0 ? bf2f(xr[tid - 1]) : 0.f, u0 = bf2f(xr[tid]), up = tid < 255 ? bf2f(xr[tid + 1]) : 0.f;
    float o = (w0 * um + w1 * u0 + w2 * up) * y;
    u16* dst = (cv == 0 ? zT : yhyT) + ((size_t)(b * 512 + c)) * LT + SEQL;
    dst[tid] = f2bf(o);
  }
}

DI void natten_wave(const Params& p, u16* Pw, int b, int h, bool lat, int r, int j, int qt) {
  const int lane = tidx() & 63, r16 = lane & 15, g = lane >> 4;
  const u16* uqk = (const u16*)(wsp(p) + O_UQK);
  const u16* vT = (const u16*)(wsp(p) + O_VT0);
  u16* yna = (u16*)(wsp(p) + O_YNA);
  const int qm0 = lat ? b * 8192 + r * 64 + 16 * j : NLAT + b * 256 + 16 * qt;
  bf16x8 qa[2];
#pragma unroll
  for (int ks = 0; ks < 2; ++ks) qa[ks] = *(const bf16x8*)(uqk + (size_t)(qm0 + r16) * 1024 + h * 64 + 32 * ks + 8 * g);
  int rs = r - 4; rs = rs < 0 ? 0 : (rs > 120 ? 120 : rs);
  int kb = 16 * j - 8; kb = kb < 0 ? 0 : (kb > 32 ? 32 : kb);
  f32x4 S[32];
  const float NEG = -1e30f;
  const float* rpb = p.na_rpb + h * 15 * 31;
#pragma unroll
  for (int nt = 0; nt < 32; ++nt) {
    if (nt < 16 && !lat) { S[nt] = f32x4{NEG, NEG, NEG, NEG}; continue; }
    if ((nt & 3) == 0) __builtin_amdgcn_sched_barrier(0);
    int keytok;
    if (nt < 16) keytok = b * 8192 + (rs + (nt >> 1)) * 64 + kb + 16 * (nt & 1) + r16;
    else keytok = NLAT + b * 256 + 16 * (nt - 16) + r16;
    const u16* kp = uqk + (size_t)keytok * 1024 + 512 + h * 64 + 8 * g;
    f32x4 a = f32x4{0.f, 0.f, 0.f, 0.f};
    a = mfma16(qa[0], *(const bf16x8*)(kp), a);
    a = mfma16(qa[1], *(const bf16x8*)(kp + 32), a);
    if (nt < 16) {
      int rr = nt >> 1, kcol = kb + 16 * (nt & 1) + r16, dr = rs + rr - r + 7;
#pragma unroll
      for (int q = 0; q < 4; ++q) {
        int qcol = 16 * j + 4 * g + q;
        int cs = qcol - 8; cs = cs < 0 ? 0 : (cs > 48 ? 48 : cs);
        bool valid = (kcol >= cs) && (kcol < cs + 16);
        int dc = kcol - qcol + 15; dc = dc < 0 ? 0 : (dc > 30 ? 30 : dc);
        float bias = rpb[dr * 31 + dc];
        a[q] = valid ? (a[q] * 0.125f + bias) * LOG2E : NEG;
      }
    } else {
#pragma unroll
      for (int q = 0; q < 4; ++q) a[q] = a[q] * (0.125f * LOG2E);
    }
    S[nt] = a;
  }
  float mx[4], sm[4];
#pragma unroll
  for (int q = 0; q < 4; ++q) {
    float m = NEG;
#pragma unroll
    for (int nt = 0; nt < 32; ++nt) m = fmaxf(m, S[nt][q]);
    m = fmaxf(m, __shfl_xor(m, 1)); m = fmaxf(m, __shfl_xor(m, 2)); m = fmaxf(m, __shfl_xor(m, 4)); m = fmaxf(m, __shfl_xor(m, 8));
    mx[q] = m; sm[q] = 0.f;
  }
#pragma unroll
  for (int nt = 0; nt < 32; ++nt) {
    if (nt < 16 && !lat) continue;
#pragma unroll
    for (int q = 0; q < 4; ++q) {
      float pv = exp2f(S[nt][q] - mx[q]);
      u16 pb = f2bf(pv);
      sm[q] += bf2f(pb);
      Pw[(4 * g + q) * 520 + 16 * nt + r16] = pb;
    }
  }
#pragma unroll
  for (int q = 0; q < 4; ++q) {
    float s = sm[q];
    s += __shfl_xor(s, 1); s += __shfl_xor(s, 2); s += __shfl_xor(s, 4); s += __shfl_xor(s, 8);
    sm[q] = 1.f / s;
  }
  __syncthreads();
  f32x4 O[4];
#pragma unroll
  for (int nt = 0; nt < 4; ++nt) O[nt] = f32x4{0.f, 0.f, 0.f, 0.f};
#pragma unroll
  for (int ks = 0; ks < 16; ++ks) {
    if (ks < 8 && !lat) continue;
    bf16x8 pa = *(const bf16x8*)(Pw + r16 * 520 + 32 * ks + 8 * g);
    size_t vcol = ks < 8 ? (size_t)(rs + ks) * 64 + kb + 8 * g : (size_t)SEQL + 32 * (ks - 8) + 8 * g;
#pragma unroll
    for (int nt = 0; nt < 4; ++nt) {
      bf16x8 vb = *(const bf16x8*)(vT + ((size_t)(b * 512 + h * 64 + 16 * nt + r16)) * LT + vcol);
      O[nt] = mfma16(pa, vb, O[nt]);
    }
  }
#pragma unroll
  for (int nt = 0; nt < 4; ++nt)
#pragma unroll
    for (int q = 0; q < 4; ++q) yna[(size_t)(qm0 + 4 * g + q) * 512 + h * 64 + 16 * nt + r16] = f2bf(O[nt][q] * sm[q]);
}

constexpr int SK_ROW = 104, SV_ROW = 72;
constexpr int MLA_STAGE = 64 * SK_ROW + 96 * SV_ROW;
DI void mla_item(const Params& p, char* smem, int b, int h, int qb) {
  const int tid = tidx(), lane = tid & 63, w = tid >> 6, c32 = lane & 31, h2 = lane >> 5;
  const u16* Q = (const u16*)(wsp(p) + O_Q);
  const u16* Kg = (const u16*)(wsp(p) + O_KB) + (size_t)(b * 8 + h) * LT * 96;
  const u16* Vg = (const u16*)(wsp(p) + O_VT1) + (size_t)(b * 8 + h) * 96 * LT;
  u16* Y1 = (u16*)(wsp(p) + O_Y1);
  u16* sb = (u16*)smem;
  const int qrow = b * 8192 + qb * 128 + w * 32 + c32;
  bf16x8 qf[6];
#pragma unroll
  for (int ks = 0; ks < 6; ++ks) qf[ks] = *(const bf16x8*)(Q + (size_t)qrow * 768 + h * 96 + 16 * ks + 8 * h2);
  f32x16 O[3];
#pragma unroll
  for (int d = 0; d < 3; ++d)
#pragma unroll
    for (int i = 0; i < 16; ++i) O[d][i] = 0.f;
  float mrun = -1e30f, lrun = 0.f;
  U4 kr0, kr1, kr2, vr0, vr1, vr2;
  const int kkey0 = tid / 12, kkc0 = tid % 12, kkey1 = (tid + 256) / 12, kkc1 = (tid + 256) % 12, kkey2 = (tid + 512) / 12, kkc2 = (tid + 512) % 12;
#define MLA_FETCH(kt_)                                                              \
  {                                                                                 \
    const u16* kp_ = Kg + (size_t)(kt_) * 64 * 96 + tid * 8;                         \
    kr0 = *(const U4*)(kp_); kr1 = *(const U4*)(kp_ + 2048); kr2 = *(const U4*)(kp_ + 4096); \
    const u16* vp_ = Vg + (size_t)(tid >> 3) * LT + (kt_) * 64 + (tid & 7) * 8;      \
    vr0 = *(const U4*)(vp_); vr1 = *(const U4*)(vp_ + (size_t)32 * LT); vr2 = *(const U4*)(vp_ + (size_t)64 * LT); \
  }
#define MLA_COMMIT(st_)                                                             \
  {                                                                                 \
    u16* s_ = (st_);                                                                \
    *(U4*)(s_ + kkey0 * SK_ROW + kkc0 * 8) = kr0;                                \
    *(U4*)(s_ + kkey1 * SK_ROW + kkc1 * 8) = kr1;                                \
    *(U4*)(s_ + kkey2 * SK_ROW + kkc2 * 8) = kr2;                                \
    u16* v_ = s_ + 64 * SK_ROW + (tid >> 3) * SV_ROW + (tid & 7) * 8;               \
    *(U4*)(v_) = vr0; *(U4*)(v_ + 32 * SV_ROW) = vr1; *(U4*)(v_ + 64 * SV_ROW) = vr2; \
  }
  MLA_FETCH(0);
  __syncthreads();
  MLA_COMMIT(sb);
  __syncthreads();
  constexpr int NKT = LT / 64;
  for (int kt = 0; kt < NKT; ++kt) {
    const u16* sK = sb + (kt & 1) * MLA_STAGE;
    const u16* sV = sK + 64 * SK_ROW;
    if (kt + 1 < NKT) MLA_FETCH(kt + 1);
    f32x16 S[2];
#pragma unroll
    for (int mt = 0; mt < 2; ++mt) {
      f32x16 a;
#pragma unroll
      for (int i = 0; i < 16; ++i) a[i] = 0.f;
#pragma unroll
      for (int ks = 0; ks < 6; ++ks) {
        bf16x8 kf = *(const bf16x8*)(sK + (32 * mt + c32) * SK_ROW + 16 * ks + 8 * h2);
        a = mfma32(kf, qf[ks], a);
      }
      S[mt] = a;
    }
    float mx = -1e30f;
#pragma unroll
    for (int mt = 0; mt < 2; ++mt)
#pragma unroll
      for (int i = 0; i < 16; ++i) mx = fmaxf(mx, S[mt][i]);
    mx = fmaxf(mx, __shfl_xor(mx, 32));
    float mnew = fmaxf(mrun, mx);
    float alpha = exp2f(mrun - mnew);
    mrun = mnew;
    float ps = 0.f;
    bf16x8 pf[4];
#pragma unroll
    for (int mt = 0; mt < 2; ++mt)
#pragma unroll
      for (int s = 0; s < 2; ++s) {
        float e[8];
#pragma unroll
        for (int jj = 0; jj < 8; ++jj) { e[jj] = exp2f(S[mt][8 * s + jj] - mnew); ps += e[jj]; }
        U4 q = mk4(pack2(e[0], e[1]), pack2(e[2], e[3]), pack2(e[4], e[5]), pack2(e[6], e[7]));
        pf[mt * 2 + s] = __builtin_bit_cast(bf16x8, q);
      }
    lrun = lrun * alpha + ps;
#pragma unroll
    for (int d = 0; d < 3; ++d)
#pragma unroll
      for (int i = 0; i < 16; ++i) O[d][i] *= alpha;
#pragma unroll
    for (int kk = 0; kk < 4; ++kk) {
      int keybase = 16 * kk + 4 * h2;
#pragma unroll
      for (int d = 0; d < 3; ++d) {
        const u16* vp = sV + (32 * d + c32) * SV_ROW + keybase;
        U2 lo = *(const U2*)(vp), hi = *(const U2*)(vp + 8);
        U4 q = mk4(lo.x, lo.y, hi.x, hi.y);
        O[d] = mfma32(__builtin_bit_cast(bf16x8, q), pf[kk], O[d]);
      }
    }
    if (kt + 1 < NKT) MLA_COMMIT(sb + ((kt + 1) & 1) * MLA_STAGE);
    __syncthreads();
  }
  float l = lrun + __shfl_xor(lrun, 32);
  float inv = 1.f / l;
#pragma unroll
  for (int d = 0; d < 3; ++d)
#pragma unroll
    for (int i4 = 0; i4 < 4; ++i4) {
      int dd = 32 * d + 8 * i4 + 4 * h2;
      U2 o = mk2(pack2(O[d][4 * i4] * inv, O[d][4 * i4 + 1] * inv), pack2(O[d][4 * i4 + 2] * inv, O[d][4 * i4 + 3] * inv));
      *(U2*)(Y1 + (size_t)qrow * 1024 + h * 96 + dd) = o;
    }
}

DI void kpe_item(const Params& p, int it) {
  const int tid = tidx();
  const u16* u1 = (const u16*)(wsp(p) + O_U1);
  u16* kbuf = (u16*)(wsp(p) + O_KB);
#pragma unroll
  for (int ps = 0; ps < 8; ++ps) {
    int m = it * 64 + ps * 8 + (tid >> 5), i = tid & 31;
    float v = bf2f(u1[(size_t)m * 1024 + 640 + i]);
    float pr = bf2f(u1[(size_t)m * 1024 + 640 + (i ^ 8)]);
    int b, s; bs_of(m, b, s);
    float o = v;
    if (m < NLAT) {
      int axis = i >> 4, second = (i >> 3) & 1, idx = i & 7;
      float inv = exp2f(-(float)idx * (13.287712379549449f / 8.f));
      float pos = (float)(axis ? (s & 63) : (s >> 6));
      float sn, cs; sincosf(pos * inv, &sn, &cs);
      o = second ? (v * cs + pr * sn) : (v * cs - pr * sn);
    }
    u16 ob = f2bf(o);
#pragma unroll
    for (int hh = 0; hh < 8; ++hh) kbuf[((size_t)(b * 8 + hh) * LT + s) * 96 + 64 + i] = ob;
  }
}

DI void fnet1_item(const Params& p, char* smem, int it) {
  const int tid = tidx();
  float* xs = (float*)smem;
  float* ct = xs + 64 * 257;
  float* st = ct + 64;
  const u16* u1 = (const u16*)(wsp(p) + O_U1);
  u16* XT = (u16*)(wsp(p) + O_XT);
  const int m0 = it * 64;
  if (tid < 64) { float sn, cs; sincosf(6.283185307179586f * (float)tid / 64.f, &sn, &cs); ct[tid] = cs; st[tid] = sn; }
  for (int e = tid; e < 64 * 256; e += 256) {
    int tok = e >> 8, ch = e & 255;
    xs[tok * 257 + ch] = bf2f(u1[(size_t)(m0 + tok) * 1024 + 672 + ch]);
  }
  __syncthreads();
  const int tok = tid & 63, gq = tid >> 6;
  float xr[64];
  {
    float* xp = xs + tok * 257 + gq * 64;
    float s = 0.f;
#pragma unroll
    for (int jj = 0; jj < 64; ++jj) { xr[jj] = xp[jj]; s += xr[jj]; }
    float mu = s * (1.f / 64.f), q2 = 0.f;
#pragma unroll
    for (int jj = 0; jj < 64; ++jj) { float d = xr[jj] - mu; q2 += d * d; }
    float rstd = rsqrtf(q2 * (1.f / 64.f) + LN_EPS);
#pragma unroll
    for (int jj = 0; jj < 64; ++jj) xr[jj] = (xr[jj] - mu) * rstd * p.fn_g[gq * 64 + jj] + p.fn_b[gq * 64 + jj];
  }
  const int b = m0 >> 13, t = (m0 & 8191) + tok;
  for (int mm = 0; mm < 64; ++mm) {
    float c = 0.f, s = 0.f;
#pragma unroll
    for (int jj = 0; jj < 64; ++jj) { int idx = (mm * jj) & 63; c += xr[jj] * ct[idx]; s += xr[jj] * st[idx]; }
    size_t n = (size_t)(b * 256 + gq * 64 + mm);
    XT[n * 16384 + t] = f2bf(c);
    XT[n * 16384 + 8192 + t] = f2bf(s);
  }
}

#ifndef STAGE_LIMIT
#define STAGE_LIMIT 99
#endif

__global__ void __launch_bounds__(256, 2) mega(Params p) {
  cg::grid_group grid = cg::this_grid();
  __shared__ __attribute__((aligned(16))) char smem[SMEM_BYTES];
  char* ws = wsp(p);
  const int nblk = gridDim.x, bid = bidx();
  float* S = (float*)(ws + O_S);
  u16* hbuf = (u16*)(ws + O_HBUF);

  phase_prep(p, smem);
  grid.sync();
  phase_ln<true, false, true>(p, R, nullptr, nullptr, nullptr, false, 0, 0, 1024);
  grid.sync();

  for (int l = 0; l < 2; ++l) {
    const int rows = (l == 0) ? R : NLAT;
    const float* mod = modp(p, l, 0);
    if (l == 0) {
      {
        ALoadRow al; al.A = hbuf; al.lda = 1024;
        EpWin0 ep; ep.uhyT = (u16*)(ws + O_UHYT); ep.uqk = (u16*)(ws + O_UQK); ep.vT = (u16*)(ws + O_VT0);
        const int ntile = (R / 128) * 24;
        for (int t = bid; t < ntile; t += nblk) gemm_tile(al, (const u16*)(ws + O_WT_ABIN), 1024, 1024, (t / 24) * 128, (t % 24) * 128, ep, smem);
      }
      grid.sync();
      {
        const int n_toep = 1024, n_na = 4096, n_nac = 128, n_tc = 512;
        for (int it = bid; it < n_toep + n_na + n_nac + n_tc; it += nblk) {
          __syncthreads();
          int t = it;
          if (t < n_toep) { toep_item(p, smem, 0, t >> 1, t & 1); continue; }
          t -= n_toep;
          u16* Pw = (u16*)smem + (tidx() >> 6) * (16 * 520);
          if (t < n_na) { int b = t >> 10, r = (t >> 3) & 127, h = t & 7; natten_wave(p, Pw, b, h, true, r, tidx() >> 6, 0); continue; }
          t -= n_na;
          if (t < n_nac) { int b = t >> 5, h = (t >> 2) & 7, q4 = t & 3; natten_wave(p, Pw, b, h, false, 0, 0, q4 * 4 + (tidx() >> 6)); continue; }
          t -= n_nac;
          toep_ctx_item(p, smem, 0, t);
        }
      }
      grid.sync();
      {
        for (int it = bid; it < 1024 + 512; it += nblk) {
          __syncthreads();
          if (it < 1024) toep_item(p, smem, 1, it >> 1, it & 1);
          else toep_ctx_item(p, smem, 1, it - 1024);
        }
      }
      grid.sync();
      {
        ALoadMix al; al.YT = (const u16*)(ws + O_YHYT); al.YN = (const u16*)(ws + O_YNA);
        EpResid ep; ep.xlat = p.x; ep.xctx = p.ctx; ep.S = S; ep.mod = mod; ep.goff = 2048;
        const int ntile = (R / 128) * 8;
        for (int t = bid; t < ntile; t += nblk) gemm_tile(al, (const u16*)(ws + O_WT_ABOUT), 1024, 1024, (t / 8) * 128, (t % 8) * 128, ep, smem);
      }
      grid.sync();
    } else {
      {
        ALoadRow al; al.A = hbuf; al.lda = 1024;
        EpPlain ep; ep.dst = (u16*)(ws + O_U1); ep.ld = 1024;
        const int ntile = (R / 128) * 8;
        for (int t = bid; t < ntile; t += nblk) gemm_tile(al, (const u16*)(ws + O_WT_CDIN), 1024, 1024, (t / 8) * 128, (t % 8) * 128, ep, smem);
      }
      grid.sync();
      {
        const int n_q = (NLAT / 128) * 6, n_kv = (R / 128) * 10, n_kpe = R / 64, n_f1 = NLAT / 64;
        float* srow = (float*)(smem + 73728);
        const u16* u1 = (const u16*)(ws + O_U1);
        for (int it = bid; it < n_q + n_kv + n_kpe + n_f1; it += nblk) {
          __syncthreads();
          int t = it;
          if (t < n_q) {
            int m0 = (t / 6) * 128, n0 = (t % 6) * 128;
            rms_rows(u1, 1024, 384, m0, srow);
            ALoadRow al; al.A = u1; al.lda = 1024;
            EpQ ep; ep.q = (u16*)(ws + O_Q); ep.srow = srow; ep.m0 = m0;
            gemm_tile(al, (const u16*)(ws + O_WT_UQ), 384, 384, m0, n0, ep, smem);
            continue;
          }
          t -= n_q;
          if (t < n_kv) {
            int m0 = (t / 10) * 128, n0 = (t % 10) * 128;
            rms_rows(u1 + 384, 1024, 256, m0, srow);
            ALoadRow al; al.A = u1 + 384; al.lda = 1024;
            EpKV ep; ep.kb = (u16*)(ws + O_KB); ep.vT = (u16*)(ws + O_VT1); ep.srow = srow; ep.m0 = m0;
            gemm_tile(al, (const u16*)(ws + O_WT_UKV), 256, 256, m0, n0, ep, smem);
            continue;
          }
          t -= n_kv;
          if (t < n_kpe) { kpe_item(p, t); continue; }
          t -= n_kpe;
          fnet1_item(p, smem, t);
        }
      }
      grid.sync();
      {
        const int n_mla = 2048, n_fn = 512;
        for (int it = bid; it < n_mla + n_fn; it += nblk) {
          __syncthreads();
          if (it < n_mla) { int b = it >> 9, h = (it >> 6) & 7, qb = it & 63; mla_item(p, smem, b, h, qb); continue; }
          int t = it - n_mla;
          ALoadDFT al;
          EpFnet ep; ep.y1 = (u16*)(ws + O_Y1);
          gemm_tile(al, (const u16*)(ws + O_XT), 16384, 16384, (t >> 3) * 128, (t & 7) * 128, ep, smem);
        }
      }
      grid.sync();
      {
        ALoadRow al; al.A = (const u16*)(ws + O_Y1); al.lda = 1024;
        EpResid ep; ep.xlat = S; ep.xctx = S + (size_t)NLAT * 1024; ep.S = S; ep.mod = mod; ep.goff = 2048;
        const int ntile = (NLAT / 128) * 8;
        for (int t = bid; t < ntile; t += nblk) gemm_tile(al, (const u16*)(ws + O_WT_CDOUT), 1024, 1024, (t / 8) * 128, (t % 8) * 128, ep, smem);
      }
      grid.sync();
    }
    phase_ln<false, true, true>(p, rows, p.ln_g + (size_t)(l * 2 + 0) * 1024, p.ln_b + (size_t)(l * 2 + 0) * 1024, nullptr, true, l, 3072, 4096);
    grid.sync();
    {
      ALoadRow al; al.A = hbuf; al.lda = 1024;
      EpRelu2 ep; ep.a1 = (u16*)(ws + O_A1);
      const int ntile = (rows / 128) * 32;
      const u16* W = (const u16*)(ws + O_WT_W1) + (size_t)l * 4096 * 1024;
      for (int t = bid; t < ntile; t += nblk) gemm_tile(al, W, 1024, 1024, (t / 32) * 128, (t % 32) * 128, ep, smem);
    }
    grid.sync();
    {
      ALoadRow al; al.A = (const u16*)(ws + O_A1); al.lda = 4096;
      EpResid ep; ep.xlat = S; ep.xctx = S + (size_t)NLAT * 1024; ep.S = S; ep.mod = mod; ep.goff = 5120;
      const int ntile = (rows / 128) * 8;
      const u16* W = (const u16*)(ws + O_WT_W2) + (size_t)l * 4096 * 1024;
      for (int t = bid; t < ntile; t += nblk) gemm_tile(al, W, 4096, 4096, (t / 8) * 128, (t % 8) * 128, ep, smem);
    }
    grid.sync();
    if (l == 0) phase_ln<false, true, true>(p, R, p.ln_g + 1024, p.ln_b + 1024, nullptr, true, 1, 0, 1024);
    else phase_ln<false, true, false>(p, NLAT, p.ln_g + 3 * 1024, p.ln_b + 3 * 1024, p.out, false, 0, 0, 0);
    if (l == 0) grid.sync();
  }
}

extern "C" void kernel_launch(void* const* d_in, const int* in_sizes, int n_in, void* d_out, int out_size, void* d_ws,
                              size_t ws_size, hipStream_t stream) {
  static int grid_blocks = 0;
  if (!grid_blocks) {
    int dev = 0, cus = 0, per_cu = 0;
    hipGetDevice(&dev);
    hipDeviceGetAttribute(&cus, hipDeviceAttributeMultiprocessorCount, dev);
    hipOccupancyMaxActiveBlocksPerMultiprocessor(&per_cu, mega, 256, 0);
    if (per_cu > 2) per_cu = 2;
    if (per_cu < 1) per_cu = 1;
    grid_blocks = cus * per_cu;
  }
  Params p{};
  const float** f = (const float**)&p;
  for (int i = 0; i < 30; ++i) f[i] = (const float*)d_in[i];
  p.out = (float*)d_out;
  p.ws = (char*)d_ws;
  void* args[] = {&p};
  hipError_t e = hipLaunchCooperativeKernel((void*)mega, dim3(grid_blocks), dim3(256), args, 0, stream);
  if (e != hipSuccess) fprintf(stderr, "cooperative launch failed: %s (grid %d)\n", hipGetErrorString(e), grid_blocks);
}
```

```cpp
#include <hip/hip_runtime.h>
#include <hip/hip_cooperative_groups.h>
#include <cstdio>
namespace cg = cooperative_groups;

#define DI __device__ __forceinline__
typedef unsigned short u16;
typedef unsigned int u32;
using bf16x8 = __attribute__((ext_vector_type(8))) short;
using f32x4 = __attribute__((ext_vector_type(4))) float;
using f32x16 = __attribute__((ext_vector_type(16))) float;
using U4 = __attribute__((ext_vector_type(4))) unsigned int;
using U2 = __attribute__((ext_vector_type(2))) unsigned int;
using F4 = __attribute__((ext_vector_type(4))) float;
#define mk4(a, b, c, d) (U4{(u32)(a), (u32)(b), (u32)(c), (u32)(d)})
#define mk2(a, b) (U2{(u32)(a), (u32)(b)})
#define mkf4(a, b, c, d) (F4{(a), (b), (c), (d)})

constexpr int NB = 4, SEQL = 8192, LC = 256;
constexpr int NLAT = NB * SEQL;
constexpr int NCTX = NB * LC;
constexpr int R = NLAT + NCTX;
constexpr int LT = SEQL + LC;
constexpr float ALPHA = 1.4142135623730951f;
constexpr float LN_EPS = 1e-5f;
constexpr float LOG2E = 1.4426950408889634f;

constexpr size_t O_WT_ABIN = 0;
constexpr size_t O_WT_ABOUT = O_WT_ABIN + 3072ull * 1024 * 2;
constexpr size_t O_WT_W1 = O_WT_ABOUT + 1024ull * 1024 * 2;
constexpr size_t O_WT_W2 = O_WT_W1 + 2ull * 4096 * 1024 * 2;
constexpr size_t O_WT_CDIN = O_WT_W2 + 2ull * 4096 * 1024 * 2;
constexpr size_t O_WT_CDOUT = O_WT_CDIN + 1024ull * 1024 * 2;
constexpr size_t O_WT_UQ = O_WT_CDOUT + 1024ull * 1024 * 2;
constexpr size_t O_WT_UKV = O_WT_UQ + 768ull * 384 * 2;
constexpr size_t O_MOD = O_WT_UKV + 1280ull * 256 * 2;
constexpr size_t O_TCTX = O_MOD + 2ull * 5 * 6144 * 4;
constexpr size_t O_S = (O_TCTX + 2ull * 512 * 512 * 2 + 255) & ~(size_t)255;
constexpr size_t O_D = O_S + (size_t)R * 1024 * 4;
constexpr size_t O_HBUF = O_D;
constexpr size_t O_UQK = O_D + (size_t)R * 1024 * 2;
constexpr size_t O_VT0 = O_UQK + (size_t)R * 1024 * 2;
constexpr size_t O_UHYT = O_VT0 + 4ull * 512 * LT * 2;
constexpr size_t O_TLAT = O_UHYT + 4ull * 1536 * LT * 2;
constexpr size_t O_ZT = O_D;
constexpr size_t O_YNA = O_D + 4ull * 512 * LT * 2;
constexpr size_t O_YHYT = O_UQK;
constexpr size_t O_A1 = O_UQK;
constexpr size_t O_U1 = O_UQK;
constexpr size_t O_Q = O_U1 + (size_t)R * 1024 * 2;
constexpr size_t O_KB = O_Q + (size_t)NLAT * 768 * 2;
constexpr size_t O_VT1 = O_KB + 32ull * LT * 96 * 2;
constexpr size_t O_XT = O_VT1 + 32ull * LT * 96 * 2;
constexpr size_t O_Y1 = O_D;
constexpr size_t WS_NEED = O_A1 + (size_t)R * 4096 * 2;
constexpr size_t O_BAR = (WS_NEED + 255) & ~(size_t)255;
static_assert(O_BAR + 256 <= 536870912ull, "ws too large");
static_assert(O_TLAT + 2ull * 512 * 16384 * 2 <= WS_NEED, "l0 region");
static_assert(O_XT + 1024ull * 16384 * 2 <= WS_NEED, "l1 region");

constexpr int SMEM_BYTES = 73728 + 1024;

struct Params {
  const float *x, *c, *ctx, *c_ctx, *mod_w, *mod_b, *ln_g, *ln_b, *mlp_w1, *mlp_w2, *ab_w_in, *ab_w_out, *hy_conv_w,
      *hy_w1, *hy_b1, *hy_freq, *hy_w2, *hy_b2, *hy_w3, *hy_log_decay, *hy_skip, *na_rpb, *cd_w_in, *cd_w_out,
      *mla_q_norm, *mla_w_uq, *mla_kv_norm, *mla_w_ukv, *fn_g, *fn_b;
  float* out;
  char* ws;
};

DI int tidx() { int t = __builtin_amdgcn_workitem_id_x(); asm volatile("" : "+v"(t)); return t; }
DI int bidx() { int b = __builtin_amdgcn_workgroup_id_x(); asm volatile("" : "+s"(b)); return b; }
DI char* wsp(const Params& p) { char* w = p.ws; asm volatile("" : "+s"(w)); return w; }

DI u32 pack2(float a, float b) { u32 r; asm("v_cvt_pk_bf16_f32 %0, %1, %2" : "=v"(r) : "v"(a), "v"(b)); return r; }
DI u16 f2bf(float x) { return (u16)pack2(x, 0.f); }
DI float bf2f(u16 h) { return __uint_as_float(((u32)h) << 16); }
DI float wave_sum(float v) {
#pragma unroll
  for (int o = 32; o >= 1; o >>= 1) v += __shfl_xor(v, o);
  return v;
}
DI f32x4 mfma16(bf16x8 a, bf16x8 b, f32x4 c) { return __builtin_amdgcn_mfma_f32_16x16x32_bf16(a, b, c, 0, 0, 0); }
DI f32x16 mfma32(bf16x8 a, bf16x8 b, f32x16 c) { return __builtin_amdgcn_mfma_f32_32x32x16_bf16(a, b, c, 0, 0, 0); }

DI const float* modp(const Params& p, int l, int bidx) { return (const float*)(wsp(p) + O_MOD) + ((size_t)l * 5 + bidx) * 6144; }
DI int bidx_of(int m) { return m < NLAT ? (m >> 13) : 4; }
DI void bs_of(int m, int& b, int& s) {
  if (m < NLAT) { b = m >> 13; s = m & 8191; }
  else { int t = m - NLAT; b = t >> 8; s = SEQL + (t & 255); }
}

constexpr int BK = 64, LROW = BK + 8;
constexpr int STAGE_U16 = 2 * 128 * LROW;

struct ALoadRow {
  const u16* A; int lda; U4 r0, r1, r2, r3;
  DI void fetch(int m0, int k0, int tid) {
    const u16* base = A + (size_t)(m0 + (tid >> 3)) * lda + k0 + (tid & 7) * 8;
    r0 = *(const U4*)(base);
    r1 = *(const U4*)(base + (size_t)32 * lda);
    r2 = *(const U4*)(base + (size_t)64 * lda);
    r3 = *(const U4*)(base + (size_t)96 * lda);
  }
  DI void commit(u16* sA, int tid) {
    u16* d = sA + (tid >> 3) * LROW + (tid & 7) * 8;
    *(U4*)(d) = r0; *(U4*)(d + 32 * LROW) = r1; *(U4*)(d + 64 * LROW) = r2; *(U4*)(d + 96 * LROW) = r3;
  }
};

struct ALoadMix {
  const u16* YT; const u16* YN; U4 r0, r1, r2, r3; bool tr;
  DI void fetch(int m0, int k0, int tid) {
    tr = (k0 < 512);
    if (tr) {
      int b, s; bs_of(m0, b, s);
      const u16* base = YT + ((size_t)(b * 512 + k0 + (tid >> 4))) * LT + s + (tid & 15) * 8;
      r0 = *(const U4*)(base);
      r1 = *(const U4*)(base + (size_t)16 * LT);
      r2 = *(const U4*)(base + (size_t)32 * LT);
      r3 = *(const U4*)(base + (size_t)48 * LT);
    } else {
      const u16* base = YN + (size_t)(m0 + (tid >> 3)) * 512 + (k0 - 512) + (tid & 7) * 8;
      r0 = *(const U4*)(base);
      r1 = *(const U4*)(base + (size_t)32 * 512);
      r2 = *(const U4*)(base + (size_t)64 * 512);
      r3 = *(const U4*)(base + (size_t)96 * 512);
    }
  }
  static DI void scat(u16* d, U4 q) {
    d[0 * LROW] = (u16)(q.x); d[1 * LROW] = (u16)(q.x >> 16);
    d[2 * LROW] = (u16)(q.y); d[3 * LROW] = (u16)(q.y >> 16);
    d[4 * LROW] = (u16)(q.z); d[5 * LROW] = (u16)(q.z >> 16);
    d[6 * LROW] = (u16)(q.w); d[7 * LROW] = (u16)(q.w >> 16);
  }
  DI void commit(u16* sA, int tid) {
    if (tr) {
      u16* d = sA + ((tid & 15) * 8) * LROW + (tid >> 4);
      scat(d, r0); scat(d + 16, r1); scat(d + 32, r2); scat(d + 48, r3);
    } else {
      u16* d = sA + (tid >> 3) * LROW + (tid & 7) * 8;
      *(U4*)(d) = r0; *(U4*)(d + 32 * LROW) = r1; *(U4*)(d + 64 * LROW) = r2; *(U4*)(d + 96 * LROW) = r3;
    }
  }
};

struct ALoadDFT {
  static DI U4 gen(int k, int kk) {
    int t0 = kk & 8191;
    int idx = k * t0 + (kk >= 8192 ? 2048 : 0);
    float v0 = __builtin_amdgcn_cosf((float)((idx) & 8191) * (1.f / 8192.f));
    float v1 = __builtin_amdgcn_cosf((float)((idx + k) & 8191) * (1.f / 8192.f));
    float v2 = __builtin_amdgcn_cosf((float)((idx + 2 * k) & 8191) * (1.f / 8192.f));
    float v3 = __builtin_amdgcn_cosf((float)((idx + 3 * k) & 8191) * (1.f / 8192.f));
    float v4 = __builtin_amdgcn_cosf((float)((idx + 4 * k) & 8191) * (1.f / 8192.f));
    float v5 = __builtin_amdgcn_cosf((float)((idx + 5 * k) & 8191) * (1.f / 8192.f));
    float v6 = __builtin_amdgcn_cosf((float)((idx + 6 * k) & 8191) * (1.f / 8192.f));
    float v7 = __builtin_amdgcn_cosf((float)((idx + 7 * k) & 8191) * (1.f / 8192.f));
    return mk4(pack2(v0, v1), pack2(v2, v3), pack2(v4, v5), pack2(v6, v7));
  }
  int k_, kk_;
  DI void fetch(int m0, int k0, int tid) { k_ = m0 + (tid >> 3); kk_ = k0 + (tid & 7) * 8; }
  DI void commit(u16* sA, int tid) {
    u16* d = sA + (tid >> 3) * LROW + (tid & 7) * 8;
    __builtin_amdgcn_sched_barrier(0);
    *(U4*)(d) = gen(k_, kk_);
    __builtin_amdgcn_sched_barrier(0);
    *(U4*)(d + 32 * LROW) = gen(k_ + 32, kk_);
    __builtin_amdgcn_sched_barrier(0);
    *(U4*)(d + 64 * LROW) = gen(k_ + 64, kk_);
    __builtin_amdgcn_sched_barrier(0);
    *(U4*)(d + 96 * LROW) = gen(k_ + 96, kk_);
    __builtin_amdgcn_sched_barrier(0);
  }
};

struct BLoadRow {
  const u16* B; int ldb; U4 r0, r1, r2, r3;
  DI void fetch(int n0, int k0, int tid) {
    const u16* base = B + (size_t)(n0 + (tid >> 3)) * ldb + k0 + (tid & 7) * 8;
    r0 = *(const U4*)(base);
    r1 = *(const U4*)(base + (size_t)32 * ldb);
    r2 = *(const U4*)(base + (size_t)64 * ldb);
    r3 = *(const U4*)(base + (size_t)96 * ldb);
  }
  DI void commit(u16* sB, int tid) {
    u16* d = sB + (tid >> 3) * LROW + (tid & 7) * 8;
    *(U4*)(d) = r0; *(U4*)(d + 32 * LROW) = r1; *(U4*)(d + 64 * LROW) = r2; *(U4*)(d + 96 * LROW) = r3;
  }
};

template <bool SWAP>
DI void gemm_compute(f32x4 (&acc)[4][4], const u16* sA, const u16* sB, int wm, int wn, int r16, int g) {
#pragma unroll
  for (int ks = 0; ks < 2; ++ks) {
    bf16x8 a[4], b[4];
#pragma unroll
    for (int i = 0; i < 4; ++i) a[i] = *(const bf16x8*)(sA + (wm * 64 + i * 16 + r16) * LROW + ks * 32 + g * 8);
#pragma unroll
    for (int j = 0; j < 4; ++j) b[j] = *(const bf16x8*)(sB + (wn * 64 + j * 16 + r16) * LROW + ks * 32 + g * 8);
#pragma unroll
    for (int i = 0; i < 4; ++i)
#pragma unroll
      for (int j = 0; j < 4; ++j) {
        if (SWAP) acc[i][j] = mfma16(b[j], a[i], acc[i][j]);
        else acc[i][j] = mfma16(a[i], b[j], acc[i][j]);
      }
  }
}

template <bool SWAP, class AL, class EP>
DI void gemm_tile(AL& al0, const u16* __restrict__ Bt, int ldb, int K, int m0, int n0, EP& ep, char* smem) {
  const int tid = tidx(), lane = tid & 63, w = tid >> 6, wm = w >> 1, wn = w & 1, r16 = lane & 15, g = lane >> 4;
  u16* sbase = (u16*)smem;
  f32x4 acc[4][4];
#pragma unroll
  for (int i = 0; i < 4; ++i)
#pragma unroll
    for (int j = 0; j < 4; ++j) acc[i][j] = f32x4{0.f, 0.f, 0.f, 0.f};
  AL al1 = al0;
  BLoadRow bl0, bl1; bl0.B = Bt; bl0.ldb = ldb; bl1.B = Bt; bl1.ldb = ldb;
  const int nk = K / BK;
  al0.fetch(m0, 0, tid); bl0.fetch(n0, 0, tid);
  al1.fetch(m0, BK, tid); bl1.fetch(n0, BK, tid);
  __syncthreads();
  al0.commit(sbase, tid); bl0.commit(sbase + 128 * LROW, tid);
  __syncthreads();
  u16* const sA0 = sbase; u16* const sB0 = sbase + 128 * LROW;
  u16* const sA1 = sbase + STAGE_U16; u16* const sB1 = sA1 + 128 * LROW;
  for (int kt = 0; kt < nk; kt += 2) {
    if (kt + 2 < nk) { al0.fetch(m0, (kt + 2) * BK, tid); bl0.fetch(n0, (kt + 2) * BK, tid); }
    gemm_compute<SWAP>(acc, sA0, sB0, wm, wn, r16, g);
    al1.commit(sA1, tid); bl1.commit(sB1, tid);
    __syncthreads();
    if (kt + 3 < nk) { al1.fetch(m0, (kt + 3) * BK, tid); bl1.fetch(n0, (kt + 3) * BK, tid); }
    gemm_compute<SWAP>(acc, sA1, sB1, wm, wn, r16, g);
    if (kt + 2 < nk) { al0.commit(sA0, tid); bl0.commit(sB0, tid); }
    __syncthreads();
  }
#pragma unroll
  for (int i = 0; i < 4; ++i)
#pragma unroll
    for (int j = 0; j < 4; ++j) {
      if (SWAP) ep.apply_t(m0 + wm * 64 + i * 16 + r16, n0 + wn * 64 + j * 16 + g * 4, acc[i][j]);
      else ep.apply(m0 + wm * 64 + i * 16 + g * 4, n0 + wn * 64 + j * 16 + r16, acc[i][j]);
    }
}

struct EpWin0 {
  u16 *uhyT, *uqk, *vT;
  DI void apply_t(int m, int nb, f32x4 v) { *(U2*)(uqk + (size_t)m * 1024 + (nb - 1536)) = mk2(pack2(v[0], v[1]), pack2(v[2], v[3])); }
  DI void apply(int mb, int n, f32x4 v) {
    int b, s; bs_of(mb, b, s);
    if (n < 1536) {
      U2 o = mk2(pack2(v[0], v[1]), pack2(v[2], v[3]));
      *(U2*)(uhyT + ((size_t)(b * 1536 + n)) * LT + s) = o;
    } else if (n < 2560) {
#pragma unroll
      for (int r = 0; r < 4; ++r) uqk[(size_t)(mb + r) * 1024 + (n - 1536)] = f2bf(v[r]);
    } else {
      U2 o = mk2(pack2(v[0], v[1]), pack2(v[2], v[3]));
      *(U2*)(vT + ((size_t)(b * 512 + (n - 2560))) * LT + s) = o;
    }
  }
};
struct EpResid {
  const float* xlat; const float* xctx; float* S; const float* mod; int goff;
  DI void apply_t(int m, int nb, f32x4 v) {
    F4 gt = *(const F4*)(mod + (size_t)bidx_of(m) * 6144 + goff + nb);
    const float* xp = (m < NLAT) ? xlat + (size_t)m * 1024 + nb : xctx + (size_t)(m - NLAT) * 1024 + nb;
    F4 xi = *(const F4*)xp;
    *(F4*)(S + (size_t)m * 1024 + nb) = mkf4(ALPHA * xi.x + gt.x * v[0], ALPHA * xi.y + gt.y * v[1], ALPHA * xi.z + gt.z * v[2], ALPHA * xi.w + gt.w * v[3]);
  }
  DI void apply(int mb, int n, f32x4 v) {
    float gt = mod[(size_t)bidx_of(mb) * 6144 + goff + n];
#pragma unroll
    for (int r = 0; r < 4; ++r) {
      int m = mb + r;
      float xi = (m < NLAT) ? xlat[(size_t)m * 1024 + n] : xctx[(size_t)(m - NLAT) * 1024 + n];
      S[(size_t)m * 1024 + n] = ALPHA * xi + gt * v[r];
    }
  }
};
struct EpRelu2 {
  u16* a1;
  DI void apply_t(int m, int nb, f32x4 v) {
    float t0 = fmaxf(v[0], 0.f), t1 = fmaxf(v[1], 0.f), t2 = fmaxf(v[2], 0.f), t3 = fmaxf(v[3], 0.f);
    *(U2*)(a1 + (size_t)m * 4096 + nb) = mk2(pack2(t0 * t0, t1 * t1), pack2(t2 * t2, t3 * t3));
  }
  DI void apply(int mb, int n, f32x4 v) {
#pragma unroll
    for (int r = 0; r < 4; ++r) { float t = fmaxf(v[r], 0.f); a1[(size_t)(mb + r) * 4096 + n] = f2bf(t * t); }
  }
};
struct EpPlain {
  u16* dst; int ld;
  DI void apply_t(int m, int nb, f32x4 v) { *(U2*)(dst + (size_t)m * ld + nb) = mk2(pack2(v[0], v[1]), pack2(v[2], v[3])); }
  DI void apply(int mb, int n, f32x4 v) {
#pragma unroll
    for (int r = 0; r < 4; ++r) dst[(size_t)(mb + r) * ld + n] = f2bf(v[r]);
  }
};
struct EpQ {
  u16* q; const float* srow; int m0;
  DI void apply_t(int m, int nb, f32x4 v) {
    int hc = nb % 96;
    float sr = srow[m - m0];
    float val[4], par[4];
#pragma unroll
    for (int r = 0; r < 4; ++r) { val[r] = v[r] * sr; par[r] = __shfl_xor(val[r], 32); }
    if (hc >= 64) {
      int i0 = hc - 64, axis = i0 >> 4, second = (i0 >> 3) & 1;
      int s = m & 8191;
      float pos = (float)(axis ? (s & 63) : (s >> 6));
#pragma unroll
      for (int r = 0; r < 4; ++r) {
        int idx = (i0 + r) & 7;
        float inv = exp2f(-(float)idx * (13.287712379549449f / 8.f));
        float rv = pos * inv * 0.15915494309189535f; float sn = __builtin_amdgcn_sinf(rv), cs = __builtin_amdgcn_cosf(rv);
        val[r] = second ? (val[r] * cs + par[r] * sn) : (val[r] * cs - par[r] * sn);
      }
    }
    const float qs = 0.10206207261596575f * LOG2E;
    *(U2*)(q + (size_t)m * 768 + nb) = mk2(pack2(val[0] * qs, val[1] * qs), pack2(val[2] * qs, val[3] * qs));
  }
  DI void apply(int mb, int n, f32x4 v) {
    int hc = n % 96;
    float val[4], par[4];
#pragma unroll
    for (int r = 0; r < 4; ++r) { val[r] = v[r] * srow[mb - m0 + r]; par[r] = __shfl_xor(val[r], 8); }
    if (hc >= 64) {
      int i = hc - 64, axis = i >> 4, second = (i >> 3) & 1, idx = i & 7;
      float inv = exp2f(-(float)idx * (13.287712379549449f / 8.f));
#pragma unroll
      for (int r = 0; r < 4; ++r) {
        int s = (mb + r) & 8191;
        float pos = (float)(axis ? (s & 63) : (s >> 6));
        float rv = pos * inv * 0.15915494309189535f; float sn = __builtin_amdgcn_sinf(rv), cs = __builtin_amdgcn_cosf(rv);
        val[r] = second ? (val[r] * cs + par[r] * sn) : (val[r] * cs - par[r] * sn);
      }
    }
    const float qs = 0.10206207261596575f * LOG2E;
#pragma unroll
    for (int r = 0; r < 4; ++r) q[(size_t)(mb + r) * 768 + n] = f2bf(val[r] * qs);
  }
};
struct EpKV {
  u16 *kb, *vT; const float* srow; int m0;
  DI void apply_t(int, int, f32x4) {}
  DI void apply(int mb, int n, f32x4 v) {
    int hh = n / 160, cc = n % 160;
    int b, s; bs_of(mb, b, s);
    float val[4];
#pragma unroll
    for (int r = 0; r < 4; ++r) val[r] = v[r] * srow[mb - m0 + r];
    if (cc < 64) {
#pragma unroll
      for (int r = 0; r < 4; ++r) kb[((size_t)(b * 8 + hh) * LT + s + r) * 96 + cc] = f2bf(val[r]);
    } else {
      U2 o = mk2(pack2(val[0], val[1]), pack2(val[2], val[3]));
      *(U2*)(vT + ((size_t)((b * 8 + hh) * 96 + (cc - 64))) * LT + s) = o;
    }
  }
};
struct EpFnet {
  u16* y1;
  DI void apply_t(int m, int nb, f32x4 v) {
    int b = nb >> 8, ch = nb & 255;
    const float sc = 0.0013810679320049757f;
    *(U2*)(y1 + ((size_t)(b * 8192 + m)) * 1024 + 768 + ch) = mk2(pack2(v[0] * sc, v[1] * sc), pack2(v[2] * sc, v[3] * sc));
  }
  DI void apply(int mb, int n, f32x4 v) {
    int b = n >> 8, ch = n & 255;
    const float sc = 0.0013810679320049757f;
#pragma unroll
    for (int r = 0; r < 4; ++r) y1[((size_t)(b * 8192 + mb + r)) * 1024 + 768 + ch] = f2bf(v[r] * sc);
  }
};

DI void rms_rows(const u16* A, int lda, int K, int m0, float* srow) {
  int tid = tidx(), row = tid >> 1, half = tid & 1;
  const u16* a = A + (size_t)(m0 + row) * lda + half * (K / 2);
  float ss = 0.f;
  for (int k = 0; k < K / 2; k += 8) {
    U4 q = *(const U4*)(a + k);
    u32 w[4] = {q.x, q.y, q.z, q.w};
#pragma unroll
    for (int e = 0; e < 4; ++e) { float lo = __uint_as_float(w[e] << 16), hi = __uint_as_float(w[e] & 0xffff0000u); ss += lo * lo + hi * hi; }
  }
  ss += __shfl_xor(ss, 1);
  if (half == 0) srow[row] = rsqrtf(ss / (float)K + LN_EPS);
}

DI void tr_tile(const float* src, int K, int N, int Nvalid, u16* dst, const float* gk, int tile, char* smem) {
  float* t = (float*)smem;
  int ntn = N / 64, kt = tile / ntn, nt = tile % ntn, k0 = kt * 64, n0 = nt * 64, tid = tidx();
#pragma unroll
  for (int ps = 0; ps < 4; ++ps) {
    int i = ps * 16 + (tid >> 4), j = (tid & 15) * 4;
    F4 v = mkf4(0.f, 0.f, 0.f, 0.f);
    if (n0 + j < Nvalid) v = *(const F4*)(src + (size_t)(k0 + i) * Nvalid + n0 + j);
    float sc = gk ? gk[k0 + i] : 1.f;
    t[i * 65 + j] = v.x * sc; t[i * 65 + j + 1] = v.y * sc; t[i * 65 + j + 2] = v.z * sc; t[i * 65 + j + 3] = v.w * sc;
  }
  __syncthreads();
  int n = tid >> 2, kc = (tid & 3) * 16;
  u32 o[8];
#pragma unroll
  for (int e = 0; e < 8; ++e) o[e] = pack2(t[(kc + 2 * e) * 65 + n], t[(kc + 2 * e + 1) * 65 + n]);
  U4* d = (U4*)(dst + (size_t)(n0 + n) * K + k0 + kc);
  d[0] = mk4(o[0], o[1], o[2], o[3]);
  d[1] = mk4(o[4], o[5], o[6], o[7]);
}

DI void mod_item(const Params& p, int it, char* smem) {
  float* sc = (float*)smem;
  int l = it / 24, chunk = it % 24, tid = tidx();
  for (int e = tid; e < 5 * 1024; e += 256) {
    int r = e >> 10, k = e & 1023;
    float v = r < 4 ? p.c[r * 1024 + k] : p.c_ctx[k];
    sc[e] = v / (1.f + __expf(-v));
  }
  __syncthreads();
  int n = chunk * 256 + tid;
  const float* W = p.mod_w + (size_t)l * 1024 * 6144 + n;
  float a0 = 0, a1 = 0, a2 = 0, a3 = 0, a4 = 0;
#pragma unroll 8
  for (int k = 0; k < 1024; ++k) {
    float wv = W[(size_t)k * 6144];
    a0 += sc[k] * wv; a1 += sc[1024 + k] * wv; a2 += sc[2048 + k] * wv; a3 += sc[3072 + k] * wv; a4 += sc[4096 + k] * wv;
  }
  float bv = p.mod_b[l * 6144 + n];
  float* o = (float*)(wsp(p) + O_MOD) + (size_t)l * 5 * 6144 + n;
  o[0] = a0 + bv; o[6144] = a1 + bv; o[2 * 6144] = a2 + bv; o[3 * 6144] = a3 + bv; o[4 * 6144] = a4 + bv;
}

DI void filt_item(const Params& p, char* smem, int Lf, int p0, u16* Tg) {
  const int TgLen = 2 * Lf, tid = tidx();
  float* zf = (float*)smem;
  float* h1 = zf + 32 * 33;
  float* h2 = h1 + 32 * 64;
  u16* st = (u16*)(h2 + 32 * 64);
  for (int e = tid; e < 32 * 33; e += 256) {
    int pos = e / 33, f = e % 33; float pp = (float)(p0 + pos);
    float t = pp / (float)(Lf - 1), wv = 6.283185307179586f * pp / (float)Lf, val;
    if (f == 0) val = t;
    else {
      int fi = (f - 1) & 15;
      float fr = 1e-4f + (float)fi * ((15.f - 1e-4f) / 15.f);
      val = (f <= 16) ? cosf(wv * fr) : -sinf(wv * fr);
    }
    zf[e] = val;
  }
  __syncthreads();
  {
    int pos = tid >> 3, u0 = (tid & 7) * 8;
#pragma unroll 1
    for (int uu = 0; uu < 8; ++uu) {
      int u = u0 + uu; float s = p.hy_b1[u];
#pragma unroll 1
      for (int f = 0; f < 33; ++f) s += zf[pos * 33 + f] * p.hy_w1[f * 64 + u];
      h1[pos * 64 + u] = sinf(p.hy_freq[u] * s);
    }
  }
  __syncthreads();
  {
    int pos = tid >> 3, u0 = (tid & 7) * 8;
#pragma unroll 1
    for (int uu = 0; uu < 8; ++uu) {
      int u = u0 + uu; float s = p.hy_b2[u];
#pragma unroll 1
      for (int f = 0; f < 64; ++f) s += h1[pos * 64 + f] * p.hy_w2[f * 64 + u];
      h2[pos * 64 + u] = sinf(p.hy_freq[u] * s);
    }
  }
  __syncthreads();
#pragma unroll 1
  for (int cc = 0; cc < 8; ++cc) {
    int col = cc * 256 + tid;
    float w3r[64];
#pragma unroll
    for (int u = 0; u < 64; ++u) w3r[u] = p.hy_w3[u * 2048 + col];
    float ld = __expf(p.hy_log_decay[col]);
    int conv = col >> 10, dir = (col >> 9) & 1, c = col & 511;
    float skipv = p.hy_skip[conv * 512 + c];
#pragma unroll 1
    for (int pos = 0; pos < 32; ++pos) {
      float a = 0.f;
#pragma unroll
      for (int u = 0; u < 64; ++u) a += h2[pos * 64 + u] * w3r[u];
      int pp = p0 + pos;
      float t = (float)pp / (float)(Lf - 1);
      float val = a * __expf(-t * ld);
      if (pp == 0) val = (dir == 0) ? (val + skipv) : 0.f;
      st[pos * 256 + tid] = f2bf(val);
    }
    __syncthreads();
#pragma unroll 1
    for (int k = 0; k < 32; ++k) {
      int cl = (tid >> 5) + 8 * k, pos = tid & 31, colw = cc * 256 + cl, pp = p0 + pos;
      int conv2 = colw >> 10, dir2 = (colw >> 9) & 1, c2 = colw & 511;
      u16 v = st[pos * 256 + cl];
      u16* dstp = Tg + (size_t)(conv2 * 512 + c2) * TgLen;
      if (dir2 == 0) dstp[Lf - pp] = v;
      else if (pp > 0) dstp[Lf + pp] = v;
      else dstp[0] = 0;
    }
    __syncthreads();
  }
}

constexpr int NT_TR = 768 + 256 + 1024 + 1024 + 1024 + 1024 + 256 + 256 + 72 + 80;
constexpr int N_PREP = NT_TR + 48 + 256 + 8;

DI void phase_prep(const Params& p, char* smem) {
  char* ws = wsp(p);
  for (int it = bidx(); it < N_PREP; it += gridDim.x) {
    __syncthreads();
    int t = it;
    if (t < NT_TR) {
      const float* src; int K, N, Nv; u16* dst; const float* gk = nullptr;
      if (t < 768) { src = p.ab_w_in; K = 1024; N = 3072; Nv = 3072; dst = (u16*)(ws + O_WT_ABIN); }
      else if ((t -= 768) < 256) { src = p.ab_w_out; K = 1024; N = 1024; Nv = 1024; dst = (u16*)(ws + O_WT_ABOUT); }
      else if ((t -= 256) < 2048) { int l = t >> 10; t &= 1023; src = p.mlp_w1 + (size_t)l * 1024 * 4096; K = 1024; N = 4096; Nv = 4096; dst = (u16*)(ws + O_WT_W1) + (size_t)l * 4096 * 1024; }
      else if ((t -= 2048) < 2048) { int l = t >> 10; t &= 1023; src = p.mlp_w2 + (size_t)l * 1024 * 4096; K = 4096; N = 1024; Nv = 1024; dst = (u16*)(ws + O_WT_W2) + (size_t)l * 4096 * 1024; }
      else if ((t -= 2048) < 256) { src = p.cd_w_in; K = 1024; N = 1024; Nv = 928; dst = (u16*)(ws + O_WT_CDIN); }
      else if ((t -= 256) < 256) { src = p.cd_w_out; K = 1024; N = 1024; Nv = 1024; dst = (u16*)(ws + O_WT_CDOUT); }
      else if ((t -= 256) < 72) { src = p.mla_w_uq; K = 384; N = 768; Nv = 768; dst = (u16*)(ws + O_WT_UQ); gk = p.mla_q_norm; }
      else { t -= 72; src = p.mla_w_ukv; K = 256; N = 1280; Nv = 1280; dst = (u16*)(ws + O_WT_UKV); gk = p.mla_kv_norm; }
      tr_tile(src, K, N, Nv, dst, gk, t, smem);
      continue;
    }
    t -= NT_TR;
    if (t < 48) { mod_item(p, t, smem); continue; }
    t -= 48;
    int Lf = SEQL; u16* Tg = (u16*)(ws + O_TLAT);
    if (t >= 256) { t -= 256; Lf = LC; Tg = (u16*)(ws + O_TCTX); }
    filt_item(p, smem, Lf, t * 32, Tg);
  }
}

template <bool FROM_IN, bool AFFINE, bool MOD>
DI void phase_ln(const Params& p, int nrows, const float* g, const float* bb, float* dst, bool dst_is_S, int lmod, int shoff,
                 int scoff) {
  const int lane = tidx() & 63, wv = tidx() >> 6;
  const int gw = bidx() * 4 + wv, nw = gridDim.x * 4;
  float* S = (float*)(wsp(p) + O_S);
  u16* hbuf = (u16*)(wsp(p) + O_HBUF);
  for (int m = gw; m < nrows; m += nw) {
    const float* src;
    if (FROM_IN) src = (m < NLAT) ? p.x + (size_t)m * 1024 : p.ctx + (size_t)(m - NLAT) * 1024;
    else src = S + (size_t)m * 1024;
    float v[16];
#pragma unroll
    for (int i = 0; i < 4; ++i) {
      F4 q = *(const F4*)(src + i * 256 + lane * 4);
      v[4 * i] = q.x; v[4 * i + 1] = q.y; v[4 * i + 2] = q.z; v[4 * i + 3] = q.w;
    }
    if (AFFINE) {
      float s = 0.f;
#pragma unroll
      for (int i = 0; i < 16; ++i) s += v[i];
      float mu = wave_sum(s) * (1.f / 1024.f);
      float q2 = 0.f;
#pragma unroll
      for (int i = 0; i < 16; ++i) { float d = v[i] - mu; q2 += d * d; }
      float rstd = rsqrtf(wave_sum(q2) * (1.f / 1024.f) + LN_EPS);
      float* drow = dst_is_S ? (S + (size_t)m * 1024) : (dst + (size_t)m * 1024);
#pragma unroll
      for (int i = 0; i < 4; ++i) {
        int e = i * 256 + lane * 4;
        F4 gg = *(const F4*)(g + e), b4 = *(const F4*)(bb + e);
        v[4 * i] = (v[4 * i] - mu) * rstd * gg.x + b4.x;
        v[4 * i + 1] = (v[4 * i + 1] - mu) * rstd * gg.y + b4.y;
        v[4 * i + 2] = (v[4 * i + 2] - mu) * rstd * gg.z + b4.z;
        v[4 * i + 3] = (v[4 * i + 3] - mu) * rstd * gg.w + b4.w;
        *(F4*)(drow + e) = mkf4(v[4 * i], v[4 * i + 1], v[4 * i + 2], v[4 * i + 3]);
      }
    }
    if (MOD) {
      float s = 0.f;
#pragma unroll
      for (int i = 0; i < 16; ++i) s += v[i];
      float mu = wave_sum(s) * (1.f / 1024.f);
      float q2 = 0.f;
#pragma unroll
      for (int i = 0; i < 16; ++i) { float d = v[i] - mu; q2 += d * d; }
      float rstd = rsqrtf(wave_sum(q2) * (1.f / 1024.f) + LN_EPS);
      const float* md = modp(p, lmod, bidx_of(m));
#pragma unroll
      for (int i = 0; i < 4; ++i) {
        int e = i * 256 + lane * 4;
        F4 sh = *(const F4*)(md + shoff + e), sc = *(const F4*)(md + scoff + e);
        float o0 = (v[4 * i] - mu) * rstd * (1.f + sc.x) + sh.x;
        float o1 = (v[4 * i + 1] - mu) * rstd * (1.f + sc.y) + sh.y;
        float o2 = (v[4 * i + 2] - mu) * rstd * (1.f + sc.z) + sh.z;
        float o3 = (v[4 * i + 3] - mu) * rstd * (1.f + sc.w) + sh.w;
        *(U2*)(hbuf + (size_t)m * 1024 + e) = mk2(pack2(o0, o1), pack2(o2, o3));
      }
    }
  }
}

DI bf16x8 toep_frag(const u32* Tr32, int o) {
  int wd = o >> 1; u32 sh = (o & 1) * 16;
  u32 d0 = Tr32[wd], d1 = Tr32[wd + 1], d2 = Tr32[wd + 2], d3 = Tr32[wd + 3], d4 = Tr32[wd + 4];
  U4 q = mk4(__builtin_amdgcn_alignbit(d1, d0, sh), __builtin_amdgcn_alignbit(d2, d1, sh),
                       __builtin_amdgcn_alignbit(d3, d2, sh), __builtin_amdgcn_alignbit(d4, d3, sh));
  return __builtin_bit_cast(bf16x8, q);
}

DI void toep_item(const Params& p, char* smem, int cv, int c, int bp) {
  const int tid = tidx(), lane = tid & 63, w = tid >> 6, r16 = lane & 15, g = lane >> 4;
  u16* Tr = (u16*)smem;
  u16* Zs = Tr + 16384 + 16;
  const u16* uhyT = (const u16*)(wsp(p) + O_UHYT);
  u16* zT = (u16*)(wsp(p) + O_ZT);
  u16* yhyT = (u16*)(wsp(p) + O_YHYT);
  {
    const U4* Tg = (const U4*)((const u16*)(wsp(p) + O_TLAT) + (size_t)(cv * 512 + c) * 16384);
    for (int e = tid; e < 2048; e += 256) ((U4*)Tr)[e] = Tg[e];
    if (tid < 2) ((U4*)Tr)[2048 + tid] = mk4(0, 0, 0, 0);
  }
  for (int bb = 0; bb < 2; ++bb) {
    int b = 2 * bp + bb;
    if (cv == 0) {
      const u16* src = uhyT + ((size_t)(b * 1536 + 1024 + c)) * LT;
      float w0 = p.hy_conv_w[1024 + c], w1 = p.hy_conv_w[1536 + 1024 + c], w2 = p.hy_conv_w[2 * 1536 + 1024 + c];
      for (int e = tid; e < 1024; e += 256) {
        int s0 = e * 8;
        U4 q = *(const U4*)(src + s0);
        float u[10];
        u[0] = s0 > 0 ? bf2f(src[s0 - 1]) : 0.f;
        u[9] = s0 + 8 < SEQL ? bf2f(src[s0 + 8]) : 0.f;
        u32 ww[4] = {q.x, q.y, q.z, q.w};
#pragma unroll
        for (int k = 0; k < 4; ++k) { u[1 + 2 * k] = __uint_as_float(ww[k] << 16); u[2 + 2 * k] = __uint_as_float(ww[k] & 0xffff0000u); }
        float o[8];
#pragma unroll
        for (int k = 0; k < 8; ++k) o[k] = w0 * u[k] + w1 * u[k + 1] + w2 * u[k + 2];
        *(U4*)(Zs + bb * 8192 + s0) = mk4(pack2(o[0], o[1]), pack2(o[2], o[3]), pack2(o[4], o[5]), pack2(o[6], o[7]));
      }
    } else {
      const U4* src = (const U4*)(zT + ((size_t)(b * 512 + c)) * LT);
      for (int e = tid; e < 1024; e += 256) ((U4*)(Zs + bb * 8192))[e] = src[e];
    }
  }
  __syncthreads();
  const int bb = w >> 1, hw = w & 1;
  const u16* Zb = Zs + bb * 8192;
  const u32* Tr32 = (const u32*)Tr;
  f32x4 acc[4][4];
#pragma unroll
  for (int i = 0; i < 4; ++i)
#pragma unroll
    for (int j = 0; j < 4; ++j) acc[i][j] = f32x4{0.f, 0.f, 0.f, 0.f};
  const int obase = 8192 - r16 + 8 * g;
  for (int dl = -127; dl <= 127; ++dl) {
    int lo = dl > 0 ? dl : 0, hi = dl < 0 ? 127 + dl : 127;
    if (hi < 64 * hw || lo > 64 * hw + 63) continue;
    bf16x8 F[6];
#pragma unroll
    for (int e = 0; e < 6; ++e) F[e] = toep_frag(Tr32, obase - 16 * (4 * dl - 2 + e));
#pragma unroll
    for (int nt = 0; nt < 4; ++nt) {
      int t1lo = 64 * hw + 16 * nt;
      if (t1lo + 15 < lo || t1lo > hi) continue;
      int s1 = t1lo + r16 - dl;
      bool ok = (s1 >= 0) && (s1 < 128);
      int s1c = ok ? s1 : 0;
#pragma unroll
      for (int ks = 0; ks < 2; ++ks) {
        U4 q = *(const U4*)(Zb + 64 * s1c + 32 * ks + 8 * g);
        if (!ok) q = mk4(0, 0, 0, 0);
        bf16x8 bfr = __builtin_bit_cast(bf16x8, q);
#pragma unroll
        for (int mt = 0; mt < 4; ++mt) acc[mt][nt] = mfma16(F[mt - 2 * ks + 2], bfr, acc[mt][nt]);
      }
    }
  }
  {
    int b = 2 * bp + bb, choff = (cv == 0) ? 0 : 512;
    const u16* xr = uhyT + ((size_t)(b * 1536 + choff + c)) * LT;
    float w0 = p.hy_conv_w[choff + c], w1 = p.hy_conv_w[1536 + choff + c], w2 = p.hy_conv_w[2 * 1536 + choff + c];
    u16* dst = (cv == 0 ? zT : yhyT) + ((size_t)(b * 512 + c)) * LT;
#pragma unroll
    for (int mt = 0; mt < 4; ++mt)
#pragma unroll
      for (int nt = 0; nt < 4; ++nt) {
        int t = 64 * (64 * hw + 16 * nt + r16) + 16 * mt + 4 * g;
        U2 q = *(const U2*)(xr + t);
        float u[6];
        u[0] = t > 0 ? bf2f(xr[t - 1]) : 0.f;
        u[5] = t + 4 < SEQL ? bf2f(xr[t + 4]) : 0.f;
        u[1] = __uint_as_float(q.x << 16); u[2] = __uint_as_float(q.x & 0xffff0000u);
        u[3] = __uint_as_float(q.y << 16); u[4] = __uint_as_float(q.y & 0xffff0000u);
        float o[4];
#pragma unroll
        for (int r = 0; r < 4; ++r) o[r] = (w0 * u[r] + w1 * u[r + 1] + w2 * u[r + 2]) * acc[mt][nt][r];
        *(U2*)(dst + t) = mk2(pack2(o[0], o[1]), pack2(o[2], o[3]));
      }
  }
}

DI void toep_ctx_item(const Params& p, char* smem, int cv, int c) {
  const int tid = tidx();
  float* Tf = (float*)smem;
  float* zf = Tf + 512;
  const u16* uhyT = (const u16*)(wsp(p) + O_UHYT);
  u16* zT = (u16*)(wsp(p) + O_ZT);
  u16* yhyT = (u16*)(wsp(p) + O_YHYT);
  const u16* Tg = (const u16*)(wsp(p) + O_TCTX) + (size_t)(cv * 512 + c) * 512;
  Tf[tid] = bf2f(Tg[tid]); Tf[tid + 256] = bf2f(Tg[tid + 256]);
  if (tid == 0) Tf[0] = 0.f;
  for (int b = 0; b < 4; ++b) {
    float zv;
    if (cv == 0) {
      const u16* src = uhyT + ((size_t)(b * 1536 + 1024 + c)) * LT + SEQL;
      float w0 = p.hy_conv_w[1024 + c], w1 = p.hy_conv_w[1536 + 1024 + c], w2 = p.hy_conv_w[2 * 1536 + 1024 + c];
      float um = tid > 0 ? bf2f(src[tid - 1]) : 0.f, u0 = bf2f(src[tid]), up = tid < 255 ? bf2f(src[tid + 1]) : 0.f;
      zv = bf2f(f2bf(w0 * um + w1 * u0 + w2 * up));
    } else {
      zv = bf2f(zT[((size_t)(b * 512 + c)) * LT + SEQL + tid]);
    }
    zf[b * 256 + tid] = zv;
  }
  __syncthreads();
  int choff = (cv == 0) ? 0 : 512;
  float w0 = p.hy_conv_w[choff + c], w1 = p.hy_conv_w[1536 + choff + c], w2 = p.hy_conv_w[2 * 1536 + choff + c];
  for (int b = 0; b < 4; ++b) {
    float y = 0.f;
    for (int s = 0; s < 256; ++s) y += Tf[256 - (tid - s)] * zf[b * 256 + s];
    const u16* xr = uhyT + ((size_t)(b * 1536 + choff + c)) * LT + SEQL;
    float um = tid > 0 ? bf2f(xr[tid - 1]) : 0.f, u0 = bf2f(xr[tid]), up = tid < 255 ? bf2f(xr[tid + 1]) : 0.f;
    float o = (w0 * um + w1 * u0 + w2 * up) * y;
    u16* dst = (cv == 0 ? zT : yhyT) + ((size_t)(b * 512 + c)) * LT + SEQL;
    dst[tid] = f2bf(o);
  }
}

DI void natten_wave(const Params& p, u16* Pw, int b, int h, bool lat, int r, int j, int qt) {
  const int lane = tidx() & 63, r16 = lane & 15, g = lane >> 4;
  const u16* uqk = (const u16*)(wsp(p) + O_UQK);
  const u16* vT = (const u16*)(wsp(p) + O_VT0);
  u16* yna = (u16*)(wsp(p) + O_YNA);
  const int qm0 = lat ? b * 8192 + r * 64 + 16 * j : NLAT + b * 256 + 16 * qt;
  bf16x8 qa[2];
#pragma unroll
  for (int ks = 0; ks < 2; ++ks) qa[ks] = *(const bf16x8*)(uqk + (size_t)(qm0 + r16) * 1024 + h * 64 + 32 * ks + 8 * g);
  int rs = r - 4; rs = rs < 0 ? 0 : (rs > 120 ? 120 : rs);
  int kb = 16 * j - 8; kb = kb < 0 ? 0 : (kb > 32 ? 32 : kb);
  f32x4 S[32];
  const float NEG = -1e30f;
  const float* rpb = p.na_rpb + h * 15 * 31;
#pragma unroll
  for (int nt = 0; nt < 32; ++nt) {
    if (nt < 16 && !lat) { S[nt] = f32x4{NEG, NEG, NEG, NEG}; continue; }
    if ((nt & 3) == 0) __builtin_amdgcn_sched_barrier(0);
    int keytok;
    if (nt < 16) keytok = b * 8192 + (rs + (nt >> 1)) * 64 + kb + 16 * (nt & 1) + r16;
    else keytok = NLAT + b * 256 + 16 * (nt - 16) + r16;
    const u16* kp = uqk + (size_t)keytok * 1024 + 512 + h * 64 + 8 * g;
    f32x4 a = f32x4{0.f, 0.f, 0.f, 0.f};
    a = mfma16(qa[0], *(const bf16x8*)(kp), a);
    a = mfma16(qa[1], *(const bf16x8*)(kp + 32), a);
    if (nt < 16) {
      int rr = nt >> 1, kcol = kb + 16 * (nt & 1) + r16, dr = rs + rr - r + 7;
#pragma unroll
      for (int q = 0; q < 4; ++q) {
        int qcol = 16 * j + 4 * g + q;
        int cs = qcol - 8; cs = cs < 0 ? 0 : (cs > 48 ? 48 : cs);
        bool valid = (kcol >= cs) && (kcol < cs + 16);
        int dc = kcol - qcol + 15; dc = dc < 0 ? 0 : (dc > 30 ? 30 : dc);
        float bias = rpb[dr * 31 + dc];
        a[q] = valid ? (a[q] * 0.125f + bias) * LOG2E : NEG;
      }
    } else {
#pragma unroll
      for (int q = 0; q < 4; ++q) a[q] = a[q] * (0.125f * LOG2E);
    }
    S[nt] = a;
  }
  float mx[4], sm[4];
#pragma unroll
  for (int q = 0; q < 4; ++q) {
    float m = NEG;
#pragma unroll
    for (int nt = 0; nt < 32; ++nt) m = fmaxf(m, S[nt][q]);
    m = fmaxf(m, __shfl_xor(m, 1)); m = fmaxf(m, __shfl_xor(m, 2)); m = fmaxf(m, __shfl_xor(m, 4)); m = fmaxf(m, __shfl_xor(m, 8));
    mx[q] = m; sm[q] = 0.f;
  }
#pragma unroll
  for (int nt = 0; nt < 32; ++nt) {
    if (nt < 16 && !lat) continue;
#pragma unroll
    for (int q = 0; q < 4; ++q) {
      float pv = exp2f(S[nt][q] - mx[q]);
      u16 pb = f2bf(pv);
      sm[q] += bf2f(pb);
      Pw[(4 * g + q) * 520 + 16 * nt + r16] = pb;
    }
  }
#pragma unroll
  for (int q = 0; q < 4; ++q) {
    float s = sm[q];
    s += __shfl_xor(s, 1); s += __shfl_xor(s, 2); s += __shfl_xor(s, 4); s += __shfl_xor(s, 8);
    sm[q] = 1.f / s;
  }
  __syncthreads();
  f32x4 O[4];
#pragma unroll
  for (int nt = 0; nt < 4; ++nt) O[nt] = f32x4{0.f, 0.f, 0.f, 0.f};
#pragma unroll
  for (int ks = 0; ks < 16; ++ks) {
    if (ks < 8 && !lat) continue;
    bf16x8 pa = *(const bf16x8*)(Pw + r16 * 520 + 32 * ks + 8 * g);
    size_t vcol = ks < 8 ? (size_t)(rs + ks) * 64 + kb + 8 * g : (size_t)SEQL + 32 * (ks - 8) + 8 * g;
#pragma unroll
    for (int nt = 0; nt < 4; ++nt) {
      bf16x8 vb = *(const bf16x8*)(vT + ((size_t)(b * 512 + h * 64 + 16 * nt + r16)) * LT + vcol);
      O[nt] = mfma16(pa, vb, O[nt]);
    }
  }
#pragma unroll
  for (int nt = 0; nt < 4; ++nt)
#pragma unroll
    for (int q = 0; q < 4; ++q) yna[(size_t)(qm0 + 4 * g + q) * 512 + h * 64 + 16 * nt + r16] = f2bf(O[nt][q] * sm[q]);
}

constexpr int SK_ROW = 104, SV_ROW = 72;
constexpr int MLA_STAGE = 64 * SK_ROW + 96 * SV_ROW;
DI void mla_item(const Params& p, char* smem, int b, int h, int qb) {
  const int tid = tidx(), lane = tid & 63, w = tid >> 6, c32 = lane & 31, h2 = lane >> 5;
  const u16* Q = (const u16*)(wsp(p) + O_Q);
  const u16* Kg = (const u16*)(wsp(p) + O_KB) + (size_t)(b * 8 + h) * LT * 96;
  const u16* Vg = (const u16*)(wsp(p) + O_VT1) + (size_t)(b * 8 + h) * 96 * LT;
  u16* Y1 = (u16*)(wsp(p) + O_Y1);
  u16* sb = (u16*)smem;
  const int qrow = b * 8192 + qb * 128 + w * 32 + c32;
  bf16x8 qf[6];
#pragma unroll
  for (int ks = 0; ks < 6; ++ks) qf[ks] = *(const bf16x8*)(Q + (size_t)qrow * 768 + h * 96 + 16 * ks + 8 * h2);
  f32x16 O[3];
#pragma unroll
  for (int d = 0; d < 3; ++d)
#pragma unroll
    for (int i = 0; i < 16; ++i) O[d][i] = 0.f;
  float mrun = -1e30f, lrun = 0.f;
  U4 kr0, kr1, kr2, vr0, vr1, vr2;
  const int kkey0 = tid / 12, kkc0 = tid % 12, kkey1 = (tid + 256) / 12, kkc1 = (tid + 256) % 12, kkey2 = (tid + 512) / 12, kkc2 = (tid + 512) % 12;
#define MLA_FETCH(kt_)                                                              \
  {                                                                                 \
    const u16* kp_ = Kg + (size_t)(kt_) * 64 * 96 + tid * 8;                         \
    kr0 = *(const U4*)(kp_); kr1 = *(const U4*)(kp_ + 2048); kr2 = *(const U4*)(kp_ + 4096); \
    const u16* vp_ = Vg + (size_t)(tid >> 3) * LT + (kt_) * 64 + (tid & 7) * 8;      \
    vr0 = *(const U4*)(vp_); vr1 = *(const U4*)(vp_ + (size_t)32 * LT); vr2 = *(const U4*)(vp_ + (size_t)64 * LT); \
  }
#define MLA_COMMIT(st_)                                                             \
  {                                                                                 \
    u16* s_ = (st_);                                                                \
    *(U4*)(s_ + kkey0 * SK_ROW + kkc0 * 8) = kr0;                                \
    *(U4*)(s_ + kkey1 * SK_ROW + kkc1 * 8) = kr1;                                \
    *(U4*)(s_ + kkey2 * SK_ROW + kkc2 * 8) = kr2;                                \
    u16* v_ = s_ + 64 * SK_ROW + (tid >> 3) * SV_ROW + (tid & 7) * 8;               \
    *(U4*)(v_) = vr0; *(U4*)(v_ + 32 * SV_ROW) = vr1; *(U4*)(v_ + 64 * SV_ROW) = vr2; \
  }
  MLA_FETCH(0);
  __syncthreads();
  MLA_COMMIT(sb);
  __syncthreads();
  constexpr int NKT = LT / 64;
  for (int kt = 0; kt < NKT; ++kt) {
    const u16* sK = sb + (kt & 1) * MLA_STAGE;
    const u16* sV = sK + 64 * SK_ROW;
    if (kt + 1 < NKT) MLA_FETCH(kt + 1);
    f32x16 S[2];
#pragma unroll
    for (int mt = 0; mt < 2; ++mt) {
      f32x16 a;
#pragma unroll
      for (int i = 0; i < 16; ++i) a[i] = 0.f;
#pragma unroll
      for (int ks = 0; ks < 6; ++ks) {
        bf16x8 kf = *(const bf16x8*)(sK + (32 * mt + c32) * SK_ROW + 16 * ks + 8 * h2);
        a = mfma32(kf, qf[ks], a);
      }
      S[mt] = a;
    }
    float mx = -1e30f;
#pragma unroll
    for (int mt = 0; mt < 2; ++mt)
#pragma unroll
      for (int i = 0; i < 16; ++i) mx = fmaxf(mx, S[mt][i]);
    mx = fmaxf(mx, __shfl_xor(mx, 32));
    float mnew = fmaxf(mrun, mx);
    float alpha = exp2f(mrun - mnew);
    mrun = mnew;
    float ps = 0.f;
    bf16x8 pf[4];
#pragma unroll
    for (int mt = 0; mt < 2; ++mt)
#pragma unroll
      for (int s = 0; s < 2; ++s) {
        float e[8];
#pragma unroll
        for (int jj = 0; jj < 8; ++jj) { e[jj] = exp2f(S[mt][8 * s + jj] - mnew); ps += e[jj]; }
        U4 q = mk4(pack2(e[0], e[1]), pack2(e[2], e[3]), pack2(e[4], e[5]), pack2(e[6], e[7]));
        pf[mt * 2 + s] = __builtin_bit_cast(bf16x8, q);
      }
    lrun = lrun * alpha + ps;
#pragma unroll
    for (int d = 0; d < 3; ++d)
#pragma unroll
      for (int i = 0; i < 16; ++i) O[d][i] *= alpha;
#pragma unroll
    for (int kk = 0; kk < 4; ++kk) {
      int keybase = 16 * kk + 4 * h2;
#pragma unroll
      for (int d = 0; d < 3; ++d) {
        const u16* vp = sV + (32 * d + c32) * SV_ROW + keybase;
        U2 lo = *(const U2*)(vp), hi = *(const U2*)(vp + 8);
        U4 q = mk4(lo.x, lo.y, hi.x, hi.y);
        O[d] = mfma32(__builtin_bit_cast(bf16x8, q), pf[kk], O[d]);
      }
    }
    if (kt + 1 < NKT) MLA_COMMIT(sb + ((kt + 1) & 1) * MLA_STAGE);
    __syncthreads();
  }
  float l = lrun + __shfl_xor(lrun, 32);
  float inv = 1.f / l;
#pragma unroll
  for (int d = 0; d < 3; ++d)
#pragma unroll
    for (int i4 = 0; i4 < 4; ++i4) {
      int dd = 32 * d + 8 * i4 + 4 * h2;
      U2 o = mk2(pack2(O[d][4 * i4] * inv, O[d][4 * i4 + 1] * inv), pack2(O[d][4 * i4 + 2] * inv, O[d][4 * i4 + 3] * inv));
      *(U2*)(Y1 + (size_t)qrow * 1024 + h * 96 + dd) = o;
    }
}

DI void kpe_item(const Params& p, int it) {
  const int tid = tidx();
  const u16* u1 = (const u16*)(wsp(p) + O_U1);
  u16* kbuf = (u16*)(wsp(p) + O_KB);
#pragma unroll
  for (int ps = 0; ps < 8; ++ps) {
    int m = it * 64 + ps * 8 + (tid >> 5), i = tid & 31;
    float v = bf2f(u1[(size_t)m * 1024 + 640 + i]);
    float pr = bf2f(u1[(size_t)m * 1024 + 640 + (i ^ 8)]);
    int b, s; bs_of(m, b, s);
    float o = v;
    if (m < NLAT) {
      int axis = i >> 4, second = (i >> 3) & 1, idx = i & 7;
      float inv = exp2f(-(float)idx * (13.287712379549449f / 8.f));
      float pos = (float)(axis ? (s & 63) : (s >> 6));
      float rv = pos * inv * 0.15915494309189535f; float sn = __builtin_amdgcn_sinf(rv), cs = __builtin_amdgcn_cosf(rv);
      o = second ? (v * cs + pr * sn) : (v * cs - pr * sn);
    }
    u16 ob = f2bf(o);
#pragma unroll
    for (int hh = 0; hh < 8; ++hh) kbuf[((size_t)(b * 8 + hh) * LT + s) * 96 + 64 + i] = ob;
  }
}

DI void fnet1_item(const Params& p, char* smem, int it) {
  const int tid = tidx();
  float* xs = (float*)smem;
  float* ct = xs + 64 * 257;
  float* st = ct + 64;
  const u16* u1 = (const u16*)(wsp(p) + O_U1);
  u16* XT = (u16*)(wsp(p) + O_XT);
  const int m0 = it * 64;
  if (tid < 64) { float sn = __builtin_amdgcn_sinf((float)tid / 64.f), cs = __builtin_amdgcn_cosf((float)tid / 64.f); ct[tid] = cs; st[tid] = sn; }
  for (int e = tid; e < 64 * 256; e += 256) {
    int tok = e >> 8, ch = e & 255;
    xs[tok * 257 + ch] = bf2f(u1[(size_t)(m0 + tok) * 1024 + 672 + ch]);
  }
  __syncthreads();
  const int tok = tid & 63, gq = tid >> 6;
  float xr[64];
  {
    float* xp = xs + tok * 257 + gq * 64;
    float s = 0.f;
#pragma unroll
    for (int jj = 0; jj < 64; ++jj) { xr[jj] = xp[jj]; s += xr[jj]; }
    float mu = s * (1.f / 64.f), q2 = 0.f;
#pragma unroll
    for (int jj = 0; jj < 64; ++jj) { float d = xr[jj] - mu; q2 += d * d; }
    float rstd = rsqrtf(q2 * (1.f / 64.f) + LN_EPS);
#pragma unroll
    for (int jj = 0; jj < 64; ++jj) xr[jj] = (xr[jj] - mu) * rstd * p.fn_g[gq * 64 + jj] + p.fn_b[gq * 64 + jj];
  }
  const int b = m0 >> 13, t = (m0 & 8191) + tok;
  for (int mm = 0; mm < 64; ++mm) {
    float c = 0.f, s = 0.f;
#pragma unroll
    for (int jj = 0; jj < 64; ++jj) { int idx = (mm * jj) & 63; c += xr[jj] * ct[idx]; s += xr[jj] * st[idx]; }
    size_t n = (size_t)(b * 256 + gq * 64 + mm);
    XT[n * 16384 + t] = f2bf(c);
    XT[n * 16384 + 8192 + t] = f2bf(s);
  }
}

DI void gbar(unsigned* ctr, unsigned& target, unsigned nblk) {
  asm volatile("s_waitcnt vmcnt(0)" ::: "memory");
  __syncthreads();
  target += nblk;
  if (__builtin_amdgcn_workitem_id_x() == 0) {
    __builtin_amdgcn_s_waitcnt(0);
    __builtin_amdgcn_fence(__ATOMIC_RELEASE, "agent");
    asm volatile("s_waitcnt vmcnt(0)" ::: "memory");
    __hip_atomic_fetch_add(ctr, 1u, __ATOMIC_RELAXED, __HIP_MEMORY_SCOPE_AGENT);
    while (__hip_atomic_load(ctr, __ATOMIC_RELAXED, __HIP_MEMORY_SCOPE_AGENT) < target) __builtin_amdgcn_s_sleep(1);
    __builtin_amdgcn_fence(__ATOMIC_ACQUIRE, "agent");
    asm volatile("s_waitcnt vmcnt(0)" ::: "memory");
  }
  __syncthreads();
}

#ifndef REP_MLA
#define REP_MLA 1
#endif
#ifndef REP_TOEP
#define REP_TOEP 1
#endif
#ifndef REP_MLP1
#define REP_MLP1 1
#endif
#ifndef REP_NAT
#define REP_NAT 1
#endif
#ifndef REP_FNG
#define REP_FNG 1
#endif
#ifndef REP_WIN
#define REP_WIN 1
#endif

__global__ void __launch_bounds__(256, 2) mega(Params p) {
  cg::grid_group grid = cg::this_grid();
  __shared__ __attribute__((aligned(16))) char smem[SMEM_BYTES];
  char* ws = wsp(p);
  const int nblk = gridDim.x, bid = bidx();
  float* S = (float*)(ws + O_S);
  u16* hbuf = (u16*)(ws + O_HBUF);
  unsigned* barp = (unsigned*)(ws + O_BAR);
  unsigned bar_target = 0;
#define SYNC() gbar(barp, bar_target, (unsigned)nblk)

  phase_prep(p, smem);
  grid.sync();
  phase_ln<true, false, true>(p, R, nullptr, nullptr, nullptr, false, 0, 0, 1024);
  SYNC();

  for (int l = 0; l < 2; ++l) {
    const int rows = (l == 0) ? R : NLAT;
    const float* mod = modp(p, l, 0);
    if (l == 0) {
      {
        ALoadRow al; al.A = hbuf; al.lda = 1024;
        EpWin0 ep; ep.uhyT = (u16*)(ws + O_UHYT); ep.uqk = (u16*)(ws + O_UQK); ep.vT = (u16*)(ws + O_VT0);
        const int ntile = (R / 128) * 24;
        for (int rep = 0; rep < REP_WIN; ++rep) for (int t = bid; t < ntile; t += nblk) {
          int nt = t % 24;
          if (nt >= 12 && nt < 20) gemm_tile<true>(al, (const u16*)(ws + O_WT_ABIN), 1024, 1024, (t / 24) * 128, nt * 128, ep, smem);
          else gemm_tile<false>(al, (const u16*)(ws + O_WT_ABIN), 1024, 1024, (t / 24) * 128, nt * 128, ep, smem);
        }
      }
      SYNC();
      {
        const int n_toep = 1024, n_na = 4096, n_nac = 128, n_tc = 512;
        for (int it = bid; it < n_toep + n_na + n_nac + n_tc; it += nblk) {
          __syncthreads();
          int t = it;
          if (t < n_toep) { for (int rep = 0; rep < REP_TOEP; ++rep) { __syncthreads(); toep_item(p, smem, 0, t >> 1, t & 1); } continue; }
          t -= n_toep;
          u16* Pw = (u16*)smem + (tidx() >> 6) * (16 * 520);
          if (t < n_na) { int b = t >> 10, r = (t >> 3) & 127, h = t & 7; for (int rep = 0; rep < REP_NAT; ++rep) { __syncthreads(); natten_wave(p, Pw, b, h, true, r, tidx() >> 6, 0); } continue; }
          t -= n_na;
          if (t < n_nac) { int b = t >> 5, h = (t >> 2) & 7, q4 = t & 3; natten_wave(p, Pw, b, h, false, 0, 0, q4 * 4 + (tidx() >> 6)); continue; }
          t -= n_nac;
          toep_ctx_item(p, smem, 0, t);
        }
      }
      SYNC();
      {
        for (int it = bid; it < 1024 + 512; it += nblk) {
          __syncthreads();
          if (it < 1024) { for (int rep = 0; rep < REP_TOEP; ++rep) { __syncthreads(); toep_item(p, smem, 1, it >> 1, it & 1); } }
          else toep_ctx_item(p, smem, 1, it - 1024);
        }
      }
      SYNC();
      {
        ALoadMix al; al.YT = (const u16*)(ws + O_YHYT); al.YN = (const u16*)(ws + O_YNA);
        EpResid ep; ep.xlat = p.x; ep.xctx = p.ctx; ep.S = S; ep.mod = mod; ep.goff = 2048;
        const int ntile = (R / 128) * 8;
        for (int t = bid; t < ntile; t += nblk) gemm_tile<true>(al, (const u16*)(ws + O_WT_ABOUT), 1024, 1024, (t / 8) * 128, (t % 8) * 128, ep, smem);
      }
      SYNC();
    } else {
      {
        ALoadRow al; al.A = hbuf; al.lda = 1024;
        EpPlain ep; ep.dst = (u16*)(ws + O_U1); ep.ld = 1024;
        const int ntile = (R / 128) * 8;
        for (int t = bid; t < ntile; t += nblk) gemm_tile<true>(al, (const u16*)(ws + O_WT_CDIN), 1024, 1024, (t / 8) * 128, (t % 8) * 128, ep, smem);
      }
      SYNC();
      {
        const int n_q = (NLAT / 128) * 6, n_kv = (R / 128) * 10, n_kpe = R / 64, n_f1 = NLAT / 64;
        float* srow = (float*)(smem + 73728);
        const u16* u1 = (const u16*)(ws + O_U1);
        for (int it = bid; it < n_q + n_kv + n_kpe + n_f1; it += nblk) {
          __syncthreads();
          int t = it;
          if (t < n_q) {
            int m0 = (t / 6) * 128, n0 = (t % 6) * 128;
            rms_rows(u1, 1024, 384, m0, srow);
            ALoadRow al; al.A = u1; al.lda = 1024;
            EpQ ep; ep.q = (u16*)(ws + O_Q); ep.srow = srow; ep.m0 = m0;
            gemm_tile<true>(al, (const u16*)(ws + O_WT_UQ), 384, 384, m0, n0, ep, smem);
            continue;
          }
          t -= n_q;
          if (t < n_kv) {
            int m0 = (t / 10) * 128, n0 = (t % 10) * 128;
            rms_rows(u1 + 384, 1024, 256, m0, srow);
            ALoadRow al; al.A = u1 + 384; al.lda = 1024;
            EpKV ep; ep.kb = (u16*)(ws + O_KB); ep.vT = (u16*)(ws + O_VT1); ep.srow = srow; ep.m0 = m0;
            gemm_tile<false>(al, (const u16*)(ws + O_WT_UKV), 256, 256, m0, n0, ep, smem);
            continue;
          }
          t -= n_kv;
          if (t < n_kpe) { kpe_item(p, t); continue; }
          t -= n_kpe;
          fnet1_item(p, smem, t);
        }
      }
      SYNC();
      {
        const int n_mla = 2048, n_fn = 512;
        for (int it = bid; it < n_mla + n_fn; it += nblk) {
          __syncthreads();
          if (it < n_mla) { int b = it >> 9, h = (it >> 6) & 7, qb = it & 63; for (int rep = 0; rep < REP_MLA; ++rep) { __syncthreads(); mla_item(p, smem, b, h, qb); } continue; }
          int t = it - n_mla;
          ALoadDFT al;
          EpFnet ep; ep.y1 = (u16*)(ws + O_Y1);
          for (int rep = 0; rep < REP_FNG; ++rep) gemm_tile<true>(al, (const u16*)(ws + O_XT), 16384, 16384, (t >> 3) * 128, (t & 7) * 128, ep, smem);
        }
      }
      SYNC();
      {
        ALoadRow al; al.A = (const u16*)(ws + O_Y1); al.lda = 1024;
        EpResid ep; ep.xlat = S; ep.xctx = S + (size_t)NLAT * 1024; ep.S = S; ep.mod = mod; ep.goff = 2048;
        const int ntile = (NLAT / 128) * 8;
        for (int t = bid; t < ntile; t += nblk) gemm_tile<true>(al, (const u16*)(ws + O_WT_CDOUT), 1024, 1024, (t / 8) * 128, (t % 8) * 128, ep, smem);
      }
      SYNC();
    }
    phase_ln<false, true, true>(p, rows, p.ln_g + (size_t)(l * 2 + 0) * 1024, p.ln_b + (size_t)(l * 2 + 0) * 1024, nullptr, true, l, 3072, 4096);
    SYNC();
    {
      ALoadRow al; al.A = hbuf; al.lda = 1024;
      EpRelu2 ep; ep.a1 = (u16*)(ws + O_A1);
      const int ntile = (rows / 128) * 32;
      const u16* W = (const u16*)(ws + O_WT_W1) + (size_t)l * 4096 * 1024;
      for (int rep = 0; rep < REP_MLP1; ++rep) for (int t = bid; t < ntile; t += nblk) gemm_tile<true>(al, W, 1024, 1024, (t / 32) * 128, (t % 32) * 128, ep, smem);
    }
    SYNC();
    {
      ALoadRow al; al.A = (const u16*)(ws + O_A1); al.lda = 4096;
      EpResid ep; ep.xlat = S; ep.xctx = S + (size_t)NLAT * 1024; ep.S = S; ep.mod = mod; ep.goff = 5120;
      const int ntile = (rows / 128) * 8;
      const u16* W = (const u16*)(ws + O_WT_W2) + (size_t)l * 4096 * 1024;
      for (int t = bid; t < ntile; t += nblk) gemm_tile<true>(al, W, 4096, 4096, (t / 8) * 128, (t % 8) * 128, ep, smem);
    }
    SYNC();
    if (l == 0) phase_ln<false, true, true>(p, R, p.ln_g + 1024, p.ln_b + 1024, nullptr, true, 1, 0, 1024);
    else phase_ln<false, true, false>(p, NLAT, p.ln_g + 3 * 1024, p.ln_b + 3 * 1024, p.out, false, 0, 0, 0);
    if (l == 0) SYNC();
  }
}

extern "C" void kernel_launch(void* const* d_in, const int* in_sizes, int n_in, void* d_out, int out_size, void* d_ws,
                              size_t ws_size, hipStream_t stream) {
  static int grid_blocks = 0;
  if (!grid_blocks) {
    int dev = 0, cus = 0, per_cu = 0;
    hipGetDevice(&dev);
    hipDeviceGetAttribute(&cus, hipDeviceAttributeMultiprocessorCount, dev);
    hipOccupancyMaxActiveBlocksPerMultiprocessor(&per_cu, mega, 256, 0);
    if (per_cu > 2) per_cu = 2;
    if (per_cu < 1) per_cu = 1;
    grid_blocks = cus * per_cu;
  }
  Params p{};
  const float** f = (const float**)&p;
  for (int i = 0; i < 30; ++i) f[i] = (const float*)d_in[i];
  p.out = (float*)d_out;
  p.ws = (char*)d_ws;
  hipMemsetAsync((char*)d_ws + O_BAR, 0, 256, stream);
  void* args[] = {&p};
  hipError_t e = hipLaunchCooperativeKernel((void*)mega, dim3(grid_blocks), dim3(256), args, 0, stream);
  if (e != hipSuccess) fprintf(stderr, "cooperative launch failed: %s (grid %d)\n", hipGetErrorString(e), grid_blocks);
}
```

```cpp
#include <hip/hip_runtime.h>
#include <hip/hip_cooperative_groups.h>
#include <cstdio>
namespace cg = cooperative_groups;

#define DI __device__ __forceinline__
typedef unsigned short u16;
typedef unsigned int u32;
using bf16x8 = __attribute__((ext_vector_type(8))) short;
using f32x4 = __attribute__((ext_vector_type(4))) float;
using f32x16 = __attribute__((ext_vector_type(16))) float;
using U4 = __attribute__((ext_vector_type(4))) unsigned int;
using U2 = __attribute__((ext_vector_type(2))) unsigned int;
using F4 = __attribute__((ext_vector_type(4))) float;
#define mk4(a, b, c, d) (U4{(u32)(a), (u32)(b), (u32)(c), (u32)(d)})
#define mk2(a, b) (U2{(u32)(a), (u32)(b)})
#define mkf4(a, b, c, d) (F4{(a), (b), (c), (d)})

constexpr int NB = 4, SEQL = 8192, LC = 256;
constexpr int NLAT = NB * SEQL;
constexpr int NCTX = NB * LC;
constexpr int R = NLAT + NCTX;
constexpr int LT = SEQL + LC;
constexpr float ALPHA = 1.4142135623730951f;
constexpr float LN_EPS = 1e-5f;
constexpr float LOG2E = 1.4426950408889634f;

constexpr size_t O_WT_ABIN = 0;
constexpr size_t O_WT_ABOUT = O_WT_ABIN + 3072ull * 1024 * 2;
constexpr size_t O_WT_W1 = O_WT_ABOUT + 1024ull * 1024 * 2;
constexpr size_t O_WT_W2 = O_WT_W1 + 2ull * 4096 * 1024 * 2;
constexpr size_t O_WT_CDIN = O_WT_W2 + 2ull * 4096 * 1024 * 2;
constexpr size_t O_WT_CDOUT = O_WT_CDIN + 1024ull * 1024 * 2;
constexpr size_t O_WT_UQ = O_WT_CDOUT + 1024ull * 1024 * 2;
constexpr size_t O_WT_UKV = O_WT_UQ + 768ull * 384 * 2;
constexpr size_t O_MOD = O_WT_UKV + 1280ull * 256 * 2;
constexpr size_t O_TCTX = O_MOD + 2ull * 5 * 6144 * 4;
constexpr size_t O_S = (O_TCTX + 2ull * 512 * 512 * 2 + 255) & ~(size_t)255;
constexpr size_t O_D = O_S + (size_t)R * 1024 * 4;
constexpr size_t O_HBUF = O_D;
constexpr size_t O_UQK = O_D + (size_t)R * 1024 * 2;
constexpr size_t O_VT0 = O_UQK + (size_t)R * 1024 * 2;
constexpr size_t O_UHYT = O_VT0 + 4ull * 512 * LT * 2;
constexpr size_t O_TLAT = O_UHYT + 4ull * 1536 * LT * 2;
constexpr size_t O_ZT = O_D;
constexpr size_t O_YNA = O_D + 4ull * 512 * LT * 2;
constexpr size_t O_YHYT = O_UQK;
constexpr size_t O_A1 = O_UQK;
constexpr size_t O_U1 = O_UQK;
constexpr size_t O_Q = O_U1 + (size_t)R * 1024 * 2;
constexpr size_t O_KB = O_Q + (size_t)NLAT * 768 * 2;
constexpr size_t O_VT1 = O_KB + 32ull * LT * 96 * 2;
constexpr size_t O_XT = O_VT1 + 32ull * LT * 96 * 2;
constexpr size_t O_Y1 = O_D;
constexpr size_t WS_NEED = O_A1 + (size_t)R * 4096 * 2;
constexpr size_t O_BAR = (WS_NEED + 255) & ~(size_t)255;
static_assert(O_BAR + 256 <= 536870912ull, "ws too large");
static_assert(O_TLAT + 2ull * 512 * 16384 * 2 <= WS_NEED, "l0 region");
static_assert(O_XT + 1024ull * 16384 * 2 <= WS_NEED, "l1 region");

constexpr int SMEM_BYTES = 73728 + 1024;

struct Params {
  const float *x, *c, *ctx, *c_ctx, *mod_w, *mod_b, *ln_g, *ln_b, *mlp_w1, *mlp_w2, *ab_w_in, *ab_w_out, *hy_conv_w,
      *hy_w1, *hy_b1, *hy_freq, *hy_w2, *hy_b2, *hy_w3, *hy_log_decay, *hy_skip, *na_rpb, *cd_w_in, *cd_w_out,
      *mla_q_norm, *mla_w_uq, *mla_kv_norm, *mla_w_ukv, *fn_g, *fn_b;
  float* out;
  char* ws;
};

DI int tidx() { int t = __builtin_amdgcn_workitem_id_x() & 255; asm volatile("" : "+v"(t)); return t; }
DI int tid512() { int t = __builtin_amdgcn_workitem_id_x(); asm volatile("" : "+v"(t)); return t; }
DI int halfx() { return __builtin_amdgcn_readfirstlane(__builtin_amdgcn_workitem_id_x() >> 8); }
DI int bidx() { int b = __builtin_amdgcn_workgroup_id_x() * 2 + halfx(); asm volatile("" : "+s"(b)); return b; }
DI int rbidx() { int b = __builtin_amdgcn_workgroup_id_x(); asm volatile("" : "+s"(b)); return b; }
#define NVB ((int)gridDim.x * 2)
DI char* wsp(const Params& p) { char* w = p.ws; asm volatile("" : "+s"(w)); return w; }

DI u32 pack2(float a, float b) { u32 r; asm("v_cvt_pk_bf16_f32 %0, %1, %2" : "=v"(r) : "v"(a), "v"(b)); return r; }
DI u16 f2bf(float x) { return (u16)pack2(x, 0.f); }
DI float bf2f(u16 h) { return __uint_as_float(((u32)h) << 16); }
DI float wave_sum(float v) {
#pragma unroll
  for (int o = 32; o >= 1; o >>= 1) v += __shfl_xor(v, o);
  return v;
}
DI f32x4 mfma16(bf16x8 a, bf16x8 b, f32x4 c) { return __builtin_amdgcn_mfma_f32_16x16x32_bf16(a, b, c, 0, 0, 0); }
DI f32x16 mfma32(bf16x8 a, bf16x8 b, f32x16 c) { return __builtin_amdgcn_mfma_f32_32x32x16_bf16(a, b, c, 0, 0, 0); }

DI const float* modp(const Params& p, int l, int bidx) { return (const float*)(wsp(p) + O_MOD) + ((size_t)l * 5 + bidx) * 6144; }
DI int bidx_of(int m) { return m < NLAT ? (m >> 13) : 4; }
DI void bs_of(int m, int& b, int& s) {
  if (m < NLAT) { b = m >> 13; s = m & 8191; }
  else { int t = m - NLAT; b = t >> 8; s = SEQL + (t & 255); }
}

constexpr int BK = 64, LROW = BK + 8;
constexpr int STAGE_U16 = 2 * 128 * LROW;

struct ALoadRow {
  const u16* A; int lda; U4 r0, r1, r2, r3;
  DI void fetch(int m0, int k0, int tid) {
    const u16* base = A + (size_t)(m0 + (tid >> 3)) * lda + k0 + (tid & 7) * 8;
    r0 = *(const U4*)(base);
    r1 = *(const U4*)(base + (size_t)32 * lda);
    r2 = *(const U4*)(base + (size_t)64 * lda);
    r3 = *(const U4*)(base + (size_t)96 * lda);
  }
  DI void commit(u16* sA, int tid) {
    u16* d = sA + (tid >> 3) * LROW + (tid & 7) * 8;
    *(U4*)(d) = r0; *(U4*)(d + 32 * LROW) = r1; *(U4*)(d + 64 * LROW) = r2; *(U4*)(d + 96 * LROW) = r3;
  }
};

struct ALoadMix {
  const u16* YT; const u16* YN; U4 r0, r1, r2, r3; bool tr;
  DI void fetch(int m0, int k0, int tid) {
    tr = (k0 < 512);
    if (tr) {
      int b, s; bs_of(m0, b, s);
      const u16* base = YT + ((size_t)(b * 512 + k0 + (tid >> 4))) * LT + s + (tid & 15) * 8;
      r0 = *(const U4*)(base);
      r1 = *(const U4*)(base + (size_t)16 * LT);
      r2 = *(const U4*)(base + (size_t)32 * LT);
      r3 = *(const U4*)(base + (size_t)48 * LT);
    } else {
      const u16* base = YN + (size_t)(m0 + (tid >> 3)) * 512 + (k0 - 512) + (tid & 7) * 8;
      r0 = *(const U4*)(base);
      r1 = *(const U4*)(base + (size_t)32 * 512);
      r2 = *(const U4*)(base + (size_t)64 * 512);
      r3 = *(const U4*)(base + (size_t)96 * 512);
    }
  }
  static DI void scat(u16* d, U4 q) {
    d[0 * LROW] = (u16)(q.x); d[1 * LROW] = (u16)(q.x >> 16);
    d[2 * LROW] = (u16)(q.y); d[3 * LROW] = (u16)(q.y >> 16);
    d[4 * LROW] = (u16)(q.z); d[5 * LROW] = (u16)(q.z >> 16);
    d[6 * LROW] = (u16)(q.w); d[7 * LROW] = (u16)(q.w >> 16);
  }
  DI void commit(u16* sA, int tid) {
    if (tr) {
      u16* d = sA + ((tid & 15) * 8) * LROW + (tid >> 4);
      scat(d, r0); scat(d + 16, r1); scat(d + 32, r2); scat(d + 48, r3);
    } else {
      u16* d = sA + (tid >> 3) * LROW + (tid & 7) * 8;
      *(U4*)(d) = r0; *(U4*)(d + 32 * LROW) = r1; *(U4*)(d + 64 * LROW) = r2; *(U4*)(d + 96 * LROW) = r3;
    }
  }
};

struct ALoadDFT {
  static DI U4 gen(int k, int kk) {
    int t0 = kk & 8191;
    int idx = k * t0 + (kk >= 8192 ? 2048 : 0);
    float v0 = __builtin_amdgcn_cosf((float)((idx) & 8191) * (1.f / 8192.f));
    float v1 = __builtin_amdgcn_cosf((float)((idx + k) & 8191) * (1.f / 8192.f));
    float v2 = __builtin_amdgcn_cosf((float)((idx + 2 * k) & 8191) * (1.f / 8192.f));
    float v3 = __builtin_amdgcn_cosf((float)((idx + 3 * k) & 8191) * (1.f / 8192.f));
    float v4 = __builtin_amdgcn_cosf((float)((idx + 4 * k) & 8191) * (1.f / 8192.f));
    float v5 = __builtin_amdgcn_cosf((float)((idx + 5 * k) & 8191) * (1.f / 8192.f));
    float v6 = __builtin_amdgcn_cosf((float)((idx + 6 * k) & 8191) * (1.f / 8192.f));
    float v7 = __builtin_amdgcn_cosf((float)((idx + 7 * k) & 8191) * (1.f / 8192.f));
    return mk4(pack2(v0, v1), pack2(v2, v3), pack2(v4, v5), pack2(v6, v7));
  }
  int k_, kk_;
  DI void fetch(int m0, int k0, int tid) { k_ = m0 + (tid >> 3); kk_ = k0 + (tid & 7) * 8; }
  DI void commit(u16* sA, int tid) {
    u16* d = sA + (tid >> 3) * LROW + (tid & 7) * 8;
    __builtin_amdgcn_sched_barrier(0);
    *(U4*)(d) = gen(k_, kk_);
    __builtin_amdgcn_sched_barrier(0);
    *(U4*)(d + 32 * LROW) = gen(k_ + 32, kk_);
    __builtin_amdgcn_sched_barrier(0);
    *(U4*)(d + 64 * LROW) = gen(k_ + 64, kk_);
    __builtin_amdgcn_sched_barrier(0);
    *(U4*)(d + 96 * LROW) = gen(k_ + 96, kk_);
    __builtin_amdgcn_sched_barrier(0);
  }
};

struct BLoadRow {
  const u16* B; int ldb; U4 r0, r1, r2, r3;
  DI void fetch(int n0, int k0, int tid) {
    const u16* base = B + (size_t)(n0 + (tid >> 3)) * ldb + k0 + (tid & 7) * 8;
    r0 = *(const U4*)(base);
    r1 = *(const U4*)(base + (size_t)32 * ldb);
    r2 = *(const U4*)(base + (size_t)64 * ldb);
    r3 = *(const U4*)(base + (size_t)96 * ldb);
  }
  DI void commit(u16* sB, int tid) {
    u16* d = sB + (tid >> 3) * LROW + (tid & 7) * 8;
    *(U4*)(d) = r0; *(U4*)(d + 32 * LROW) = r1; *(U4*)(d + 64 * LROW) = r2; *(U4*)(d + 96 * LROW) = r3;
  }
};

template <bool SWAP>
DI void gemm_compute(f32x4 (&acc)[4][4], const u16* sA, const u16* sB, int wm, int wn, int r16, int g) {
#pragma unroll
  for (int ks = 0; ks < 2; ++ks) {
    bf16x8 a[4], b[4];
#pragma unroll
    for (int i = 0; i < 4; ++i) a[i] = *(const bf16x8*)(sA + (wm * 64 + i * 16 + r16) * LROW + ks * 32 + g * 8);
#pragma unroll
    for (int j = 0; j < 4; ++j) b[j] = *(const bf16x8*)(sB + (wn * 64 + j * 16 + r16) * LROW + ks * 32 + g * 8);
#pragma unroll
    for (int i = 0; i < 4; ++i)
#pragma unroll
      for (int j = 0; j < 4; ++j) {
        if (SWAP) acc[i][j] = mfma16(b[j], a[i], acc[i][j]);
        else acc[i][j] = mfma16(a[i], b[j], acc[i][j]);
      }
  }
}

template <bool SWAP, class AL, class EP, int VAR = 0>
DI void gemm_tile(AL& al0, const u16* __restrict__ Bt, int ldb, int K, int m0, int n0, EP& ep, char* smem) {
  const int tid = tidx(), lane = tid & 63, w = tid >> 6, wm = w >> 1, wn = w & 1, r16 = lane & 15, g = lane >> 4;
  u16* sbase = (u16*)smem;
  f32x4 acc[4][4];
#pragma unroll
  for (int i = 0; i < 4; ++i)
#pragma unroll
    for (int j = 0; j < 4; ++j) acc[i][j] = f32x4{0.f, 0.f, 0.f, 0.f};
  AL al1 = al0;
  BLoadRow bl0, bl1; bl0.B = Bt; bl0.ldb = ldb; bl1.B = Bt; bl1.ldb = ldb;
  const int nk = K / BK;
  al0.fetch(m0, 0, tid); bl0.fetch(n0, 0, tid);
  al1.fetch(m0, BK, tid); bl1.fetch(n0, BK, tid);
  __syncthreads();
  al0.commit(sbase, tid); bl0.commit(sbase + 128 * LROW, tid);
  __syncthreads();
  u16* const sA0 = sbase; u16* const sB0 = sbase + 128 * LROW;
  u16* const sA1 = sbase + STAGE_U16; u16* const sB1 = sA1 + 128 * LROW;
  for (int kt = 0; kt < nk; kt += 2) {
    if (VAR != 1) { int k2 = (kt + 2 < nk ? kt + 2 : nk - 2) * BK; al0.fetch(m0, k2, tid); bl0.fetch(n0, k2, tid); }
    __builtin_amdgcn_sched_barrier(0);
    if (VAR != 2) gemm_compute<SWAP>(acc, sA0, sB0, wm, wn, r16, g);
    al1.commit(sA1, tid); bl1.commit(sB1, tid);
    __syncthreads();
    if (VAR != 1) { int k3 = (kt + 3 < nk ? kt + 3 : nk - 1) * BK; al1.fetch(m0, k3, tid); bl1.fetch(n0, k3, tid); }
    __builtin_amdgcn_sched_barrier(0);
    if (VAR != 2) gemm_compute<SWAP>(acc, sA1, sB1, wm, wn, r16, g);
    al0.commit(sA0, tid); bl0.commit(sB0, tid);
    __syncthreads();
  }
#pragma unroll
  for (int i = 0; i < 4; ++i)
#pragma unroll
    for (int j = 0; j < 4; ++j) {
      if (VAR == 3) { if (acc[i][j][0] == 1.2345f) ep.apply_t(m0, n0, acc[i][j]); }
      else if (SWAP) ep.apply_t(m0 + wm * 64 + i * 16 + r16, n0 + wn * 64 + j * 16 + g * 4, acc[i][j]);
      else ep.apply(m0 + wm * 64 + i * 16 + g * 4, n0 + wn * 64 + j * 16 + r16, acc[i][j]);
    }
}

struct LoadRowB {
  const u16* A; int lda; U4 r0, r1, r2, r3;
  DI void fetch(int m0, int k0, int tid) {
    const u16* base = A + (size_t)(m0 + (tid >> 3)) * lda + k0 + (tid & 7) * 8;
    r0 = *(const U4*)(base);
    r1 = *(const U4*)(base + (size_t)64 * lda);
    r2 = *(const U4*)(base + (size_t)128 * lda);
    r3 = *(const U4*)(base + (size_t)192 * lda);
  }
  DI void commit(u16* sA, int tid) {
    u16* d = sA + (tid >> 3) * LROW + (tid & 7) * 8;
    *(U4*)(d) = r0; *(U4*)(d + 64 * LROW) = r1; *(U4*)(d + 128 * LROW) = r2; *(U4*)(d + 192 * LROW) = r3;
  }
};
struct ALoadMixB {
  const u16* YT; const u16* YN; U4 r0, r1, r2, r3; bool tr;
  DI void fetch(int m0, int k0, int tid) {
    tr = (k0 < 512);
    if (tr) {
      int b, s; bs_of(m0, b, s);
      const u16* base = YT + ((size_t)(b * 512 + k0 + (tid >> 5))) * LT + s + (tid & 31) * 8;
      r0 = *(const U4*)(base);
      r1 = *(const U4*)(base + (size_t)16 * LT);
      r2 = *(const U4*)(base + (size_t)32 * LT);
      r3 = *(const U4*)(base + (size_t)48 * LT);
    } else {
      const u16* base = YN + (size_t)(m0 + (tid >> 3)) * 512 + (k0 - 512) + (tid & 7) * 8;
      r0 = *(const U4*)(base);
      r1 = *(const U4*)(base + (size_t)64 * 512);
      r2 = *(const U4*)(base + (size_t)128 * 512);
      r3 = *(const U4*)(base + (size_t)192 * 512);
    }
  }
  DI void commit(u16* sA, int tid) {
    if (tr) {
      u16* d = sA + ((tid & 31) * 8) * LROW + (tid >> 5);
      ALoadMix::scat(d, r0); ALoadMix::scat(d + 16, r1); ALoadMix::scat(d + 32, r2); ALoadMix::scat(d + 48, r3);
    } else {
      u16* d = sA + (tid >> 3) * LROW + (tid & 7) * 8;
      *(U4*)(d) = r0; *(U4*)(d + 64 * LROW) = r1; *(U4*)(d + 128 * LROW) = r2; *(U4*)(d + 192 * LROW) = r3;
    }
  }
};

template <bool SWAP, class AL, class EP>
DI void gemm_big(AL& al, const u16* __restrict__ Bt, int ldb, int K, int m0, int n0, EP& ep, char* smem_all) {
  const int tid = tid512(), lane = tid & 63, w = tid >> 6, wm = w >> 2, wn = w & 3, r16 = lane & 15, g = lane >> 4;
  u16* sbase = (u16*)smem_all;
  constexpr int STG = 2 * 256 * LROW;
  f32x4 acc[8][4];
#pragma unroll
  for (int i = 0; i < 8; ++i)
#pragma unroll
    for (int j = 0; j < 4; ++j) acc[i][j] = f32x4{0.f, 0.f, 0.f, 0.f};
  LoadRowB bl; bl.A = Bt; bl.lda = ldb;
  const int nk = K / BK;
  al.fetch(m0, 0, tid); bl.fetch(n0, 0, tid);
  __syncthreads();
  al.commit(sbase, tid); bl.commit(sbase + 256 * LROW, tid);
  __syncthreads();
  for (int kt = 0; kt < nk; ++kt) {
    const u16* sA = sbase + (kt & 1) * STG;
    const u16* sB = sA + 256 * LROW;
    { int kn = (kt + 1 < nk ? kt + 1 : kt) * BK; al.fetch(m0, kn, tid); bl.fetch(n0, kn, tid); }
    __builtin_amdgcn_sched_barrier(0);
#pragma unroll
    for (int ks = 0; ks < 2; ++ks) {
      bf16x8 b[4];
#pragma unroll
      for (int j = 0; j < 4; ++j) b[j] = *(const bf16x8*)(sB + (wn * 64 + j * 16 + r16) * LROW + ks * 32 + g * 8);
#pragma unroll
      for (int ih = 0; ih < 2; ++ih) {
        bf16x8 a[4];
#pragma unroll
        for (int i = 0; i < 4; ++i) a[i] = *(const bf16x8*)(sA + (wm * 128 + (ih * 4 + i) * 16 + r16) * LROW + ks * 32 + g * 8);
#pragma unroll
        for (int i = 0; i < 4; ++i)
#pragma unroll
          for (int j = 0; j < 4; ++j) {
            if (SWAP) acc[ih * 4 + i][j] = mfma16(b[j], a[i], acc[ih * 4 + i][j]);
            else acc[ih * 4 + i][j] = mfma16(a[i], b[j], acc[ih * 4 + i][j]);
          }
        __builtin_amdgcn_sched_barrier(0);
      }
    }
    u16* nA = sbase + ((kt + 1) & 1) * STG;
    al.commit(nA, tid); bl.commit(nA + 256 * LROW, tid);
    __syncthreads();
  }
#pragma unroll
  for (int i = 0; i < 8; ++i)
#pragma unroll
    for (int j = 0; j < 4; ++j) {
      if (SWAP) ep.apply_t(m0 + wm * 128 + i * 16 + r16, n0 + wn * 64 + j * 16 + g * 4, acc[i][j]);
      else ep.apply(m0 + wm * 128 + i * 16 + g * 4, n0 + wn * 64 + j * 16 + r16, acc[i][j]);
    }
}

struct EpWin0 {
  u16 *uhyT, *uqk, *vT;
  DI void apply_t(int m, int nb, f32x4 v) { *(U2*)(uqk + (size_t)m * 1024 + (nb - 1536)) = mk2(pack2(v[0], v[1]), pack2(v[2], v[3])); }
  DI void apply(int mb, int n, f32x4 v) {
    int b, s; bs_of(mb, b, s);
    if (n < 1536) {
      U2 o = mk2(pack2(v[0], v[1]), pack2(v[2], v[3]));
      *(U2*)(uhyT + ((size_t)(b * 1536 + n)) * LT + s) = o;
    } else if (n < 2560) {
#pragma unroll
      for (int r = 0; r < 4; ++r) uqk[(size_t)(mb + r) * 1024 + (n - 1536)] = f2bf(v[r]);
    } else {
      U2 o = mk2(pack2(v[0], v[1]), pack2(v[2], v[3]));
      *(U2*)(vT + ((size_t)(b * 512 + (n - 2560))) * LT + s) = o;
    }
  }
};
struct EpResid {
  const float* xlat; const float* xctx; float* S; const float* mod; int goff;
  DI void apply_t(int m, int nb, f32x4 v) {
    F4 gt = *(const F4*)(mod + (size_t)bidx_of(m) * 6144 + goff + nb);
    const float* xp = (m < NLAT) ? xlat + (size_t)m * 1024 + nb : xctx + (size_t)(m - NLAT) * 1024 + nb;
    F4 xi = *(const F4*)xp;
    *(F4*)(S + (size_t)m * 1024 + nb) = mkf4(ALPHA * xi.x + gt.x * v[0], ALPHA * xi.y + gt.y * v[1], ALPHA * xi.z + gt.z * v[2], ALPHA * xi.w + gt.w * v[3]);
  }
  DI void apply(int mb, int n, f32x4 v) {
    float gt = mod[(size_t)bidx_of(mb) * 6144 + goff + n];
#pragma unroll
    for (int r = 0; r < 4; ++r) {
      int m = mb + r;
      float xi = (m < NLAT) ? xlat[(size_t)m * 1024 + n] : xctx[(size_t)(m - NLAT) * 1024 + n];
      S[(size_t)m * 1024 + n] = ALPHA * xi + gt * v[r];
    }
  }
};
struct EpRelu2 {
  u16* a1;
  DI void apply_t(int m, int nb, f32x4 v) {
    float t0 = fmaxf(v[0], 0.f), t1 = fmaxf(v[1], 0.f), t2 = fmaxf(v[2], 0.f), t3 = fmaxf(v[3], 0.f);
    *(U2*)(a1 + (size_t)m * 4096 + nb) = mk2(pack2(t0 * t0, t1 * t1), pack2(t2 * t2, t3 * t3));
  }
  DI void apply(int mb, int n, f32x4 v) {
#pragma unroll
    for (int r = 0; r < 4; ++r) { float t = fmaxf(v[r], 0.f); a1[(size_t)(mb + r) * 4096 + n] = f2bf(t * t); }
  }
};
struct EpPlain {
  u16* dst; int ld;
  DI void apply_t(int m, int nb, f32x4 v) { *(U2*)(dst + (size_t)m * ld + nb) = mk2(pack2(v[0], v[1]), pack2(v[2], v[3])); }
  DI void apply(int mb, int n, f32x4 v) {
#pragma unroll
    for (int r = 0; r < 4; ++r) dst[(size_t)(mb + r) * ld + n] = f2bf(v[r]);
  }
};
struct EpQ {
  u16* q; const float* srow; int m0;
  DI void apply_t(int m, int nb, f32x4 v) {
    int hc = nb % 96;
    float sr = srow[m - m0];
    float val[4], par[4];
#pragma unroll
    for (int r = 0; r < 4; ++r) { val[r] = v[r] * sr; par[r] = __shfl_xor(val[r], 32); }
    if (hc >= 64) {
      int i0 = hc - 64, axis = i0 >> 4, second = (i0 >> 3) & 1;
      int s = m & 8191;
      float pos = (float)(axis ? (s & 63) : (s >> 6));
#pragma unroll
      for (int r = 0; r < 4; ++r) {
        int idx = (i0 + r) & 7;
        float inv = exp2f(-(float)idx * (13.287712379549449f / 8.f));
        float rv = pos * inv * 0.15915494309189535f; float sn = __builtin_amdgcn_sinf(rv), cs = __builtin_amdgcn_cosf(rv);
        val[r] = second ? (val[r] * cs + par[r] * sn) : (val[r] * cs - par[r] * sn);
      }
    }
    const float qs = 0.10206207261596575f * LOG2E;
    *(U2*)(q + (size_t)m * 768 + nb) = mk2(pack2(val[0] * qs, val[1] * qs), pack2(val[2] * qs, val[3] * qs));
  }
  DI void apply(int mb, int n, f32x4 v) {
    int hc = n % 96;
    float val[4], par[4];
#pragma unroll
    for (int r = 0; r < 4; ++r) { val[r] = v[r] * srow[mb - m0 + r]; par[r] = __shfl_xor(val[r], 8); }
    if (hc >= 64) {
      int i = hc - 64, axis = i >> 4, second = (i >> 3) & 1, idx = i & 7;
      float inv = exp2f(-(float)idx * (13.287712379549449f / 8.f));
#pragma unroll
      for (int r = 0; r < 4; ++r) {
        int s = (mb + r) & 8191;
        float pos = (float)(axis ? (s & 63) : (s >> 6));
        float rv = pos * inv * 0.15915494309189535f; float sn = __builtin_amdgcn_sinf(rv), cs = __builtin_amdgcn_cosf(rv);
        val[r] = second ? (val[r] * cs + par[r] * sn) : (val[r] * cs - par[r] * sn);
      }
    }
    const float qs = 0.10206207261596575f * LOG2E;
#pragma unroll
    for (int r = 0; r < 4; ++r) q[(size_t)(mb + r) * 768 + n] = f2bf(val[r] * qs);
  }
};
struct EpKV {
  u16 *kb, *vT; const float* srow; int m0;
  DI void apply_t(int, int, f32x4) {}
  DI void apply(int mb, int n, f32x4 v) {
    int hh = n / 160, cc = n % 160;
    int b, s; bs_of(mb, b, s);
    float val[4];
#pragma unroll
    for (int r = 0; r < 4; ++r) val[r] = v[r] * srow[mb - m0 + r];
    if (cc < 64) {
#pragma unroll
      for (int r = 0; r < 4; ++r) kb[((size_t)(b * 8 + hh) * LT + s + r) * 96 + cc] = f2bf(val[r]);
    } else {
      U2 o = mk2(pack2(val[0], val[1]), pack2(val[2], val[3]));
      *(U2*)(vT + ((size_t)((b * 8 + hh) * 96 + (cc - 64))) * LT + s) = o;
    }
  }
};
struct EpFnet {
  u16* y1;
  DI void apply_t(int m, int nb, f32x4 v) {
    int b = nb >> 8, ch = nb & 255;
    const float sc = 0.0013810679320049757f;
    *(U2*)(y1 + ((size_t)(b * 8192 + m)) * 1024 + 768 + ch) = mk2(pack2(v[0] * sc, v[1] * sc), pack2(v[2] * sc, v[3] * sc));
  }
  DI void apply(int mb, int n, f32x4 v) {
    int b = n >> 8, ch = n & 255;
    const float sc = 0.0013810679320049757f;
#pragma unroll
    for (int r = 0; r < 4; ++r) y1[((size_t)(b * 8192 + mb + r)) * 1024 + 768 + ch] = f2bf(v[r] * sc);
  }
};

DI void rms_rows(const u16* A, int lda, int K, int m0, float* srow) {
  int tid = tidx(), row = tid >> 1, half = tid & 1;
  const u16* a = A + (size_t)(m0 + row) * lda + half * (K / 2);
  float ss = 0.f;
  for (int k = 0; k < K / 2; k += 8) {
    U4 q = *(const U4*)(a + k);
    u32 w[4] = {q.x, q.y, q.z, q.w};
#pragma unroll
    for (int e = 0; e < 4; ++e) { float lo = __uint_as_float(w[e] << 16), hi = __uint_as_float(w[e] & 0xffff0000u); ss += lo * lo + hi * hi; }
  }
  ss += __shfl_xor(ss, 1);
  if (half == 0) srow[row] = rsqrtf(ss / (float)K + LN_EPS);
}

DI void tr_tile(const float* src, int K, int N, int Nvalid, u16* dst, const float* gk, int tile, char* smem) {
  float* t = (float*)smem;
  int ntn = N / 64, kt = tile / ntn, nt = tile % ntn, k0 = kt * 64, n0 = nt * 64, tid = tidx();
#pragma unroll
  for (int ps = 0; ps < 4; ++ps) {
    int i = ps * 16 + (tid >> 4), j = (tid & 15) * 4;
    F4 v = mkf4(0.f, 0.f, 0.f, 0.f);
    if (n0 + j < Nvalid) v = *(const F4*)(src + (size_t)(k0 + i) * Nvalid + n0 + j);
    float sc = gk ? gk[k0 + i] : 1.f;
    t[i * 65 + j] = v.x * sc; t[i * 65 + j + 1] = v.y * sc; t[i * 65 + j + 2] = v.z * sc; t[i * 65 + j + 3] = v.w * sc;
  }
  __syncthreads();
  int n = tid >> 2, kc = (tid & 3) * 16;
  u32 o[8];
#pragma unroll
  for (int e = 0; e < 8; ++e) o[e] = pack2(t[(kc + 2 * e) * 65 + n], t[(kc + 2 * e + 1) * 65 + n]);
  U4* d = (U4*)(dst + (size_t)(n0 + n) * K + k0 + kc);
  d[0] = mk4(o[0], o[1], o[2], o[3]);
  d[1] = mk4(o[4], o[5], o[6], o[7]);
}

DI void mod_item(const Params& p, int it, char* smem) {
  float* sc = (float*)smem;
  int l = it / 24, chunk = it % 24, tid = tidx();
  for (int e = tid; e < 5 * 1024; e += 256) {
    int r = e >> 10, k = e & 1023;
    float v = r < 4 ? p.c[r * 1024 + k] : p.c_ctx[k];
    sc[e] = v / (1.f + __expf(-v));
  }
  __syncthreads();
  int n = chunk * 256 + tid;
  const float* W = p.mod_w + (size_t)l * 1024 * 6144 + n;
  float a0 = 0, a1 = 0, a2 = 0, a3 = 0, a4 = 0;
#pragma unroll 8
  for (int k = 0; k < 1024; ++k) {
    float wv = W[(size_t)k * 6144];
    a0 += sc[k] * wv; a1 += sc[1024 + k] * wv; a2 += sc[2048 + k] * wv; a3 += sc[3072 + k] * wv; a4 += sc[4096 + k] * wv;
  }
  float bv = p.mod_b[l * 6144 + n];
  float* o = (float*)(wsp(p) + O_MOD) + (size_t)l * 5 * 6144 + n;
  o[0] = a0 + bv; o[6144] = a1 + bv; o[2 * 6144] = a2 + bv; o[3 * 6144] = a3 + bv; o[4 * 6144] = a4 + bv;
}

DI void filt_item(const Params& p, char* smem, int Lf, int p0, u16* Tg) {
  const int TgLen = 2 * Lf, tid = tidx();
  float* zf = (float*)smem;
  float* h1 = zf + 32 * 33;
  float* h2 = h1 + 32 * 64;
  u16* st = (u16*)(h2 + 32 * 64);
  for (int e = tid; e < 32 * 33; e += 256) {
    int pos = e / 33, f = e % 33; float pp = (float)(p0 + pos);
    float t = pp / (float)(Lf - 1), wv = 6.283185307179586f * pp / (float)Lf, val;
    if (f == 0) val = t;
    else {
      int fi = (f - 1) & 15;
      float fr = 1e-4f + (float)fi * ((15.f - 1e-4f) / 15.f);
      val = (f <= 16) ? cosf(wv * fr) : -sinf(wv * fr);
    }
    zf[e] = val;
  }
  __syncthreads();
  {
    int pos = tid >> 3, u0 = (tid & 7) * 8;
#pragma unroll 1
    for (int uu = 0; uu < 8; ++uu) {
      int u = u0 + uu; float s = p.hy_b1[u];
#pragma unroll 1
      for (int f = 0; f < 33; ++f) s += zf[pos * 33 + f] * p.hy_w1[f * 64 + u];
      h1[pos * 64 + u] = sinf(p.hy_freq[u] * s);
    }
  }
  __syncthreads();
  {
    int pos = tid >> 3, u0 = (tid & 7) * 8;
#pragma unroll 1
    for (int uu = 0; uu < 8; ++uu) {
      int u = u0 + uu; float s = p.hy_b2[u];
#pragma unroll 1
      for (int f = 0; f < 64; ++f) s += h1[pos * 64 + f] * p.hy_w2[f * 64 + u];
      h2[pos * 64 + u] = sinf(p.hy_freq[u] * s);
    }
  }
  __syncthreads();
#pragma unroll 1
  for (int cc = 0; cc < 8; ++cc) {
    int col = cc * 256 + tid;
    float w3r[64];
#pragma unroll
    for (int u = 0; u < 64; ++u) w3r[u] = p.hy_w3[u * 2048 + col];
    float ld = __expf(p.hy_log_decay[col]);
    int conv = col >> 10, dir = (col >> 9) & 1, c = col & 511;
    float skipv = p.hy_skip[conv * 512 + c];
#pragma unroll 1
    for (int pos = 0; pos < 32; ++pos) {
      float a = 0.f;
#pragma unroll
      for (int u = 0; u < 64; ++u) a += h2[pos * 64 + u] * w3r[u];
      int pp = p0 + pos;
      float t = (float)pp / (float)(Lf - 1);
      float val = a * __expf(-t * ld);
      if (pp == 0) val = (dir == 0) ? (val + skipv) : 0.f;
      st[pos * 256 + tid] = f2bf(val);
    }
    __syncthreads();
#pragma unroll 1
    for (int k = 0; k < 32; ++k) {
      int cl = (tid >> 5) + 8 * k, pos = tid & 31, colw = cc * 256 + cl, pp = p0 + pos;
      int conv2 = colw >> 10, dir2 = (colw >> 9) & 1, c2 = colw & 511;
      u16 v = st[pos * 256 + cl];
      u16* dstp = Tg + (size_t)(conv2 * 512 + c2) * TgLen;
      if (dir2 == 0) dstp[Lf - pp] = v;
      else if (pp > 0) dstp[Lf + pp] = v;
      else dstp[0] = 0;
    }
    __syncthreads();
  }
}

constexpr int NT_TR = 768 + 256 + 1024 + 1024 + 1024 + 1024 + 256 + 256 + 72 + 80;
constexpr int N_PREP = NT_TR + 48 + 256 + 8;

DI void phase_prep(const Params& p, char* smem) {
  char* ws = wsp(p);
  for (int it = bidx(); it < N_PREP; it += NVB) {
    __syncthreads();
    int t = it;
    if (t < NT_TR) {
      const float* src; int K, N, Nv; u16* dst; const float* gk = nullptr;
      if (t < 768) { src = p.ab_w_in; K = 1024; N = 3072; Nv = 3072; dst = (u16*)(ws + O_WT_ABIN); }
      else if ((t -= 768) < 256) { src = p.ab_w_out; K = 1024; N = 1024; Nv = 1024; dst = (u16*)(ws + O_WT_ABOUT); }
      else if ((t -= 256) < 2048) { int l = t >> 10; t &= 1023; src = p.mlp_w1 + (size_t)l * 1024 * 4096; K = 1024; N = 4096; Nv = 4096; dst = (u16*)(ws + O_WT_W1) + (size_t)l * 4096 * 1024; }
      else if ((t -= 2048) < 2048) { int l = t >> 10; t &= 1023; src = p.mlp_w2 + (size_t)l * 1024 * 4096; K = 4096; N = 1024; Nv = 1024; dst = (u16*)(ws + O_WT_W2) + (size_t)l * 4096 * 1024; }
      else if ((t -= 2048) < 256) { src = p.cd_w_in; K = 1024; N = 1024; Nv = 928; dst = (u16*)(ws + O_WT_CDIN); }
      else if ((t -= 256) < 256) { src = p.cd_w_out; K = 1024; N = 1024; Nv = 1024; dst = (u16*)(ws + O_WT_CDOUT); }
      else if ((t -= 256) < 72) { src = p.mla_w_uq; K = 384; N = 768; Nv = 768; dst = (u16*)(ws + O_WT_UQ); gk = p.mla_q_norm; }
      else { t -= 72; src = p.mla_w_ukv; K = 256; N = 1280; Nv = 1280; dst = (u16*)(ws + O_WT_UKV); gk = p.mla_kv_norm; }
      tr_tile(src, K, N, Nv, dst, gk, t, smem);
      continue;
    }
    t -= NT_TR;
    if (t < 48) { mod_item(p, t, smem); continue; }
    t -= 48;
    int Lf = SEQL; u16* Tg = (u16*)(ws + O_TLAT);
    if (t >= 256) { t -= 256; Lf = LC; Tg = (u16*)(ws + O_TCTX); }
    filt_item(p, smem, Lf, t * 32, Tg);
  }
}

template <bool FROM_IN, bool AFFINE, bool MOD>
DI void phase_ln(const Params& p, int nrows, const float* g, const float* bb, float* dst, bool dst_is_S, int lmod, int shoff,
                 int scoff) {
  const int lane = tidx() & 63, wv = tidx() >> 6;
  const int gw = bidx() * 4 + wv, nw = NVB * 4;
  float* S = (float*)(wsp(p) + O_S);
  u16* hbuf = (u16*)(wsp(p) + O_HBUF);
  for (int m = gw; m < nrows; m += nw) {
    const float* src;
    if (FROM_IN) src = (m < NLAT) ? p.x + (size_t)m * 1024 : p.ctx + (size_t)(m - NLAT) * 1024;
    else src = S + (size_t)m * 1024;
    float v[16];
#pragma unroll
    for (int i = 0; i < 4; ++i) {
      F4 q = *(const F4*)(src + i * 256 + lane * 4);
      v[4 * i] = q.x; v[4 * i + 1] = q.y; v[4 * i + 2] = q.z; v[4 * i + 3] = q.w;
    }
    if (AFFINE) {
      float s = 0.f;
#pragma unroll
      for (int i = 0; i < 16; ++i) s += v[i];
      float mu = wave_sum(s) * (1.f / 1024.f);
      float q2 = 0.f;
#pragma unroll
      for (int i = 0; i < 16; ++i) { float d = v[i] - mu; q2 += d * d; }
      float rstd = rsqrtf(wave_sum(q2) * (1.f / 1024.f) + LN_EPS);
      float* drow = dst_is_S ? (S + (size_t)m * 1024) : (dst + (size_t)m * 1024);
#pragma unroll
      for (int i = 0; i < 4; ++i) {
        int e = i * 256 + lane * 4;
        F4 gg = *(const F4*)(g + e), b4 = *(const F4*)(bb + e);
        v[4 * i] = (v[4 * i] - mu) * rstd * gg.x + b4.x;
        v[4 * i + 1] = (v[4 * i + 1] - mu) * rstd * gg.y + b4.y;
        v[4 * i + 2] = (v[4 * i + 2] - mu) * rstd * gg.z + b4.z;
        v[4 * i + 3] = (v[4 * i + 3] - mu) * rstd * gg.w + b4.w;
        *(F4*)(drow + e) = mkf4(v[4 * i], v[4 * i + 1], v[4 * i + 2], v[4 * i + 3]);
      }
    }
    if (MOD) {
      float s = 0.f;
#pragma unroll
      for (int i = 0; i < 16; ++i) s += v[i];
      float mu = wave_sum(s) * (1.f / 1024.f);
      float q2 = 0.f;
#pragma unroll
      for (int i = 0; i < 16; ++i) { float d = v[i] - mu; q2 += d * d; }
      float rstd = rsqrtf(wave_sum(q2) * (1.f / 1024.f) + LN_EPS);
      const float* md = modp(p, lmod, bidx_of(m));
#pragma unroll
      for (int i = 0; i < 4; ++i) {
        int e = i * 256 + lane * 4;
        F4 sh = *(const F4*)(md + shoff + e), sc = *(const F4*)(md + scoff + e);
        float o0 = (v[4 * i] - mu) * rstd * (1.f + sc.x) + sh.x;
        float o1 = (v[4 * i + 1] - mu) * rstd * (1.f + sc.y) + sh.y;
        float o2 = (v[4 * i + 2] - mu) * rstd * (1.f + sc.z) + sh.z;
        float o3 = (v[4 * i + 3] - mu) * rstd * (1.f + sc.w) + sh.w;
        *(U2*)(hbuf + (size_t)m * 1024 + e) = mk2(pack2(o0, o1), pack2(o2, o3));
      }
    }
  }
}

DI bf16x8 toep_frag(const u32* Tr32, int o) {
  int wd = o >> 1; u32 sh = (o & 1) * 16;
  u32 d0 = Tr32[wd], d1 = Tr32[wd + 1], d2 = Tr32[wd + 2], d3 = Tr32[wd + 3], d4 = Tr32[wd + 4];
  U4 q = mk4(__builtin_amdgcn_alignbit(d1, d0, sh), __builtin_amdgcn_alignbit(d2, d1, sh),
                       __builtin_amdgcn_alignbit(d3, d2, sh), __builtin_amdgcn_alignbit(d4, d3, sh));
  return __builtin_bit_cast(bf16x8, q);
}

DI void toep_item(const Params& p, char* smem, int cv, int c, int bp) {
  const int tid = tidx(), lane = tid & 63, w = tid >> 6, r16 = lane & 15, g = lane >> 4;
  u16* Tr = (u16*)smem;
  u16* Zs = Tr + 16384 + 16;
  const u16* uhyT = (const u16*)(wsp(p) + O_UHYT);
  u16* zT = (u16*)(wsp(p) + O_ZT);
  u16* yhyT = (u16*)(wsp(p) + O_YHYT);
  {
    const U4* Tg = (const U4*)((const u16*)(wsp(p) + O_TLAT) + (size_t)(cv * 512 + c) * 16384);
    for (int e = tid; e < 2048; e += 256) ((U4*)Tr)[e] = Tg[e];
    if (tid < 2) ((U4*)Tr)[2048 + tid] = mk4(0, 0, 0, 0);
  }
  for (int bb = 0; bb < 2; ++bb) {
    int b = 2 * bp + bb;
    if (cv == 0) {
      const u16* src = uhyT + ((size_t)(b * 1536 + 1024 + c)) * LT;
      float w0 = p.hy_conv_w[1024 + c], w1 = p.hy_conv_w[1536 + 1024 + c], w2 = p.hy_conv_w[2 * 1536 + 1024 + c];
      for (int e = tid; e < 1024; e += 256) {
        int s0 = e * 8;
        U4 q = *(const U4*)(src + s0);
        float u[10];
        u[0] = s0 > 0 ? bf2f(src[s0 - 1]) : 0.f;
        u[9] = s0 + 8 < SEQL ? bf2f(src[s0 + 8]) : 0.f;
        u32 ww[4] = {q.x, q.y, q.z, q.w};
#pragma unroll
        for (int k = 0; k < 4; ++k) { u[1 + 2 * k] = __uint_as_float(ww[k] << 16); u[2 + 2 * k] = __uint_as_float(ww[k] & 0xffff0000u); }
        float o[8];
#pragma unroll
        for (int k = 0; k < 8; ++k) o[k] = w0 * u[k] + w1 * u[k + 1] + w2 * u[k + 2];
        *(U4*)(Zs + bb * 8192 + s0) = mk4(pack2(o[0], o[1]), pack2(o[2], o[3]), pack2(o[4], o[5]), pack2(o[6], o[7]));
      }
    } else {
      const U4* src = (const U4*)(zT + ((size_t)(b * 512 + c)) * LT);
      for (int e = tid; e < 1024; e += 256) ((U4*)(Zs + bb * 8192))[e] = src[e];
    }
  }
  __syncthreads();
  const int bb = w >> 1, hw = w & 1;
  const u16* Zb = Zs + bb * 8192;
  const u32* Tr32 = (const u32*)Tr;
  f32x4 acc[4][4];
#pragma unroll
  for (int i = 0; i < 4; ++i)
#pragma unroll
    for (int j = 0; j < 4; ++j) acc[i][j] = f32x4{0.f, 0.f, 0.f, 0.f};
  const int obase = 8192 - r16 + 8 * g;
  for (int dl = -127; dl <= 127; ++dl) {
    int lo = dl > 0 ? dl : 0, hi = dl < 0 ? 127 + dl : 127;
    if (hi < 64 * hw || lo > 64 * hw + 63) continue;
    bf16x8 F[6];
#pragma unroll
    for (int e = 0; e < 6; ++e) F[e] = toep_frag(Tr32, obase - 16 * (4 * dl - 2 + e));
#pragma unroll
    for (int nt = 0; nt < 4; ++nt) {
      int t1lo = 64 * hw + 16 * nt;
      if (t1lo + 15 < lo || t1lo > hi) continue;
      int s1 = t1lo + r16 - dl;
      bool ok = (s1 >= 0) && (s1 < 128);
      int s1c = ok ? s1 : 0;
#pragma unroll
      for (int ks = 0; ks < 2; ++ks) {
        U4 q = *(const U4*)(Zb + 64 * s1c + 32 * ks + 8 * g);
        if (!ok) q = mk4(0, 0, 0, 0);
        bf16x8 bfr = __builtin_bit_cast(bf16x8, q);
#pragma unroll
        for (int mt = 0; mt < 4; ++mt) acc[mt][nt] = mfma16(F[mt - 2 * ks + 2], bfr, acc[mt][nt]);
      }
    }
  }
  {
    int b = 2 * bp + bb, choff = (cv == 0) ? 0 : 512;
    const u16* xr = uhyT + ((size_t)(b * 1536 + choff + c)) * LT;
    float w0 = p.hy_conv_w[choff + c], w1 = p.hy_conv_w[1536 + choff + c], w2 = p.hy_conv_w[2 * 1536 + choff + c];
    u16* dst = (cv == 0 ? zT : yhyT) + ((size_t)(b * 512 + c)) * LT;
#pragma unroll
    for (int mt = 0; mt < 4; ++mt)
#pragma unroll
      for (int nt = 0; nt < 4; ++nt) {
        int t = 64 * (64 * hw + 16 * nt + r16) + 16 * mt + 4 * g;
        U2 q = *(const U2*)(xr + t);
        float u[6];
        u[0] = t > 0 ? bf2f(xr[t - 1]) : 0.f;
        u[5] = t + 4 < SEQL ? bf2f(xr[t + 4]) : 0.f;
        u[1] = __uint_as_float(q.x << 16); u[2] = __uint_as_float(q.x & 0xffff0000u);
        u[3] = __uint_as_float(q.y << 16); u[4] = __uint_as_float(q.y & 0xffff0000u);
        float o[4];
#pragma unroll
        for (int r = 0; r < 4; ++r) o[r] = (w0 * u[r] + w1 * u[r + 1] + w2 * u[r + 2]) * acc[mt][nt][r];
        *(U2*)(dst + t) = mk2(pack2(o[0], o[1]), pack2(o[2], o[3]));
      }
  }
}

DI void toep_ctx_item(const Params& p, char* smem, int cv, int c) {
  const int tid = tidx();
  float* Tf = (float*)smem;
  float* zf = Tf + 512;
  const u16* uhyT = (const u16*)(wsp(p) + O_UHYT);
  u16* zT = (u16*)(wsp(p) + O_ZT);
  u16* yhyT = (u16*)(wsp(p) + O_YHYT);
  const u16* Tg = (const u16*)(wsp(p) + O_TCTX) + (size_t)(cv * 512 + c) * 512;
  Tf[tid] = bf2f(Tg[tid]); Tf[tid + 256] = bf2f(Tg[tid + 256]);
  if (tid == 0) Tf[0] = 0.f;
  for (int b = 0; b < 4; ++b) {
    float zv;
    if (cv == 0) {
      const u16* src = uhyT + ((size_t)(b * 1536 + 1024 + c)) * LT + SEQL;
      float w0 = p.hy_conv_w[1024 + c], w1 = p.hy_conv_w[1536 + 1024 + c], w2 = p.hy_conv_w[2 * 1536 + 1024 + c];
      float um = tid > 0 ? bf2f(src[tid - 1]) : 0.f, u0 = bf2f(src[tid]), up = tid < 255 ? bf2f(src[tid + 1]) : 0.f;
      zv = bf2f(f2bf(w0 * um + w1 * u0 + w2 * up));
    } else {
      zv = bf2f(zT[((size_t)(b * 512 + c)) * LT + SEQL + tid]);
    }
    zf[b * 256 + tid] = zv;
  }
  __syncthreads();
  int choff = (cv == 0) ? 0 : 512;
  float w0 = p.hy_conv_w[choff + c], w1 = p.hy_conv_w[1536 + choff + c], w2 = p.hy_conv_w[2 * 1536 + choff + c];
  for (int b = 0; b < 4; ++b) {
    float y = 0.f;
    for (int s = 0; s < 256; ++s) y += Tf[256 - (tid - s)] * zf[b * 256 + s];
    const u16* xr = uhyT + ((size_t)(b * 1536 + choff + c)) * LT + SEQL;
    float um = tid > 0 ? bf2f(xr[tid - 1]) : 0.f, u0 = bf2f(xr[tid]), up = tid < 255 ? bf2f(xr[tid + 1]) : 0.f;
    float o = (w0 * um + w1 * u0 + w2 * up) * y;
    u16* dst = (cv == 0 ? zT : yhyT) + ((size_t)(b * 512 + c)) * LT + SEQL;
    dst[tid] = f2bf(o);
  }
}

DI void natten_wave(const Params& p, u16* Pw, int b, int h, bool lat, int r, int j, int qt) {
  const int lane = tidx() & 63, r16 = lane & 15, g = lane >> 4;
  const u16* uqk = (const u16*)(wsp(p) + O_UQK);
  const u16* vT = (const u16*)(wsp(p) + O_VT0);
  u16* yna = (u16*)(wsp(p) + O_YNA);
  const int qm0 = lat ? b * 8192 + r * 64 + 16 * j : NLAT + b * 256 + 16 * qt;
  bf16x8 qa[2];
#pragma unroll
  for (int ks = 0; ks < 2; ++ks) qa[ks] = *(const bf16x8*)(uqk + (size_t)(qm0 + r16) * 1024 + h * 64 + 32 * ks + 8 * g);
  int rs = r - 4; rs = rs < 0 ? 0 : (rs > 120 ? 120 : rs);
  int kb = 16 * j - 8; kb = kb < 0 ? 0 : (kb > 32 ? 32 : kb);
  f32x4 S[32];
  const float NEG = -1e30f;
  const float* rpb = p.na_rpb + h * 15 * 31;
#pragma unroll
  for (int nt = 0; nt < 32; ++nt) {
    if (nt < 16 && !lat) { S[nt] = f32x4{NEG, NEG, NEG, NEG}; continue; }
    if ((nt & 3) == 0) __builtin_amdgcn_sched_barrier(0);
    int keytok;
    if (nt < 16) keytok = b * 8192 + (rs + (nt >> 1)) * 64 + kb + 16 * (nt & 1) + r16;
    else keytok = NLAT + b * 256 + 16 * (nt - 16) + r16;
    const u16* kp = uqk + (size_t)keytok * 1024 + 512 + h * 64 + 8 * g;
    f32x4 a = f32x4{0.f, 0.f, 0.f, 0.f};
    a = mfma16(qa[0], *(const bf16x8*)(kp), a);
    a = mfma16(qa[1], *(const bf16x8*)(kp + 32), a);
    if (nt < 16) {
      int rr = nt >> 1, kcol = kb + 16 * (nt & 1) + r16, dr = rs + rr - r + 7;
#pragma unroll
      for (int q = 0; q < 4; ++q) {
        int qcol = 16 * j + 4 * g + q;
        int cs = qcol - 8; cs = cs < 0 ? 0 : (cs > 48 ? 48 : cs);
        bool valid = (kcol >= cs) && (kcol < cs + 16);
        int dc = kcol - qcol + 15; dc = dc < 0 ? 0 : (dc > 30 ? 30 : dc);
        float bias = rpb[dr * 31 + dc];
        a[q] = valid ? (a[q] * 0.125f + bias) * LOG2E : NEG;
      }
    } else {
#pragma unroll
      for (int q = 0; q < 4; ++q) a[q] = a[q] * (0.125f * LOG2E);
    }
    S[nt] = a;
  }
  float mx[4], sm[4];
#pragma unroll
  for (int q = 0; q < 4; ++q) {
    float m = NEG;
#pragma unroll
    for (int nt = 0; nt < 32; ++nt) m = fmaxf(m, S[nt][q]);
    m = fmaxf(m, __shfl_xor(m, 1)); m = fmaxf(m, __shfl_xor(m, 2)); m = fmaxf(m, __shfl_xor(m, 4)); m = fmaxf(m, __shfl_xor(m, 8));
    mx[q] = m; sm[q] = 0.f;
  }
#pragma unroll
  for (int nt = 0; nt < 32; ++nt) {
    if (nt < 16 && !lat) continue;
#pragma unroll
    for (int q = 0; q < 4; ++q) {
      float pv = __builtin_amdgcn_exp2f(S[nt][q] - mx[q]);
      u16 pb = f2bf(pv);
      sm[q] += bf2f(pb);
      Pw[(4 * g + q) * 520 + 16 * nt + r16] = pb;
    }
  }
#pragma unroll
  for (int q = 0; q < 4; ++q) {
    float s = sm[q];
    s += __shfl_xor(s, 1); s += __shfl_xor(s, 2); s += __shfl_xor(s, 4); s += __shfl_xor(s, 8);
    sm[q] = 1.f / s;
  }
  __syncthreads();
  f32x4 O[4];
#pragma unroll
  for (int nt = 0; nt < 4; ++nt) O[nt] = f32x4{0.f, 0.f, 0.f, 0.f};
#pragma unroll
  for (int ks = 0; ks < 16; ++ks) {
    if (ks < 8 && !lat) continue;
    bf16x8 pa = *(const bf16x8*)(Pw + r16 * 520 + 32 * ks + 8 * g);
    size_t vcol = ks < 8 ? (size_t)(rs + ks) * 64 + kb + 8 * g : (size_t)SEQL + 32 * (ks - 8) + 8 * g;
#pragma unroll
    for (int nt = 0; nt < 4; ++nt) {
      bf16x8 vb = *(const bf16x8*)(vT + ((size_t)(b * 512 + h * 64 + 16 * nt + r16)) * LT + vcol);
      O[nt] = mfma16(pa, vb, O[nt]);
    }
  }
#pragma unroll
  for (int nt = 0; nt < 4; ++nt)
#pragma unroll
    for (int q = 0; q < 4; ++q) yna[(size_t)(qm0 + 4 * g + q) * 512 + h * 64 + 16 * nt + r16] = f2bf(O[nt][q] * sm[q]);
}

constexpr int SK_ROW = 104, SV_ROW = 72;
constexpr int MLA_STAGE = 64 * SK_ROW + 96 * SV_ROW;
DI void mla_item(const Params& p, char* smem, int b, int h, int qb) {
  const int tid = tidx(), lane = tid & 63, w = tid >> 6, c32 = lane & 31, h2 = lane >> 5;
  const u16* Q = (const u16*)(wsp(p) + O_Q);
  const u16* Kg = (const u16*)(wsp(p) + O_KB) + (size_t)(b * 8 + h) * LT * 96;
  const u16* Vg = (const u16*)(wsp(p) + O_VT1) + (size_t)(b * 8 + h) * 96 * LT;
  u16* Y1 = (u16*)(wsp(p) + O_Y1);
  u16* sb = (u16*)smem;
  const int qrow = b * 8192 + qb * 128 + w * 32 + c32;
  bf16x8 qf[6];
#pragma unroll
  for (int ks = 0; ks < 6; ++ks) qf[ks] = *(const bf16x8*)(Q + (size_t)qrow * 768 + h * 96 + 16 * ks + 8 * h2);
  f32x16 O[3];
#pragma unroll
  for (int d = 0; d < 3; ++d)
#pragma unroll
    for (int i = 0; i < 16; ++i) O[d][i] = 0.f;
  float mrun = -1e30f, lrun = 0.f;
  U4 kr0, kr1, kr2, vr0, vr1, vr2;
  const int kkey0 = tid / 12, kkc0 = tid % 12, kkey1 = (tid + 256) / 12, kkc1 = (tid + 256) % 12, kkey2 = (tid + 512) / 12, kkc2 = (tid + 512) % 12;
#define MLA_FETCH(kt_)                                                              \
  {                                                                                 \
    const u16* kp_ = Kg + (size_t)(kt_) * 64 * 96 + tid * 8;                         \
    kr0 = *(const U4*)(kp_); kr1 = *(const U4*)(kp_ + 2048); kr2 = *(const U4*)(kp_ + 4096); \
    const u16* vp_ = Vg + (size_t)(tid >> 3) * LT + (kt_) * 64 + (tid & 7) * 8;      \
    vr0 = *(const U4*)(vp_); vr1 = *(const U4*)(vp_ + (size_t)32 * LT); vr2 = *(const U4*)(vp_ + (size_t)64 * LT); \
  }
#define MLA_COMMIT(st_)                                                             \
  {                                                                                 \
    u16* s_ = (st_);                                                                \
    *(U4*)(s_ + kkey0 * SK_ROW + kkc0 * 8) = kr0;                                \
    *(U4*)(s_ + kkey1 * SK_ROW + kkc1 * 8) = kr1;                                \
    *(U4*)(s_ + kkey2 * SK_ROW + kkc2 * 8) = kr2;                                \
    u16* v_ = s_ + 64 * SK_ROW + (tid >> 3) * SV_ROW + (tid & 7) * 8;               \
    *(U4*)(v_) = vr0; *(U4*)(v_ + 32 * SV_ROW) = vr1; *(U4*)(v_ + 64 * SV_ROW) = vr2; \
  }
  MLA_FETCH(0);
  __syncthreads();
  MLA_COMMIT(sb);
  __syncthreads();
  constexpr int NKT = LT / 64;
  for (int kt = 0; kt < NKT; ++kt) {
    const u16* sK = sb + (kt & 1) * MLA_STAGE;
    const u16* sV = sK + 64 * SK_ROW;
    if (kt + 1 < NKT) MLA_FETCH(kt + 1);
    f32x16 S[2];
#pragma unroll
    for (int mt = 0; mt < 2; ++mt) {
      f32x16 a;
#pragma unroll
      for (int i = 0; i < 16; ++i) a[i] = 0.f;
#pragma unroll
      for (int ks = 0; ks < 6; ++ks) {
        bf16x8 kf = *(const bf16x8*)(sK + (32 * mt + c32) * SK_ROW + 16 * ks + 8 * h2);
        a = mfma32(kf, qf[ks], a);
      }
      S[mt] = a;
    }
    float mx = -1e30f;
#pragma unroll
    for (int mt = 0; mt < 2; ++mt)
#pragma unroll
      for (int i = 0; i < 16; ++i) mx = fmaxf(mx, S[mt][i]);
    mx = fmaxf(mx, __shfl_xor(mx, 32));
    float mnew = fmaxf(mrun, mx);
    float alpha = __builtin_amdgcn_exp2f(mrun - mnew);
    mrun = mnew;
    float ps = 0.f;
    bf16x8 pf[4];
#pragma unroll
    for (int mt = 0; mt < 2; ++mt)
#pragma unroll
      for (int s = 0; s < 2; ++s) {
        float e[8];
#pragma unroll
        for (int jj = 0; jj < 8; ++jj) { e[jj] = __builtin_amdgcn_exp2f(S[mt][8 * s + jj] - mnew); ps += e[jj]; }
        U4 q = mk4(pack2(e[0], e[1]), pack2(e[2], e[3]), pack2(e[4], e[5]), pack2(e[6], e[7]));
        pf[mt * 2 + s] = __builtin_bit_cast(bf16x8, q);
      }
    lrun = lrun * alpha + ps;
    if (__any(alpha != 1.f)) {
#pragma unroll
      for (int d = 0; d < 3; ++d)
#pragma unroll
        for (int i = 0; i < 16; ++i) O[d][i] *= alpha;
    }
#pragma unroll
    for (int kk = 0; kk < 4; ++kk) {
      int keybase = 16 * kk + 4 * h2;
#pragma unroll
      for (int d = 0; d < 3; ++d) {
        const u16* vp = sV + (32 * d + c32) * SV_ROW + keybase;
        U2 lo = *(const U2*)(vp), hi = *(const U2*)(vp + 8);
        U4 q = mk4(lo.x, lo.y, hi.x, hi.y);
        O[d] = mfma32(__builtin_bit_cast(bf16x8, q), pf[kk], O[d]);
      }
    }
    if (kt + 1 < NKT) MLA_COMMIT(sb + ((kt + 1) & 1) * MLA_STAGE);
    __syncthreads();
  }
  float l = lrun + __shfl_xor(lrun, 32);
  float inv = 1.f / l;
#pragma unroll
  for (int d = 0; d < 3; ++d)
#pragma unroll
    for (int i4 = 0; i4 < 4; ++i4) {
      int dd = 32 * d + 8 * i4 + 4 * h2;
      U2 o = mk2(pack2(O[d][4 * i4] * inv, O[d][4 * i4 + 1] * inv), pack2(O[d][4 * i4 + 2] * inv, O[d][4 * i4 + 3] * inv));
      *(U2*)(Y1 + (size_t)qrow * 1024 + h * 96 + dd) = o;
    }
}

DI void kpe_item(const Params& p, int it) {
  const int tid = tidx();
  const u16* u1 = (const u16*)(wsp(p) + O_U1);
  u16* kbuf = (u16*)(wsp(p) + O_KB);
#pragma unroll
  for (int ps = 0; ps < 8; ++ps) {
    int m = it * 64 + ps * 8 + (tid >> 5), i = tid & 31;
    float v = bf2f(u1[(size_t)m * 1024 + 640 + i]);
    float pr = bf2f(u1[(size_t)m * 1024 + 640 + (i ^ 8)]);
    int b, s; bs_of(m, b, s);
    float o = v;
    if (m < NLAT) {
      int axis = i >> 4, second = (i >> 3) & 1, idx = i & 7;
      float inv = exp2f(-(float)idx * (13.287712379549449f / 8.f));
      float pos = (float)(axis ? (s & 63) : (s >> 6));
      float rv = pos * inv * 0.15915494309189535f; float sn = __builtin_amdgcn_sinf(rv), cs = __builtin_amdgcn_cosf(rv);
      o = second ? (v * cs + pr * sn) : (v * cs - pr * sn);
    }
    u16 ob = f2bf(o);
#pragma unroll
    for (int hh = 0; hh < 8; ++hh) kbuf[((size_t)(b * 8 + hh) * LT + s) * 96 + 64 + i] = ob;
  }
}

DI void fnet1_item(const Params& p, char* smem, int it) {
  const int tid = tidx();
  float* xs = (float*)smem;
  float* ct = xs + 64 * 257;
  float* st = ct + 64;
  const u16* u1 = (const u16*)(wsp(p) + O_U1);
  u16* XT = (u16*)(wsp(p) + O_XT);
  const int m0 = it * 64;
  if (tid < 64) { float sn = __builtin_amdgcn_sinf((float)tid / 64.f), cs = __builtin_amdgcn_cosf((float)tid / 64.f); ct[tid] = cs; st[tid] = sn; }
  for (int e = tid; e < 64 * 256; e += 256) {
    int tok = e >> 8, ch = e & 255;
    xs[tok * 257 + ch] = bf2f(u1[(size_t)(m0 + tok) * 1024 + 672 + ch]);
  }
  __syncthreads();
  const int tok = tid & 63, gq = tid >> 6;
  float xr[64];
  {
    float* xp = xs + tok * 257 + gq * 64;
    float s = 0.f;
#pragma unroll
    for (int jj = 0; jj < 64; ++jj) { xr[jj] = xp[jj]; s += xr[jj]; }
    float mu = s * (1.f / 64.f), q2 = 0.f;
#pragma unroll
    for (int jj = 0; jj < 64; ++jj) { float d = xr[jj] - mu; q2 += d * d; }
    float rstd = rsqrtf(q2 * (1.f / 64.f) + LN_EPS);
#pragma unroll
    for (int jj = 0; jj < 64; ++jj) xr[jj] = (xr[jj] - mu) * rstd * p.fn_g[gq * 64 + jj] + p.fn_b[gq * 64 + jj];
  }
  const int b = m0 >> 13, t = (m0 & 8191) + tok;
  for (int mm = 0; mm < 64; ++mm) {
    float c = 0.f, s = 0.f;
#pragma unroll
    for (int jj = 0; jj < 64; ++jj) { int idx = (mm * jj) & 63; c += xr[jj] * ct[idx]; s += xr[jj] * st[idx]; }
    size_t n = (size_t)(b * 256 + gq * 64 + mm);
    XT[n * 16384 + t] = f2bf(c);
    XT[n * 16384 + 8192 + t] = f2bf(s);
  }
}

DI void gbar(unsigned* ctr, unsigned& target, unsigned nblk) {
  asm volatile("s_waitcnt vmcnt(0)" ::: "memory");
  __syncthreads();
  target += nblk;
  if (__builtin_amdgcn_workitem_id_x() == 0) {
    __builtin_amdgcn_s_waitcnt(0);
    __builtin_amdgcn_fence(__ATOMIC_RELEASE, "agent");
    asm volatile("s_waitcnt vmcnt(0)" ::: "memory");
    __hip_atomic_fetch_add(ctr, 1u, __ATOMIC_RELAXED, __HIP_MEMORY_SCOPE_AGENT);
    while (__hip_atomic_load(ctr, __ATOMIC_RELAXED, __HIP_MEMORY_SCOPE_AGENT) < target) __builtin_amdgcn_s_sleep(1);
    __builtin_amdgcn_fence(__ATOMIC_ACQUIRE, "agent");
    asm volatile("s_waitcnt vmcnt(0)" ::: "memory");
  }
  __syncthreads();
}

#ifndef REP_MLA
#define REP_MLA 1
#endif
#ifndef REP_TOEP
#define REP_TOEP 1
#endif
#ifndef REP_MLP1
#define REP_MLP1 1
#endif
#ifndef REP_NAT
#define REP_NAT 1
#endif
#ifndef REP_FNG
#define REP_FNG 1
#endif
#ifndef REP_WIN
#define REP_WIN 1
#endif

__global__ void __launch_bounds__(512, 2) mega(Params p) {
  cg::grid_group grid = cg::this_grid();
  __shared__ __attribute__((aligned(16))) char smem_all[2 * SMEM_BYTES];
  char* smem = smem_all + halfx() * SMEM_BYTES;
  char* ws = wsp(p);
  const int nblk = NVB, bid = bidx();
  const int rnblk = gridDim.x, rbid = rbidx();
  float* S = (float*)(ws + O_S);
  u16* hbuf = (u16*)(ws + O_HBUF);
  unsigned* barp = (unsigned*)(ws + O_BAR);
  unsigned bar_target = 0;
#define SYNC() gbar(barp, bar_target, (unsigned)rnblk)

  phase_prep(p, smem);
  grid.sync();
  phase_ln<true, false, true>(p, R, nullptr, nullptr, nullptr, false, 0, 0, 1024);
  SYNC();

  for (int l = 0; l < 2; ++l) {
    const int rows = (l == 0) ? R : NLAT;
    const float* mod = modp(p, l, 0);
    if (l == 0) {
      {
        EpWin0 ep; ep.uhyT = (u16*)(ws + O_UHYT); ep.uqk = (u16*)(ws + O_UQK); ep.vT = (u16*)(ws + O_VT0);
        const u16* W = (const u16*)(ws + O_WT_ABIN);
        {
          LoadRowB al; al.A = hbuf; al.lda = 1024;
          for (int t = rbid; t < 128 * 12; t += rnblk) {
            int nt = t % 12;
            if (nt >= 6 && nt < 10) gemm_big<true>(al, W, 1024, 1024, (t / 12) * 256, nt * 256, ep, smem_all);
            else gemm_big<false>(al, W, 1024, 1024, (t / 12) * 256, nt * 256, ep, smem_all);
          }
        }
        {
          ALoadRow al; al.A = hbuf; al.lda = 1024;
          for (int t = bid; t < 8 * 24; t += nblk) {
            int nt = t % 24;
            if (nt >= 12 && nt < 20) gemm_tile<true>(al, W, 1024, 1024, NLAT + (t / 24) * 128, nt * 128, ep, smem);
            else gemm_tile<false>(al, W, 1024, 1024, NLAT + (t / 24) * 128, nt * 128, ep, smem);
          }
        }
      }
      SYNC();
      {
        const int n_toep = 1024, n_na = 4096, n_nac = 128, n_tc = 512;
        for (int it = bid; it < n_toep + n_na + n_nac + n_tc; it += nblk) {
          __syncthreads();
          int t = it;
          if (t < n_toep) { toep_item(p, smem, 0, t >> 1, t & 1); continue; }
          t -= n_toep;
          u16* Pw = (u16*)smem + (tidx() >> 6) * (16 * 520);
          if (t < n_na) { int b = t >> 10, r = (t >> 3) & 127, h = t & 7; natten_wave(p, Pw, b, h, true, r, tidx() >> 6, 0); continue; }
          t -= n_na;
          if (t < n_nac) { int b = t >> 5, h = (t >> 2) & 7, q4 = t & 3; natten_wave(p, Pw, b, h, false, 0, 0, q4 * 4 + (tidx() >> 6)); continue; }
          t -= n_nac;
          toep_ctx_item(p, smem, 0, t);
        }
      }
      SYNC();
      {
        for (int it = bid; it < 1024 + 512; it += nblk) {
          __syncthreads();
          if (it < 1024) toep_item(p, smem, 1, it >> 1, it & 1);
          else toep_ctx_item(p, smem, 1, it - 1024);
        }
      }
      SYNC();
      {
        EpResid ep; ep.xlat = p.x; ep.xctx = p.ctx; ep.S = S; ep.mod = mod; ep.goff = 2048;
        const u16* W = (const u16*)(ws + O_WT_ABOUT);
        {
          ALoadMixB al; al.YT = (const u16*)(ws + O_YHYT); al.YN = (const u16*)(ws + O_YNA);
          for (int t = rbid; t < 128 * 4; t += rnblk) gemm_big<true>(al, W, 1024, 1024, (t / 4) * 256, (t % 4) * 256, ep, smem_all);
        }
        {
          ALoadMix al; al.YT = (const u16*)(ws + O_YHYT); al.YN = (const u16*)(ws + O_YNA);
          for (int t = bid; t < 8 * 8; t += nblk) gemm_tile<true>(al, W, 1024, 1024, NLAT + (t / 8) * 128, (t % 8) * 128, ep, smem);
        }
      }
      SYNC();
    } else {
      {
        EpPlain ep; ep.dst = (u16*)(ws + O_U1); ep.ld = 1024;
        const u16* W = (const u16*)(ws + O_WT_CDIN);
        {
          LoadRowB al; al.A = hbuf; al.lda = 1024;
          for (int t = rbid; t < 128 * 4; t += rnblk) gemm_big<true>(al, W, 1024, 1024, (t / 4) * 256, (t % 4) * 256, ep, smem_all);
        }
        {
          ALoadRow al; al.A = hbuf; al.lda = 1024;
          for (int t = bid; t < 8 * 8; t += nblk) gemm_tile<true>(al, W, 1024, 1024, NLAT + (t / 8) * 128, (t % 8) * 128, ep, smem);
        }
      }
      SYNC();
      {
        const int n_q = (NLAT / 128) * 6, n_kv = (R / 128) * 10, n_kpe = R / 64, n_f1 = NLAT / 64;
        float* srow = (float*)(smem + 73728);
        const u16* u1 = (const u16*)(ws + O_U1);
        for (int it = bid; it < n_q + n_kv + n_kpe + n_f1; it += nblk) {
          __syncthreads();
          int t = it;
          if (t < n_q) {
            int m0 = (t / 6) * 128, n0 = (t % 6) * 128;
            rms_rows(u1, 1024, 384, m0, srow);
            ALoadRow al; al.A = u1; al.lda = 1024;
            EpQ ep; ep.q = (u16*)(ws + O_Q); ep.srow = srow; ep.m0 = m0;
            gemm_tile<true>(al, (const u16*)(ws + O_WT_UQ), 384, 384, m0, n0, ep, smem);
            continue;
          }
          t -= n_q;
          if (t < n_kv) {
            int m0 = (t / 10) * 128, n0 = (t % 10) * 128;
            rms_rows(u1 + 384, 1024, 256, m0, srow);
            ALoadRow al; al.A = u1 + 384; al.lda = 1024;
            EpKV ep; ep.kb = (u16*)(ws + O_KB); ep.vT = (u16*)(ws + O_VT1); ep.srow = srow; ep.m0 = m0;
            gemm_tile<false>(al, (const u16*)(ws + O_WT_UKV), 256, 256, m0, n0, ep, smem);
            continue;
          }
          t -= n_kv;
          if (t < n_kpe) { kpe_item(p, t); continue; }
          t -= n_kpe;
          fnet1_item(p, smem, t);
        }
      }
      SYNC();
      {
        const int n_mla = 2048, n_fn = 512;
        for (int it = bid; it < n_mla + n_fn; it += nblk) {
          __syncthreads();
          if (it < n_mla) { int b = it >> 9, h = (it >> 6) & 7, qb = it & 63; mla_item(p, smem, b, h, qb); continue; }
          int t = it - n_mla;
          ALoadDFT al;
          EpFnet ep; ep.y1 = (u16*)(ws + O_Y1);
          gemm_tile<true>(al, (const u16*)(ws + O_XT), 16384, 16384, (t >> 3) * 128, (t & 7) * 128, ep, smem);
        }
      }
      SYNC();
      {
        LoadRowB al; al.A = (const u16*)(ws + O_Y1); al.lda = 1024;
        EpResid ep; ep.xlat = S; ep.xctx = S + (size_t)NLAT * 1024; ep.S = S; ep.mod = mod; ep.goff = 2048;
        for (int t = rbid; t < 128 * 4; t += rnblk) gemm_big<true>(al, (const u16*)(ws + O_WT_CDOUT), 1024, 1024, (t / 4) * 256, (t % 4) * 256, ep, smem_all);
      }
      SYNC();
    }
    phase_ln<false, true, true>(p, rows, p.ln_g + (size_t)(l * 2 + 0) * 1024, p.ln_b + (size_t)(l * 2 + 0) * 1024, nullptr, true, l, 3072, 4096);
    SYNC();
    {
      EpRelu2 ep; ep.a1 = (u16*)(ws + O_A1);
      const u16* W = (const u16*)(ws + O_WT_W1) + (size_t)l * 4096 * 1024;
      {
        LoadRowB al; al.A = hbuf; al.lda = 1024;
        for (int t = rbid; t < 128 * 16; t += rnblk) gemm_big<true>(al, W, 1024, 1024, (t / 16) * 256, (t % 16) * 256, ep, smem_all);
      }
      if (l == 0) {
        ALoadRow al; al.A = hbuf; al.lda = 1024;
        for (int t = bid; t < 8 * 32; t += nblk) gemm_tile<true>(al, W, 1024, 1024, NLAT + (t / 32) * 128, (t % 32) * 128, ep, smem);
      }
    }
    SYNC();
    {
      EpResid ep; ep.xlat = S; ep.xctx = S + (size_t)NLAT * 1024; ep.S = S; ep.mod = mod; ep.goff = 5120;
      const u16* W = (const u16*)(ws + O_WT_W2) + (size_t)l * 4096 * 1024;
      {
        LoadRowB al; al.A = (const u16*)(ws + O_A1); al.lda = 4096;
        for (int t = rbid; t < 128 * 4; t += rnblk) gemm_big<true>(al, W, 4096, 4096, (t / 4) * 256, (t % 4) * 256, ep, smem_all);
      }
      if (l == 0) {
        ALoadRow al; al.A = (const u16*)(ws + O_A1); al.lda = 4096;
        for (int t = bid; t < 8 * 8; t += nblk) gemm_tile<true>(al, W, 4096, 4096, NLAT + (t / 8) * 128, (t % 8) * 128, ep, smem);
      }
    }
    SYNC();
    if (l == 0) phase_ln<false, true, true>(p, R, p.ln_g + 1024, p.ln_b + 1024, nullptr, true, 1, 0, 1024);
    else phase_ln<false, true, false>(p, NLAT, p.ln_g + 3 * 1024, p.ln_b + 3 * 1024, p.out, false, 0, 0, 0);
    if (l == 0) SYNC();
  }
}

extern "C" void kernel_launch(void* const* d_in, const int* in_sizes, int n_in, void* d_out, int out_size, void* d_ws,
                              size_t ws_size, hipStream_t stream) {
  static int grid_blocks = 0;
  if (!grid_blocks) {
    int dev = 0, cus = 0, per_cu = 0;
    hipGetDevice(&dev);
    hipDeviceGetAttribute(&cus, hipDeviceAttributeMultiprocessorCount, dev);
    hipOccupancyMaxActiveBlocksPerMultiprocessor(&per_cu, mega, 512, 0);
    if (per_cu > 1) per_cu = 1;
    if (per_cu < 1) per_cu = 1;
    grid_blocks = cus * per_cu;
  }
  Params p{};
  const float** f = (const float**)&p;
  for (int i = 0; i < 30; ++i) f[i] = (const float*)d_in[i];
  p.out = (float*)d_out;
  p.ws = (char*)d_ws;
  hipMemsetAsync((char*)d_ws + O_BAR, 0, 256, stream);
  void* args[] = {&p};
  hipError_t e = hipLaunchCooperativeKernel((void*)mega, dim3(grid_blocks), dim3(512), args, 0, stream);
  if (e != hipSuccess) fprintf(stderr, "cooperative launch failed: %s (grid %d)\n", hipGetErrorString(e), grid_blocks);
}
```

```cpp
#include <hip/hip_runtime.h>
#include <hip/hip_cooperative_groups.h>
#include <cstdio>
namespace cg = cooperative_groups;

#define DI __device__ __forceinline__
typedef unsigned short u16;
typedef unsigned int u32;
using bf16x8 = __attribute__((ext_vector_type(8))) short;
using f32x4 = __attribute__((ext_vector_type(4))) float;
using f32x16 = __attribute__((ext_vector_type(16))) float;
using U4 = __attribute__((ext_vector_type(4))) unsigned int;
using U2 = __attribute__((ext_vector_type(2))) unsigned int;
using F4 = __attribute__((ext_vector_type(4))) float;
using f32x2 = __attribute__((ext_vector_type(2))) float;
#define mk4(a, b, c, d) (U4{(u32)(a), (u32)(b), (u32)(c), (u32)(d)})
#define mk2(a, b) (U2{(u32)(a), (u32)(b)})
#define mkf4(a, b, c, d) (F4{(a), (b), (c), (d)})

constexpr int NB = 4, SEQL = 8192, LC = 256;
constexpr int NLAT = NB * SEQL;
constexpr int NCTX = NB * LC;
constexpr int R = NLAT + NCTX;
constexpr int LT = SEQL + LC;
constexpr float ALPHA = 1.4142135623730951f;
constexpr float LN_EPS = 1e-5f;
constexpr float LOG2E = 1.4426950408889634f;

constexpr size_t O_WT_ABIN = 0;
constexpr size_t O_WT_ABOUT = O_WT_ABIN + 3072ull * 1024 * 2;
constexpr size_t O_WT_W1 = O_WT_ABOUT + 1024ull * 1024 * 2;
constexpr size_t O_WT_W2 = O_WT_W1 + 2ull * 4096 * 1024 * 2;
constexpr size_t O_WT_CDIN = O_WT_W2 + 2ull * 4096 * 1024 * 2;
constexpr size_t O_WT_CDOUT = O_WT_CDIN + 1024ull * 1024 * 2;
constexpr size_t O_WT_UQ = O_WT_CDOUT + 1024ull * 1024 * 2;
constexpr size_t O_WT_UKV = O_WT_UQ + 768ull * 384 * 2;
constexpr size_t O_MOD = O_WT_UKV + 1280ull * 256 * 2;
constexpr size_t O_TCTX = O_MOD + 2ull * 5 * 6144 * 4;
constexpr size_t O_S = (O_TCTX + 2ull * 512 * 512 * 2 + 255) & ~(size_t)255;
constexpr size_t O_D = O_S + (size_t)R * 1024 * 4;
constexpr size_t O_HBUF = O_D;
constexpr size_t O_UQK = O_D + (size_t)R * 1024 * 2;
constexpr size_t O_VT0 = O_UQK + (size_t)R * 1024 * 2;
constexpr size_t O_UHYT = O_VT0 + 4ull * 512 * LT * 2;
constexpr size_t O_TLAT = O_UHYT + 4ull * 1536 * LT * 2;
constexpr size_t O_ZT = O_D;
constexpr size_t O_YNA = O_D + 4ull * 512 * LT * 2;
constexpr size_t O_YHYT = O_UQK;
constexpr size_t O_A1 = O_UQK;
constexpr size_t O_U1 = O_UQK;
constexpr size_t O_Q = O_U1 + (size_t)R * 1024 * 2;
constexpr size_t O_KB = O_Q + (size_t)NLAT * 768 * 2;
constexpr size_t O_KP = O_KB + 32ull * LT * 64 * 2;
constexpr size_t O_VT1 = O_KB + 32ull * LT * 96 * 2;
constexpr size_t O_XT = O_VT1 + 32ull * LT * 96 * 2;
constexpr size_t O_Y1 = O_D;
constexpr size_t WS_NEED = O_A1 + (size_t)R * 4096 * 2;
constexpr size_t O_BAR = (WS_NEED + 255) & ~(size_t)255;
static_assert(O_BAR + 16384 <= 536870912ull, "ws too large");
static_assert(O_TLAT + 2ull * 512 * 16384 * 2 <= WS_NEED, "l0 region");
static_assert(O_XT + 1024ull * 16384 * 2 <= WS_NEED, "l1 region");

constexpr int SMEM_BYTES = 73728 + 1024;

struct Params {
  const float *x, *c, *ctx, *c_ctx, *mod_w, *mod_b, *ln_g, *ln_b, *mlp_w1, *mlp_w2, *ab_w_in, *ab_w_out, *hy_conv_w,
      *hy_w1, *hy_b1, *hy_freq, *hy_w2, *hy_b2, *hy_w3, *hy_log_decay, *hy_skip, *na_rpb, *cd_w_in, *cd_w_out,
      *mla_q_norm, *mla_w_uq, *mla_kv_norm, *mla_w_ukv, *fn_g, *fn_b;
  float* out;
  char* ws;
};

DI int tidx() { int t = __builtin_amdgcn_workitem_id_x() & 255; asm volatile("" : "+v"(t)); return t; }
DI int tid512() { int t = __builtin_amdgcn_workitem_id_x(); asm volatile("" : "+v"(t)); return t; }
DI int halfx() { return __builtin_amdgcn_readfirstlane(__builtin_amdgcn_workitem_id_x() >> 8); }
DI int bidx() { int b = __builtin_amdgcn_workgroup_id_x() * 2 + halfx(); asm volatile("" : "+s"(b)); return b; }
DI int rbidx() { int b = __builtin_amdgcn_workgroup_id_x(); asm volatile("" : "+s"(b)); return b; }
#define NVB ((int)gridDim.x * 2)
DI char* wsp(const Params& p) { char* w = p.ws; asm volatile("" : "+s"(w)); return w; }

DI u32 pack2(float a, float b) { u32 r; asm("v_cvt_pk_bf16_f32 %0, %1, %2" : "=v"(r) : "v"(a), "v"(b)); return r; }
DI u32 pack2g(float a, float b) { return pack2(a + 0.0f, b + 0.0f); }
DI u16 f2bf(float x) { return (u16)pack2(x, 0.f); }
DI float bf2f(u16 h) { return __uint_as_float(((u32)h) << 16); }
DI float wave_sum(float v) {
#pragma unroll
  for (int o = 32; o >= 1; o >>= 1) v += __shfl_xor(v, o);
  return v;
}
DI f32x4 mfma16(bf16x8 a, bf16x8 b, f32x4 c) { return __builtin_amdgcn_mfma_f32_16x16x32_bf16(a, b, c, 0, 0, 0); }
DI f32x16 mfma32(bf16x8 a, bf16x8 b, f32x16 c) { return __builtin_amdgcn_mfma_f32_32x32x16_bf16(a, b, c, 0, 0, 0); }

DI const float* modp(const Params& p, int l, int bidx) { return (const float*)(wsp(p) + O_MOD) + ((size_t)l * 5 + bidx) * 6144; }
DI int bidx_of(int m) { return m < NLAT ? (m >> 13) : 4; }
DI void bs_of(int m, int& b, int& s) {
  if (m < NLAT) { b = m >> 13; s = m & 8191; }
  else { int t = m - NLAT; b = t >> 8; s = SEQL + (t & 255); }
}

constexpr int BK = 64, LROW = BK + 8;
constexpr int STAGE_U16 = 2 * 128 * LROW;

struct ALoadRow {
  const u16* A; int lda; U4 r0, r1, r2, r3;
  DI void fetch(int m0, int k0, int tid) {
    const u16* base = A + (size_t)(m0 + (tid >> 3)) * lda + k0 + (tid & 7) * 8;
    r0 = *(const U4*)(base);
    r1 = *(const U4*)(base + (size_t)32 * lda);
    r2 = *(const U4*)(base + (size_t)64 * lda);
    r3 = *(const U4*)(base + (size_t)96 * lda);
  }
  DI void commit(u16* sA, int tid) {
    u16* d = sA + (tid >> 3) * LROW + (tid & 7) * 8;
    *(U4*)(d) = r0; *(U4*)(d + 32 * LROW) = r1; *(U4*)(d + 64 * LROW) = r2; *(U4*)(d + 96 * LROW) = r3;
  }
};

struct ALoadMix {
  const u16* YT; const u16* YN; U4 r0, r1, r2, r3; bool tr;
  DI void fetch(int m0, int k0, int tid) {
    tr = (k0 < 512);
    if (tr) {
      int b, s; bs_of(m0, b, s);
      const u16* base = YT + ((size_t)(b * 512 + k0 + (tid >> 4))) * LT + s + (tid & 15) * 8;
      r0 = *(const U4*)(base);
      r1 = *(const U4*)(base + (size_t)16 * LT);
      r2 = *(const U4*)(base + (size_t)32 * LT);
      r3 = *(const U4*)(base + (size_t)48 * LT);
    } else {
      const u16* base = YN + (size_t)(m0 + (tid >> 3)) * 512 + (k0 - 512) + (tid & 7) * 8;
      r0 = *(const U4*)(base);
      r1 = *(const U4*)(base + (size_t)32 * 512);
      r2 = *(const U4*)(base + (size_t)64 * 512);
      r3 = *(const U4*)(base + (size_t)96 * 512);
    }
  }
  static DI void scat(u16* d, U4 q) {
    d[0 * LROW] = (u16)(q.x); d[1 * LROW] = (u16)(q.x >> 16);
    d[2 * LROW] = (u16)(q.y); d[3 * LROW] = (u16)(q.y >> 16);
    d[4 * LROW] = (u16)(q.z); d[5 * LROW] = (u16)(q.z >> 16);
    d[6 * LROW] = (u16)(q.w); d[7 * LROW] = (u16)(q.w >> 16);
  }
  DI void commit(u16* sA, int tid) {
    if (tr) {
      u16* d = sA + ((tid & 15) * 8) * LROW + (tid >> 4);
      scat(d, r0); scat(d + 16, r1); scat(d + 32, r2); scat(d + 48, r3);
    } else {
      u16* d = sA + (tid >> 3) * LROW + (tid & 7) * 8;
      *(U4*)(d) = r0; *(U4*)(d + 32 * LROW) = r1; *(U4*)(d + 64 * LROW) = r2; *(U4*)(d + 96 * LROW) = r3;
    }
  }
};

struct ALoadDFT {
  static DI U4 gen(int k, int kk) {
    int t0 = kk & 8191;
    int idx = k * t0 + (kk >= 8192 ? 2048 : 0);
    float v0 = __builtin_amdgcn_cosf((float)((idx) & 8191) * (1.f / 8192.f));
    float v1 = __builtin_amdgcn_cosf((float)((idx + k) & 8191) * (1.f / 8192.f));
    float v2 = __builtin_amdgcn_cosf((float)((idx + 2 * k) & 8191) * (1.f / 8192.f));
    float v3 = __builtin_amdgcn_cosf((float)((idx + 3 * k) & 8191) * (1.f / 8192.f));
    float v4 = __builtin_amdgcn_cosf((float)((idx + 4 * k) & 8191) * (1.f / 8192.f));
    float v5 = __builtin_amdgcn_cosf((float)((idx + 5 * k) & 8191) * (1.f / 8192.f));
    float v6 = __builtin_amdgcn_cosf((float)((idx + 6 * k) & 8191) * (1.f / 8192.f));
    float v7 = __builtin_amdgcn_cosf((float)((idx + 7 * k) & 8191) * (1.f / 8192.f));
    return mk4(pack2(v0, v1), pack2(v2, v3), pack2(v4, v5), pack2(v6, v7));
  }
  int kofs; int k_, kk_;
  DI void fetch(int m0, int k0, int tid) { k_ = m0 + (tid >> 3); kk_ = kofs + k0 + (tid & 7) * 8; }
  DI void commit(u16* sA, int tid) {
    u16* d = sA + (tid >> 3) * LROW + (tid & 7) * 8;
    __builtin_amdgcn_sched_barrier(0);
    *(U4*)(d) = gen(k_, kk_);
    __builtin_amdgcn_sched_barrier(0);
    *(U4*)(d + 32 * LROW) = gen(k_ + 32, kk_);
    __builtin_amdgcn_sched_barrier(0);
    *(U4*)(d + 64 * LROW) = gen(k_ + 64, kk_);
    __builtin_amdgcn_sched_barrier(0);
    *(U4*)(d + 96 * LROW) = gen(k_ + 96, kk_);
    __builtin_amdgcn_sched_barrier(0);
  }
};

struct BLoadRow {
  const u16* B; int ldb; U4 r0, r1, r2, r3;
  DI void fetch(int n0, int k0, int tid) {
    const u16* base = B + (size_t)(n0 + (tid >> 3)) * ldb + k0 + (tid & 7) * 8;
    r0 = *(const U4*)(base);
    r1 = *(const U4*)(base + (size_t)32 * ldb);
    r2 = *(const U4*)(base + (size_t)64 * ldb);
    r3 = *(const U4*)(base + (size_t)96 * ldb);
  }
  DI void commit(u16* sB, int tid) {
    u16* d = sB + (tid >> 3) * LROW + (tid & 7) * 8;
    *(U4*)(d) = r0; *(U4*)(d + 32 * LROW) = r1; *(U4*)(d + 64 * LROW) = r2; *(U4*)(d + 96 * LROW) = r3;
  }
};

template <bool SWAP>
DI void gemm_compute(f32x4 (&acc)[4][4], const u16* sA, const u16* sB, int wm, int wn, int r16, int g) {
#pragma unroll
  for (int ks = 0; ks < 2; ++ks) {
    bf16x8 a[4], b[4];
#pragma unroll
    for (int i = 0; i < 4; ++i) a[i] = *(const bf16x8*)(sA + (wm * 64 + i * 16 + r16) * LROW + ks * 32 + g * 8);
#pragma unroll
    for (int j = 0; j < 4; ++j) b[j] = *(const bf16x8*)(sB + (wn * 64 + j * 16 + r16) * LROW + ks * 32 + g * 8);
#pragma unroll
    for (int i = 0; i < 4; ++i)
#pragma unroll
      for (int j = 0; j < 4; ++j) {
        if (SWAP) acc[i][j] = mfma16(b[j], a[i], acc[i][j]);
        else acc[i][j] = mfma16(a[i], b[j], acc[i][j]);
      }
  }
}

template <bool SWAP, class AL, class EP, int VAR = 0>
DI void gemm_tile(AL& al0, const u16* __restrict__ Bt, int ldb, int K, int m0, int n0, EP& ep, char* smem) {
  const int tid = tidx(), lane = tid & 63, w = tid >> 6, wm = w >> 1, wn = w & 1, r16 = lane & 15, g = lane >> 4;
  u16* sbase = (u16*)smem;
  f32x4 acc[4][4];
#pragma unroll
  for (int i = 0; i < 4; ++i)
#pragma unroll
    for (int j = 0; j < 4; ++j) acc[i][j] = f32x4{0.f, 0.f, 0.f, 0.f};
  AL al1 = al0;
  BLoadRow bl0, bl1; bl0.B = Bt; bl0.ldb = ldb; bl1.B = Bt; bl1.ldb = ldb;
  const int nk = K / BK;
  al0.fetch(m0, 0, tid); bl0.fetch(n0, 0, tid);
  al1.fetch(m0, BK, tid); bl1.fetch(n0, BK, tid);
  __syncthreads();
  al0.commit(sbase, tid); bl0.commit(sbase + 128 * LROW, tid);
  __syncthreads();
  u16* const sA0 = sbase; u16* const sB0 = sbase + 128 * LROW;
  u16* const sA1 = sbase + STAGE_U16; u16* const sB1 = sA1 + 128 * LROW;
  for (int kt = 0; kt < nk; kt += 2) {
    if (VAR != 1) { int k2 = (kt + 2 < nk ? kt + 2 : nk - 2) * BK; al0.fetch(m0, k2, tid); bl0.fetch(n0, k2, tid); }
    __builtin_amdgcn_sched_barrier(0);
    if (VAR != 2) gemm_compute<SWAP>(acc, sA0, sB0, wm, wn, r16, g);
    al1.commit(sA1, tid); bl1.commit(sB1, tid);
    __syncthreads();
    if (VAR != 1) { int k3 = (kt + 3 < nk ? kt + 3 : nk - 1) * BK; al1.fetch(m0, k3, tid); bl1.fetch(n0, k3, tid); }
    __builtin_amdgcn_sched_barrier(0);
    if (VAR != 2) gemm_compute<SWAP>(acc, sA1, sB1, wm, wn, r16, g);
    al0.commit(sA0, tid); bl0.commit(sB0, tid);
    __syncthreads();
  }
#pragma unroll
  for (int i = 0; i < 4; ++i)
#pragma unroll
    for (int j = 0; j < 4; ++j) {
      if (VAR == 3) { if (acc[i][j][0] == 1.2345f) ep.apply_t(m0, n0, acc[i][j]); }
      else if (SWAP) ep.apply_t(m0 + wm * 64 + i * 16 + r16, n0 + wn * 64 + j * 16 + g * 4, acc[i][j]);
      else ep.apply(m0 + wm * 64 + i * 16 + g * 4, n0 + wn * 64 + j * 16 + r16, acc[i][j]);
    }
}

struct LoadRowB {
  const u16* A; int lda; U4 r0, r1, r2, r3;
  DI void fetch(int m0, int k0, int tid) {
    const u16* base = A + (size_t)(m0 + (tid >> 3)) * lda + k0 + (tid & 7) * 8;
    r0 = *(const U4*)(base);
    r1 = *(const U4*)(base + (size_t)64 * lda);
    r2 = *(const U4*)(base + (size_t)128 * lda);
    r3 = *(const U4*)(base + (size_t)192 * lda);
  }
  DI void commit(u16* sA, int tid) {
    u16* d = sA + (tid >> 3) * LROW + (tid & 7) * 8;
    *(U4*)(d) = r0; *(U4*)(d + 64 * LROW) = r1; *(U4*)(d + 128 * LROW) = r2; *(U4*)(d + 192 * LROW) = r3;
  }
};
struct ALoadMixB {
  const u16* YT; const u16* YN; U4 r0, r1, r2, r3; bool tr;
  DI void fetch(int m0, int k0, int tid) {
    tr = (k0 < 512);
    if (tr) {
      int b, s; bs_of(m0, b, s);
      const u16* base = YT + ((size_t)(b * 512 + k0 + (tid >> 5))) * LT + s + (tid & 31) * 8;
      r0 = *(const U4*)(base);
      r1 = *(const U4*)(base + (size_t)16 * LT);
      r2 = *(const U4*)(base + (size_t)32 * LT);
      r3 = *(const U4*)(base + (size_t)48 * LT);
    } else {
      const u16* base = YN + (size_t)(m0 + (tid >> 3)) * 512 + (k0 - 512) + (tid & 7) * 8;
      r0 = *(const U4*)(base);
      r1 = *(const U4*)(base + (size_t)64 * 512);
      r2 = *(const U4*)(base + (size_t)128 * 512);
      r3 = *(const U4*)(base + (size_t)192 * 512);
    }
  }
  DI void commit(u16* sA, int tid) {
    if (tr) {
      u16* d = sA + ((tid & 31) * 8) * LROW + (tid >> 5);
      ALoadMix::scat(d, r0); ALoadMix::scat(d + 16, r1); ALoadMix::scat(d + 32, r2); ALoadMix::scat(d + 48, r3);
    } else {
      u16* d = sA + (tid >> 3) * LROW + (tid & 7) * 8;
      *(U4*)(d) = r0; *(U4*)(d + 64 * LROW) = r1; *(U4*)(d + 128 * LROW) = r2; *(U4*)(d + 192 * LROW) = r3;
    }
  }
};

template <bool SWAP, class AL, class EP>
DI void gemm_big(AL& al, const u16* __restrict__ Bt, int ldb, int K, int m0, int n0, EP& ep, char* smem_all) {
  const int tid = tid512(), lane = tid & 63, w = tid >> 6, wm = w >> 2, wn = w & 3, r16 = lane & 15, g = lane >> 4;
  u16* sbase = (u16*)smem_all;
  constexpr int STG = 2 * 256 * LROW;
  f32x4 acc[8][4];
#pragma unroll
  for (int i = 0; i < 8; ++i)
#pragma unroll
    for (int j = 0; j < 4; ++j) acc[i][j] = f32x4{0.f, 0.f, 0.f, 0.f};
  LoadRowB bl; bl.A = Bt; bl.lda = ldb;
  const int nk = K / BK;
  al.fetch(m0, 0, tid); bl.fetch(n0, 0, tid);
  __syncthreads();
  al.commit(sbase, tid); bl.commit(sbase + 256 * LROW, tid);
  __syncthreads();
  for (int kt = 0; kt < nk; ++kt) {
    const u16* sA = sbase + (kt & 1) * STG;
    const u16* sB = sA + 256 * LROW;
    { int kn = (kt + 1 < nk ? kt + 1 : kt) * BK; al.fetch(m0, kn, tid); bl.fetch(n0, kn, tid); }
    __builtin_amdgcn_sched_barrier(0);
#pragma unroll
    for (int ks = 0; ks < 2; ++ks) {
      bf16x8 b[4];
#pragma unroll
      for (int j = 0; j < 4; ++j) b[j] = *(const bf16x8*)(sB + (wn * 64 + j * 16 + r16) * LROW + ks * 32 + g * 8);
#pragma unroll
      for (int ih = 0; ih < 2; ++ih) {
        bf16x8 a[4];
#pragma unroll
        for (int i = 0; i < 4; ++i) a[i] = *(const bf16x8*)(sA + (wm * 128 + (ih * 4 + i) * 16 + r16) * LROW + ks * 32 + g * 8);
#pragma unroll
        for (int i = 0; i < 4; ++i)
#pragma unroll
          for (int j = 0; j < 4; ++j) {
            if (SWAP) acc[ih * 4 + i][j] = mfma16(b[j], a[i], acc[ih * 4 + i][j]);
            else acc[ih * 4 + i][j] = mfma16(a[i], b[j], acc[ih * 4 + i][j]);
          }
        __builtin_amdgcn_sched_barrier(0);
      }
    }
    u16* nA = sbase + ((kt + 1) & 1) * STG;
    al.commit(nA, tid); bl.commit(nA + 256 * LROW, tid);
    __syncthreads();
  }
#pragma unroll
  for (int i = 0; i < 8; ++i)
#pragma unroll
    for (int j = 0; j < 4; ++j) {
      if (SWAP) ep.apply_t(m0 + wm * 128 + i * 16 + r16, n0 + wn * 64 + j * 16 + g * 4, acc[i][j]);
      else ep.apply(m0 + wm * 128 + i * 16 + g * 4, n0 + wn * 64 + j * 16 + r16, acc[i][j]);
    }
}

struct EpWin0 {
  u16 *uhyT, *uqk, *vT;
  DI void apply_t(int m, int nb, f32x4 v) const { *(U2*)(uqk + (size_t)m * 1024 + (nb - 1536)) = mk2(pack2g(v[0], v[1]), pack2g(v[2], v[3])); }
  DI void apply(int mb, int n, f32x4 v) const {
    int b, s; bs_of(mb, b, s);
    if (n < 1536) {
      U2 o = mk2(pack2g(v[0], v[1]), pack2g(v[2], v[3]));
      *(U2*)(uhyT + ((size_t)(b * 1536 + n)) * LT + s) = o;
    } else if (n < 2560) {
#pragma unroll
      for (int r = 0; r < 4; ++r) uqk[(size_t)(mb + r) * 1024 + (n - 1536)] = (u16)pack2g(v[r], 0.f);
    } else {
      U2 o = mk2(pack2g(v[0], v[1]), pack2g(v[2], v[3]));
      *(U2*)(vT + ((size_t)(b * 512 + (n - 2560))) * LT + s) = o;
    }
  }
};
struct EpResid {
  const float* xlat; const float* xctx; float* S; const float* mod; int goff;
  DI void apply_t(int m, int nb, f32x4 v) const {
    F4 gt = *(const F4*)(mod + (size_t)bidx_of(m) * 6144 + goff + nb);
    const float* xp = (m < NLAT) ? xlat + (size_t)m * 1024 + nb : xctx + (size_t)(m - NLAT) * 1024 + nb;
    F4 xi = *(const F4*)xp;
    *(F4*)(S + (size_t)m * 1024 + nb) = mkf4(ALPHA * xi.x + gt.x * v[0], ALPHA * xi.y + gt.y * v[1], ALPHA * xi.z + gt.z * v[2], ALPHA * xi.w + gt.w * v[3]);
  }
  DI void apply(int mb, int n, f32x4 v) const {
    float gt = mod[(size_t)bidx_of(mb) * 6144 + goff + n];
#pragma unroll
    for (int r = 0; r < 4; ++r) {
      int m = mb + r;
      float xi = (m < NLAT) ? xlat[(size_t)m * 1024 + n] : xctx[(size_t)(m - NLAT) * 1024 + n];
      S[(size_t)m * 1024 + n] = ALPHA * xi + gt * v[r];
    }
  }
};
struct EpRelu2 {
  u16* a1;
  DI void apply_t(int m, int nb, f32x4 v) const {
    float t0 = fmaxf(v[0], 0.f), t1 = fmaxf(v[1], 0.f), t2 = fmaxf(v[2], 0.f), t3 = fmaxf(v[3], 0.f);
    *(U2*)(a1 + (size_t)m * 4096 + nb) = mk2(pack2(t0 * t0, t1 * t1), pack2(t2 * t2, t3 * t3));
  }
  DI void apply(int mb, int n, f32x4 v) const {
#pragma unroll
    for (int r = 0; r < 4; ++r) { float t = fmaxf(v[r], 0.f); a1[(size_t)(mb + r) * 4096 + n] = f2bf(t * t); }
  }
};
struct EpPlain {
  u16* dst; int ld;
  DI void apply_t(int m, int nb, f32x4 v) const { *(U2*)(dst + (size_t)m * ld + nb) = mk2(pack2g(v[0], v[1]), pack2g(v[2], v[3])); }
  DI void apply(int mb, int n, f32x4 v) const {
#pragma unroll
    for (int r = 0; r < 4; ++r) dst[(size_t)(mb + r) * ld + n] = (u16)pack2g(v[r], 0.f);
  }
};
struct EpQ {
  u16* q; const float* srow; int m0;
  DI void apply_t(int m, int nb, f32x4 v) const {
    int hc = nb % 96;
    float sr = srow[m - m0];
    float val[4], par[4];
#pragma unroll
    for (int r = 0; r < 4; ++r) { val[r] = v[r] * sr; par[r] = __shfl_xor(val[r], 32); }
    if (hc >= 64) {
      int i0 = hc - 64, axis = i0 >> 4, second = (i0 >> 3) & 1;
      int s = m & 8191;
      float pos = (float)(axis ? (s & 63) : (s >> 6));
#pragma unroll
      for (int r = 0; r < 4; ++r) {
        int idx = (i0 + r) & 7;
        float inv = exp2f(-(float)idx * (13.287712379549449f / 8.f));
        float rv = pos * inv * 0.15915494309189535f; float sn = __builtin_amdgcn_sinf(rv), cs = __builtin_amdgcn_cosf(rv);
        val[r] = second ? (val[r] * cs + par[r] * sn) : (val[r] * cs - par[r] * sn);
      }
    }
    const float qs = 0.10206207261596575f * LOG2E;
    *(U2*)(q + (size_t)m * 768 + nb) = mk2(pack2(val[0] * qs, val[1] * qs), pack2(val[2] * qs, val[3] * qs));
  }
  DI void apply(int mb, int n, f32x4 v) const {
    int hc = n % 96;
    float val[4], par[4];
#pragma unroll
    for (int r = 0; r < 4; ++r) { val[r] = v[r] * srow[mb - m0 + r]; par[r] = __shfl_xor(val[r], 8); }
    if (hc >= 64) {
      int i = hc - 64, axis = i >> 4, second = (i >> 3) & 1, idx = i & 7;
      float inv = exp2f(-(float)idx * (13.287712379549449f / 8.f));
#pragma unroll
      for (int r = 0; r < 4; ++r) {
        int s = (mb + r) & 8191;
        float pos = (float)(axis ? (s & 63) : (s >> 6));
        float rv = pos * inv * 0.15915494309189535f; float sn = __builtin_amdgcn_sinf(rv), cs = __builtin_amdgcn_cosf(rv);
        val[r] = second ? (val[r] * cs + par[r] * sn) : (val[r] * cs - par[r] * sn);
      }
    }
    const float qs = 0.10206207261596575f * LOG2E;
#pragma unroll
    for (int r = 0; r < 4; ++r) q[(size_t)(mb + r) * 768 + n] = f2bf(val[r] * qs);
  }
};
struct EpKV {
  u16 *kn, *vT; const float* srow; int m0;
  DI void apply_t(int, int, f32x4) const {}
  DI void apply(int mb, int n, f32x4 v) const {
    int b, s; bs_of(mb, b, s);
    float val[4];
#pragma unroll
    for (int r = 0; r < 4; ++r) val[r] = v[r] * srow[mb - m0 + r];
    if (n < 512) {
      int hh = n >> 6, cc = n & 63;
#pragma unroll
      for (int r = 0; r < 4; ++r) kn[((size_t)(b * 8 + hh) * LT + s + r) * 64 + cc] = f2bf(val[r]);
    } else {
      int j = n - 512, hh = j / 96, d = j % 96;
      U2 o = mk2(pack2(val[0], val[1]), pack2(val[2], val[3]));
      *(U2*)(vT + ((size_t)((b * 8 + hh) * 96 + d)) * LT + s) = o;
    }
  }
};
struct EpLds {
  float* buf; int m0, n0;
  DI void apply_t(int m, int nb, f32x4 v) const { *(F4*)(buf + (m - m0) * 132 + (nb - n0)) = mkf4(v[0], v[1], v[2], v[3]); }
  DI void apply(int, int, f32x4) const {}
};
struct EpFnet {
  u16* y1;
  DI void apply_t(int m, int nb, f32x4 v) const {
    int b = nb >> 8, ch = nb & 255;
    const float sc = 0.0013810679320049757f;
    *(U2*)(y1 + ((size_t)(b * 8192 + m)) * 1024 + 768 + ch) = mk2(pack2(v[0] * sc, v[1] * sc), pack2(v[2] * sc, v[3] * sc));
  }
  DI void apply(int mb, int n, f32x4 v) const {
    int b = n >> 8, ch = n & 255;
    const float sc = 0.0013810679320049757f;
#pragma unroll
    for (int r = 0; r < 4; ++r) y1[((size_t)(b * 8192 + mb + r)) * 1024 + 768 + ch] = f2bf(v[r] * sc);
  }
};

DI void rms_rows(const u16* A, int lda, int K, int m0, float* srow) {
  int tid = tidx(), row = tid >> 1, half = tid & 1;
  const u16* a = A + (size_t)(m0 + row) * lda + half * (K / 2);
  float ss = 0.f;
  for (int k = 0; k < K / 2; k += 8) {
    U4 q = *(const U4*)(a + k);
    u32 w[4] = {q.x, q.y, q.z, q.w};
#pragma unroll
    for (int e = 0; e < 4; ++e) { float lo = __uint_as_float(w[e] << 16), hi = __uint_as_float(w[e] & 0xffff0000u); ss += lo * lo + hi * hi; }
  }
  ss += __shfl_xor(ss, 1);
  if (half == 0) srow[row] = rsqrtf(ss / (float)K + LN_EPS);
}


namespace pg8 {
#define PG8_LAS __attribute__((address_space(3)))
typedef unsigned short bf16_t;
typedef short bf16x8 __attribute__((ext_vector_type(8)));
typedef float f32x4 __attribute__((ext_vector_type(4)));
typedef unsigned u32x4 __attribute__((ext_vector_type(4)));
constexpr int BM = 256, BK = 64, HALF = 128, HTB = HALF * BK * 2  , STAGE_BYTES = 8 * HTB, NXCD = 8, WGM = 8;

__host__ __device__ __forceinline__ int lds_byte(int r, int c) { const int st = (r >> 4) * 2 + (c >> 5), rr = r & 15, cc = c & 31, ob = rr * 64 + cc * 2; return st * 1024 + (ob ^ (((ob >> 9) & 1) << 5)); }
__host__ __device__ __forceinline__ void stage_rc(int b, int& R, int& C) { const int st = b / 1024, sb = b % 1024, swz = sb ^ (((sb >> 9) & 1) << 5); R = (st >> 1) * 16 + swz / 64; C = (st & 1) * 32 + (swz % 64) / 2; }
__host__ __device__ __forceinline__ int perm32(int rho) { const int n = rho >> 4, i = rho & 15; return 8 * (i >> 2) + 4 * n + (i & 3); }

struct Unit { int pm, pn; };
struct Gemm { const bf16_t* A; const bf16_t* Bt; int M, N, K; };

struct StaticOrder {
    int nM, nN, nwg, G, c;
    __host__ __device__ void init(int M, int N, int G_, int c_) { nM = M / BM; nN = N / BM; nwg = nM * nN; G = G_; c = c_; }
    __host__ __device__ bool next(int i, Unit& u) const {
        const long L = (long)i * G + c; if (L >= nwg) return false;
        int wgid = (int)L; { const int q = nwg / NXCD, r = nwg % NXCD, xcd = wgid % NXCD, off = wgid / NXCD; wgid = (xcd < r ? xcd * (q + 1) : r * (q + 1) + (xcd - r) * q) + off; }
        const int nig = WGM * nN, gid = wgid / nig, fm = gid * WGM, gsz = (nM - fm) < WGM ? (nM - fm) : WGM;
        u.pm = fm + ((wgid % nig) % gsz); u.pn = (wgid % nig) / gsz; return true;
    }
    __device__ __forceinline__ void a_ready(const Unit&) const {}
    __device__ __forceinline__ void done(const Unit&) const {}
};
template <class Epi, class Sched, bool STAMP = false>
__device__ __forceinline__ void gemm_phase(PG8_LAS unsigned char* lds, const Gemm g, const Sched& S, const Epi& E, unsigned long long* stamps) {
    const int tid = tid512(), wid = __builtin_amdgcn_readfirstlane(tid >> 6), lane = tid & 63, wr = wid >> 2, wc = wid & 3, fr = lane & 15, fq = lane >> 4;
    const int K = g.K, nt = K / BK;
    int ts_lo = 0, ts_hi = 0, nts = 0; const unsigned long long rt_entry = STAMP ? (unsigned long long)wall_clock64() : 0ull;
#define PG8_STAMP() do { if (STAMP && wid == 0 && nts < 64) { const unsigned long long _c = (unsigned long long)clock64(); \
        ts_lo = (lane == nts) ? (int)(unsigned)_c : ts_lo; ts_hi = (lane == nts) ? (int)(unsigned)(_c >> 32) : ts_hi; ++nts; } } while (0)
    PG8_STAMP();
    unsigned voffA[2], voffB[2];
#pragma unroll
    for (int i = 0; i < 2; ++i) { int R, C; stage_rc(tid * 16 + i * 8192, R, C); const int Rb = Epi::PERM ? ((R & ~31) + perm32(R & 31)) : R;
        voffA[i] = (unsigned)(R * K + C) * 2u; voffB[i] = (unsigned)(Rb * K + C) * 2u; }
    const size_t kstep = (size_t)(BK * 2);
    const size_t hstep = (size_t)HALF * K * 2;
    const size_t tstep = 2 * hstep;
    const unsigned ldsw = (unsigned)wid * 1024u;
    const int aoff = lds_byte(wr * 64 + fr, fq * 8), boff = lds_byte(wc * 32 + fr, fq * 8);
#define PG8_SA(b, h) (((b) * 2 + (h)) * HTB)
#define PG8_SB(b, h) ((4 + (b) * 2 + (h)) * HTB)
#define PG8_STAGE(bufoff, gbase, voff) do { _Pragma("unroll") for (int _i = 0; _i < 2; ++_i) \
        __builtin_amdgcn_global_load_lds((const unsigned*)((const char*)(gbase) + (voff)[_i]), (PG8_LAS unsigned*)(lds + (bufoff) + ldsw + _i * 8192), 16, 0, 0); } while (0)
#define PG8_LDA(dst, b, h) do { _Pragma("unroll") for (int m = 0; m < 4; ++m) _Pragma("unroll") for (int k = 0; k < 2; ++k) dst[m][k] = *(const PG8_LAS bf16x8*)(lds + PG8_SA(b, h) + aoff + m * 2048 + k * 1024); } while (0)
#define PG8_LDB(dst, b, h) do { _Pragma("unroll") for (int n = 0; n < 2; ++n) _Pragma("unroll") for (int k = 0; k < 2; ++k) dst[n][k] = *(const PG8_LAS bf16x8*)(lds + PG8_SB(b, h) + boff + n * 2048 + k * 1024); } while (0)
#define PG8_MMA(ai, bj, At, Bt) do { __builtin_amdgcn_s_setprio(1); _Pragma("unroll") for (int m = 0; m < 4; ++m) _Pragma("unroll") for (int n = 0; n < 2; ++n) _Pragma("unroll") for (int k = 0; k < 2; ++k) \
        acc[ai][bj][m][n] = __builtin_amdgcn_mfma_f32_16x16x32_bf16(Bt[n][k], At[m][k], acc[ai][bj][m][n], 0, 0, 0); __builtin_amdgcn_s_setprio(0); } while (0)
#define PG8_WAIT_V(n) asm volatile("s_waitcnt vmcnt(" #n ")" ::: "memory")
#define PG8_WAIT_L(n) asm volatile("s_waitcnt lgkmcnt(" #n ")" ::: "memory")
#define PG8_BAR __builtin_amdgcn_s_barrier()
#define PG8_SCHED __builtin_amdgcn_sched_barrier(0)
    Unit cur, nxt; int ui = 0;
    if (!S.next(0, cur)) return;
    f32x4 acc[2][2][4][2];
#pragma unroll
    for (int a = 0; a < 2; ++a)
#pragma unroll
        for (int b = 0; b < 2; ++b)
#pragma unroll
            for (int m = 0; m < 4; ++m)
#pragma unroll
                for (int n = 0; n < 2; ++n) acc[a][b][m][n] = (f32x4){0.f, 0.f, 0.f, 0.f};
    bf16x8 At[4][2], B0[2][2], B1[2][2];
    const char* cA = (const char*)g.A + (size_t)cur.pm * tstep; const char* cB = (const char*)g.Bt + (size_t)cur.pn * tstep;
    S.a_ready(cur);
    PG8_STAGE(PG8_SB(0, 0), cB, voffB); PG8_STAGE(PG8_SA(0, 0), cA, voffA); PG8_STAGE(PG8_SB(0, 1), cB + hstep, voffB); PG8_STAGE(PG8_SA(0, 1), cA + hstep, voffA);
    if (wr == 1) PG8_BAR;
    PG8_WAIT_V(4); PG8_BAR;
    PG8_STAGE(PG8_SB(1, 0), cB + kstep, voffB); PG8_STAGE(PG8_SA(1, 0), cA + kstep, voffA); PG8_STAGE(PG8_SB(1, 1), cB + hstep + kstep, voffB);
    PG8_WAIT_V(6); PG8_BAR;
    PG8_STAMP();
    for (;;) {
        const bool has_next = S.next(ui + 1, nxt);
        const char* nA = has_next ? (const char*)g.A + (size_t)nxt.pm * tstep : cA; const char* nB = has_next ? (const char*)g.Bt + (size_t)nxt.pn * tstep : cB;
        for (int t = 0; t < nt; t += 2) {
            const bool last = (t == nt - 2);
            const char* a1 = cA + (size_t)(t + 1) * kstep;
            const char* a2 = last ? nA : cA + (size_t)(t + 2) * kstep; const char* b2 = last ? nB : cB + (size_t)(t + 2) * kstep;
            const char* a3 = a2 + kstep; const char* b3 = b2 + kstep;
            if (last && has_next) S.a_ready(nxt);
            PG8_LDB(B0, 0, 0); PG8_SCHED; PG8_LDA(At, 0, 0); PG8_STAGE(PG8_SA(1, 1), a1 + hstep, voffA);
            PG8_WAIT_L(8); PG8_BAR; PG8_WAIT_L(0); PG8_MMA(0, 0, At, B0); PG8_BAR; PG8_SCHED;
            PG8_LDB(B1, 0, 1); PG8_STAGE(PG8_SB(0, 0), b2, voffB);
            PG8_BAR; PG8_WAIT_L(0); PG8_MMA(0, 1, At, B1); PG8_BAR;
            PG8_LDA(At, 0, 1); PG8_STAGE(PG8_SA(0, 0), a2, voffA);
            PG8_BAR; PG8_WAIT_L(0); PG8_MMA(1, 0, At, B0); PG8_BAR; PG8_SCHED;
            PG8_STAGE(PG8_SB(0, 1), b2 + hstep, voffB);
            PG8_WAIT_V(6); PG8_BAR; PG8_MMA(1, 1, At, B1); PG8_BAR;
            PG8_LDB(B0, 1, 0); PG8_SCHED; PG8_LDA(At, 1, 0); PG8_STAGE(PG8_SA(0, 1), a2 + hstep, voffA);
            PG8_WAIT_L(8); PG8_BAR; PG8_WAIT_L(0); PG8_MMA(0, 0, At, B0); PG8_BAR; PG8_SCHED;
            PG8_LDB(B1, 1, 1); PG8_STAGE(PG8_SB(1, 0), b3, voffB);
            PG8_BAR; PG8_WAIT_L(0); PG8_MMA(0, 1, At, B1); PG8_BAR;
            PG8_LDA(At, 1, 1); PG8_STAGE(PG8_SA(1, 0), a3, voffA);
            PG8_BAR; PG8_WAIT_L(0); PG8_MMA(1, 0, At, B0); PG8_BAR; PG8_SCHED;
            PG8_STAGE(PG8_SB(1, 1), b3 + hstep, voffB);
            PG8_WAIT_V(6); PG8_BAR; PG8_MMA(1, 1, At, B1); PG8_BAR;
        }
        PG8_STAMP();
        if constexpr (!Epi::AFTER_DRAIN) { E(acc, cur, wr, wc, fr, fq); S.done(cur); }
        PG8_STAMP();
        if (!has_next) break;
#pragma unroll
        for (int a = 0; a < 2; ++a)
#pragma unroll
            for (int b = 0; b < 2; ++b)
#pragma unroll
                for (int m = 0; m < 4; ++m)
#pragma unroll
                    for (int n = 0; n < 2; ++n) acc[a][b][m][n] = (f32x4){0.f, 0.f, 0.f, 0.f};
        cur = nxt; cA = nA; cB = nB; ++ui;
    }
    PG8_WAIT_V(0);
    if (wr == 0) PG8_BAR;
    PG8_BAR;
    if constexpr (Epi::AFTER_DRAIN) { E.fused(acc, cur, wr, wc, fr, fq, lds, wid, lane); S.done(cur); }
    PG8_STAMP();
    if (STAMP && wid == 0) { stamps[lane] = lane < nts ? (((unsigned long long)(unsigned)ts_hi << 32) | (unsigned)ts_lo) : 0ull;
        if (lane == 62) stamps[62] = rt_entry; if (lane == 63) stamps[63] = (unsigned long long)wall_clock64(); }
#undef PG8_STAMP
#undef PG8_SA
#undef PG8_SB
#undef PG8_STAGE
#undef PG8_LDA
#undef PG8_LDB
#undef PG8_MMA
#undef PG8_WAIT_V
#undef PG8_WAIT_L
#undef PG8_BAR
#undef PG8_SCHED
}
}

template <class EP, bool SWAPROLE> struct EpiAdapt {
  static constexpr bool PERM = false, AFTER_DRAIN = false;
  EP ep; int roff, coff;
  DI void operator()(const f32x4 (&acc)[2][2][4][2], const pg8::Unit& u, int wr, int wc, int fr, int fq) const {
    const int row0 = u.pm * 256 + wr * 64 + fr + roff, col0 = u.pn * 256 + wc * 32 + 4 * fq + coff;
#pragma unroll
    for (int ai = 0; ai < 2; ++ai)
#pragma unroll
      for (int m = 0; m < 4; ++m)
#pragma unroll
        for (int bj = 0; bj < 2; ++bj)
#pragma unroll
          for (int n = 0; n < 2; ++n) {
            const int r = row0 + ai * 128 + m * 16, c = col0 + bj * 128 + n * 16;
            if (SWAPROLE) ep.apply(c, r, acc[ai][bj][m][n]);
            else ep.apply_t(r, c, acc[ai][bj][m][n]);
          }
  }
};
template <class EP, bool SWAPROLE>
DI void run_phase(char* smem_all, const u16* A, const u16* Bt, int M, int N, int K, const EP& ep, int roff, int coff) {
  pg8::Gemm g; g.A = A; g.Bt = Bt; g.M = M; g.N = N; g.K = K;
  pg8::StaticOrder S; S.init(M, N, (int)gridDim.x, rbidx());
  EpiAdapt<EP, SWAPROLE> E; E.ep = ep; E.roff = roff; E.coff = coff;
  __syncthreads();
  pg8::gemm_phase<EpiAdapt<EP, SWAPROLE>, pg8::StaticOrder, false>((PG8_LAS unsigned char*)smem_all, g, S, E, nullptr);
  __syncthreads();
}

DI void tr_tile(const float* src, int K, int N, int Nvalid, u16* dst, const float* gk, int tile, char* smem, bool perm_ukv) {
  float* t = (float*)smem;
  int ntn = N / 64, kt = tile / ntn, nt = tile % ntn, k0 = kt * 64, n0 = nt * 64, tid = tidx();
#pragma unroll
  for (int ps = 0; ps < 4; ++ps) {
    int i = ps * 16 + (tid >> 4), j = (tid & 15) * 4;
    F4 v = mkf4(0.f, 0.f, 0.f, 0.f);
    if (n0 + j < Nvalid) v = *(const F4*)(src + (size_t)(k0 + i) * Nvalid + n0 + j);
    float sc = gk ? gk[k0 + i] : 1.f;
    t[i * 65 + j] = v.x * sc; t[i * 65 + j + 1] = v.y * sc; t[i * 65 + j + 2] = v.z * sc; t[i * 65 + j + 3] = v.w * sc;
  }
  __syncthreads();
  int n = tid >> 2, kc = (tid & 3) * 16;
  u32 o[8];
#pragma unroll
  for (int e = 0; e < 8; ++e) o[e] = pack2(t[(kc + 2 * e) * 65 + n], t[(kc + 2 * e + 1) * 65 + n]);
  int nn = n0 + n;
  if (perm_ukv) { int hh = nn / 160, cc = nn % 160; nn = cc < 64 ? hh * 64 + cc : 512 + hh * 96 + (cc - 64); }
  U4* d = (U4*)(dst + (size_t)nn * K + k0 + kc);
  d[0] = mk4(o[0], o[1], o[2], o[3]);
  d[1] = mk4(o[4], o[5], o[6], o[7]);
}

DI void mod_item(const Params& p, int it, char* smem) {
  float* sc = (float*)smem;
  float* red = sc + 5 * 1024;
  int l = it / 96, chunk = it % 96, tid = tidx(), lane = tid & 63, w = tid >> 6;
  for (int e = tid; e < 5 * 1024; e += 256) {
    int r = e >> 10, k = e & 1023;
    float v = r < 4 ? p.c[r * 1024 + k] : p.c_ctx[k];
    sc[e] = v / (1.f + __expf(-v));
  }
  __syncthreads();
  int n = chunk * 64 + lane;
  const float* W = p.mod_w + (size_t)l * 1024 * 6144 + n;
  float a0 = 0, a1 = 0, a2 = 0, a3 = 0, a4 = 0;
#pragma unroll 16
  for (int kk = 0; kk < 256; ++kk) {
    int k = w * 256 + kk;
    float wv = W[(size_t)k * 6144];
    a0 += sc[k] * wv; a1 += sc[1024 + k] * wv; a2 += sc[2048 + k] * wv; a3 += sc[3072 + k] * wv; a4 += sc[4096 + k] * wv;
  }
  red[(w * 5 + 0) * 64 + lane] = a0; red[(w * 5 + 1) * 64 + lane] = a1; red[(w * 5 + 2) * 64 + lane] = a2;
  red[(w * 5 + 3) * 64 + lane] = a3; red[(w * 5 + 4) * 64 + lane] = a4;
  __syncthreads();
  if (w == 0) {
    float bv = p.mod_b[l * 6144 + n];
    float* o = (float*)(wsp(p) + O_MOD) + (size_t)l * 5 * 6144 + n;
#pragma unroll
    for (int r = 0; r < 5; ++r) o[r * 6144] = red[(0 * 5 + r) * 64 + lane] + red[(1 * 5 + r) * 64 + lane] + red[(2 * 5 + r) * 64 + lane] + red[(3 * 5 + r) * 64 + lane] + bv;
  }
}

DI void filt_item(const Params& p, char* smem, int Lf, int p0, u16* Tg) {
  const int TgLen = 2 * Lf, tid = tidx();
  float* zf = (float*)smem;
  float* h1 = zf + 32 * 33;
  float* w1s = h1 + 32 * 64;
  float* w2s = w1s + 33 * 64;
  float* h2 = w2s + 64 * 64;
  u16* st = (u16*)smem;
  constexpr int STR = 258;
  for (int e = tid; e < 33 * 64; e += 256) w1s[e] = p.hy_w1[e];
  for (int e = tid; e < 64 * 64; e += 256) w2s[e] = p.hy_w2[e];
#pragma unroll 1
  for (int batch = 0; batch < 2; ++batch) {
    for (int e = tid; e < 32 * 33; e += 256) {
      int pos = e / 33, f = e % 33; float pp = (float)(p0 + 32 * batch + pos);
      float t = pp / (float)(Lf - 1), wv = 6.283185307179586f * pp / (float)Lf, val;
      if (f == 0) val = t;
      else {
        int fi = (f - 1) & 15;
        float fr = 1e-4f + (float)fi * ((15.f - 1e-4f) / 15.f);
        val = (f <= 16) ? cosf(wv * fr) : -sinf(wv * fr);
      }
      zf[e] = val;
    }
    __syncthreads();
    {
      int pos = tid >> 3, ug = tid & 7;
      float acc[8];
#pragma unroll
      for (int uu = 0; uu < 8; ++uu) acc[uu] = p.hy_b1[ug + 8 * uu];
#pragma unroll 3
      for (int f = 0; f < 33; ++f) {
        float z = zf[pos * 33 + f];
#pragma unroll
        for (int uu = 0; uu < 8; ++uu) acc[uu] += z * w1s[f * 64 + ug + 8 * uu];
      }
#pragma unroll
      for (int uu = 0; uu < 8; ++uu) h1[pos * 64 + ug + 8 * uu] = sinf(p.hy_freq[ug + 8 * uu] * acc[uu]);
    }
    __syncthreads();
    {
      int pos = tid >> 3, ug = tid & 7;
      float acc[8];
#pragma unroll
      for (int uu = 0; uu < 8; ++uu) acc[uu] = p.hy_b2[ug + 8 * uu];
#pragma unroll 4
      for (int f = 0; f < 64; ++f) {
        float z = h1[pos * 64 + f];
#pragma unroll
        for (int uu = 0; uu < 8; ++uu) acc[uu] += z * w2s[f * 64 + ug + 8 * uu];
      }
#pragma unroll
      for (int uu = 0; uu < 8; ++uu) h2[(32 * batch + pos) * 64 + ug + 8 * uu] = sinf(p.hy_freq[ug + 8 * uu] * acc[uu]);
    }
    __syncthreads();
  }
#pragma unroll 1
  for (int cc = 0; cc < 8; ++cc) {
    int col = cc * 256 + tid;
    float w3r[64];
#pragma unroll
    for (int u = 0; u < 64; ++u) w3r[u] = p.hy_w3[u * 2048 + col];
    float ld = __expf(p.hy_log_decay[col]);
    int conv = col >> 10, dir = (col >> 9) & 1, c = col & 511;
    float skipv = p.hy_skip[conv * 512 + c];
#pragma unroll 1
    for (int pos = 0; pos < 64; ++pos) {
      float a = 0.f;
#pragma unroll
      for (int u = 0; u < 64; ++u) a += h2[pos * 64 + u] * w3r[u];
      int pp = p0 + pos;
      float t = (float)pp / (float)(Lf - 1);
      float val = a * __expf(-t * ld);
      if (pp == 0) val = (dir == 0) ? (val + skipv) : 0.f;
      st[pos * STR + tid] = f2bf(val);
    }
    __syncthreads();
#pragma unroll 1
    for (int k = 0; k < 64; ++k) {
      int cl = (tid >> 6) + 4 * k, pos = tid & 63, colw = cc * 256 + cl, pp = p0 + pos;
      int conv2 = colw >> 10, dir2 = (colw >> 9) & 1, c2 = colw & 511;
      Tg[(size_t)(conv2 * 512 + c2) * TgLen + dir2 * Lf + pp] = st[pos * STR + cl];
    }
    __syncthreads();
  }
}

constexpr int NT_TR = 768 + 256 + 1024 + 1024 + 1024 + 1024 + 256 + 256 + 72 + 80;
constexpr int N_PREP = NT_TR + 192 + 128 + 4;

DI void phase_prep(const Params& p, char* smem) {
  char* ws = wsp(p);
  for (int it = bidx(); it < N_PREP; it += NVB) {
    __syncthreads();
    int t = it;
    if (t < NT_TR) {
      const float* src; int K, N, Nv; u16* dst; const float* gk = nullptr; bool perm = false;
      if (t < 768) { src = p.ab_w_in; K = 1024; N = 3072; Nv = 3072; dst = (u16*)(ws + O_WT_ABIN); }
      else if ((t -= 768) < 256) { src = p.ab_w_out; K = 1024; N = 1024; Nv = 1024; dst = (u16*)(ws + O_WT_ABOUT); }
      else if ((t -= 256) < 2048) { int l = t >> 10; t &= 1023; src = p.mlp_w1 + (size_t)l * 1024 * 4096; K = 1024; N = 4096; Nv = 4096; dst = (u16*)(ws + O_WT_W1) + (size_t)l * 4096 * 1024; }
      else if ((t -= 2048) < 2048) { int l = t >> 10; t &= 1023; src = p.mlp_w2 + (size_t)l * 1024 * 4096; K = 4096; N = 1024; Nv = 1024; dst = (u16*)(ws + O_WT_W2) + (size_t)l * 4096 * 1024; }
      else if ((t -= 2048) < 256) { src = p.cd_w_in; K = 1024; N = 1024; Nv = 928; dst = (u16*)(ws + O_WT_CDIN); }
      else if ((t -= 256) < 256) { src = p.cd_w_out; K = 1024; N = 1024; Nv = 1024; dst = (u16*)(ws + O_WT_CDOUT); }
      else if ((t -= 256) < 72) { src = p.mla_w_uq; K = 384; N = 768; Nv = 768; dst = (u16*)(ws + O_WT_UQ); gk = p.mla_q_norm; }
      else { t -= 72; src = p.mla_w_ukv; K = 256; N = 1280; Nv = 1280; dst = (u16*)(ws + O_WT_UKV); gk = p.mla_kv_norm; perm = true; }
      tr_tile(src, K, N, Nv, dst, gk, t, smem, perm);
      continue;
    }
    t -= NT_TR;
    if (t < 192) { mod_item(p, t, smem); continue; }
    t -= 192;
    int Lf = SEQL; u16* Tg = (u16*)(ws + O_TLAT);
    if (t >= 128) { t -= 128; Lf = LC; Tg = (u16*)(ws + O_TCTX); }
    filt_item(p, smem, Lf, t * 64, Tg);
  }
}

template <bool FROM_IN, bool AFFINE, bool MOD>
DI void phase_ln(const Params& p, int nrows, const float* g, const float* bb, float* dst, bool dst_is_S, int lmod, int shoff,
                 int scoff) {
  const int lane = tidx() & 63, wv = tidx() >> 6;
  const int gw = bidx() * 4 + wv, nw = NVB * 4;
  float* S = (float*)(wsp(p) + O_S);
  u16* hbuf = (u16*)(wsp(p) + O_HBUF);
  for (int m = gw; m < nrows; m += nw) {
    const float* src;
    if (FROM_IN) src = (m < NLAT) ? p.x + (size_t)m * 1024 : p.ctx + (size_t)(m - NLAT) * 1024;
    else src = S + (size_t)m * 1024;
    float v[16];
#pragma unroll
    for (int i = 0; i < 4; ++i) {
      F4 q = *(const F4*)(src + i * 256 + lane * 4);
      v[4 * i] = q.x; v[4 * i + 1] = q.y; v[4 * i + 2] = q.z; v[4 * i + 3] = q.w;
    }
    if (AFFINE) {
      float s = 0.f;
#pragma unroll
      for (int i = 0; i < 16; ++i) s += v[i];
      float mu = wave_sum(s) * (1.f / 1024.f);
      float q2 = 0.f;
#pragma unroll
      for (int i = 0; i < 16; ++i) { float d = v[i] - mu; q2 += d * d; }
      float rstd = rsqrtf(wave_sum(q2) * (1.f / 1024.f) + LN_EPS);
      float* drow = dst_is_S ? (S + (size_t)m * 1024) : (dst + (size_t)m * 1024);
#pragma unroll
      for (int i = 0; i < 4; ++i) {
        int e = i * 256 + lane * 4;
        F4 gg = *(const F4*)(g + e), b4 = *(const F4*)(bb + e);
        v[4 * i] = (v[4 * i] - mu) * rstd * gg.x + b4.x;
        v[4 * i + 1] = (v[4 * i + 1] - mu) * rstd * gg.y + b4.y;
        v[4 * i + 2] = (v[4 * i + 2] - mu) * rstd * gg.z + b4.z;
        v[4 * i + 3] = (v[4 * i + 3] - mu) * rstd * gg.w + b4.w;
        *(F4*)(drow + e) = mkf4(v[4 * i], v[4 * i + 1], v[4 * i + 2], v[4 * i + 3]);
      }
    }
    if (MOD) {
      float s = 0.f;
#pragma unroll
      for (int i = 0; i < 16; ++i) s += v[i];
      float mu = wave_sum(s) * (1.f / 1024.f);
      float q2 = 0.f;
#pragma unroll
      for (int i = 0; i < 16; ++i) { float d = v[i] - mu; q2 += d * d; }
      float rstd = rsqrtf(wave_sum(q2) * (1.f / 1024.f) + LN_EPS);
      const float* md = modp(p, lmod, bidx_of(m));
#pragma unroll
      for (int i = 0; i < 4; ++i) {
        int e = i * 256 + lane * 4;
        F4 sh = *(const F4*)(md + shoff + e), sc = *(const F4*)(md + scoff + e);
        float o0 = (v[4 * i] - mu) * rstd * (1.f + sc.x) + sh.x;
        float o1 = (v[4 * i + 1] - mu) * rstd * (1.f + sc.y) + sh.y;
        float o2 = (v[4 * i + 2] - mu) * rstd * (1.f + sc.z) + sh.z;
        float o3 = (v[4 * i + 3] - mu) * rstd * (1.f + sc.w) + sh.w;
        *(U2*)(hbuf + (size_t)m * 1024 + e) = mk2(pack2(o0, o1), pack2(o2, o3));
      }
    }
  }
}

DI bf16x8 toep_frag(const u32* Tr32, int o) {
  int wd = o >> 1; u32 sh = (o & 1) * 16;
  u32 d0 = Tr32[wd], d1 = Tr32[wd + 1], d2 = Tr32[wd + 2], d3 = Tr32[wd + 3], d4 = Tr32[wd + 4];
  U4 q = mk4(__builtin_amdgcn_alignbit(d1, d0, sh), __builtin_amdgcn_alignbit(d2, d1, sh),
                       __builtin_amdgcn_alignbit(d3, d2, sh), __builtin_amdgcn_alignbit(d4, d3, sh));
  return __builtin_bit_cast(bf16x8, q);
}

DI void toep_item(const Params& p, char* smem, int cv, int c, int bp) {
  const int tid = tidx(), lane = tid & 63, w = tid >> 6, r16 = lane & 15, g = lane >> 4;
  u16* Tr = (u16*)smem;
  u16* Zs = Tr + 16384 + 16;
  const u16* uhyT = (const u16*)(wsp(p) + O_UHYT);
  u16* zT = (u16*)(wsp(p) + O_ZT);
  u16* yhyT = (u16*)(wsp(p) + O_YHYT);
  {
    const u16* GF = (const u16*)(wsp(p) + O_TLAT) + (size_t)(cv * 512 + c) * 16384;
    const U4* GB = (const U4*)(GF + 8192);
    const u16 t0v = GF[0];
    for (int e = tid; e < 1024; e += 256) {
      U4 q = GB[e];
      if (e == 0) q.x = (q.x & 0xffff0000u) | (u32)t0v;
      ((U4*)Tr)[1024 + e] = q;
    }
    for (int e = tid; e < 1024; e += 256) {
      U4 q = ((const U4*)GF)[e];
      u16* d = Tr + 8192 - 8 * e;
      d[0] = (u16)(q.x); d[-1] = (u16)(q.x >> 16); d[-2] = (u16)(q.y); d[-3] = (u16)(q.y >> 16);
      d[-4] = (u16)(q.z); d[-5] = (u16)(q.z >> 16); d[-6] = (u16)(q.w); d[-7] = (u16)(q.w >> 16);
    }
    if (tid == 0) Tr[0] = 0;
    if (tid < 2) { u32 z = 0; asm volatile("" : "+v"(z)); ((U4*)Tr)[2048 + tid] = mk4(z, z, z, z); }
  }
  for (int bb = 0; bb < 2; ++bb) {
    int b = 2 * bp + bb;
    if (cv == 0) {
      const u16* src = uhyT + ((size_t)(b * 1536 + 1024 + c)) * LT;
      float w0 = p.hy_conv_w[1024 + c], w1 = p.hy_conv_w[1536 + 1024 + c], w2 = p.hy_conv_w[2 * 1536 + 1024 + c];
      for (int e = tid; e < 1024; e += 256) {
        int s0 = e * 8;
        U4 q = *(const U4*)(src + s0);
        float u[10];
        u[0] = s0 > 0 ? bf2f(src[s0 - 1]) : 0.f;
        u[9] = s0 + 8 < SEQL ? bf2f(src[s0 + 8]) : 0.f;
        u32 ww[4] = {q.x, q.y, q.z, q.w};
#pragma unroll
        for (int k = 0; k < 4; ++k) { u[1 + 2 * k] = __uint_as_float(ww[k] << 16); u[2 + 2 * k] = __uint_as_float(ww[k] & 0xffff0000u); }
        float o[8];
#pragma unroll
        for (int k = 0; k < 8; ++k) o[k] = w0 * u[k] + w1 * u[k + 1] + w2 * u[k + 2];
        *(U4*)(Zs + bb * 8192 + s0) = mk4(pack2(o[0], o[1]), pack2(o[2], o[3]), pack2(o[4], o[5]), pack2(o[6], o[7]));
      }
    } else {
      const U4* src = (const U4*)(zT + ((size_t)(b * 512 + c)) * LT);
      for (int e = tid; e < 1024; e += 256) ((U4*)(Zs + bb * 8192))[e] = src[e];
    }
  }
  __syncthreads();
  const int bb = w >> 1, hw = w & 1;
  const u16* Zb = Zs + bb * 8192;
  const u32* Tr32 = (const u32*)Tr;
  f32x4 acc[4][4];
#pragma unroll
  for (int i = 0; i < 4; ++i)
#pragma unroll
    for (int j = 0; j < 4; ++j) acc[i][j] = f32x4{0.f, 0.f, 0.f, 0.f};
  const int obase = 8192 - r16 + 8 * g;
  const int dl_lo = hw ? -63 : -127, dl_hi = hw ? 127 : 63;
  bf16x8 F[6];
#pragma unroll
  for (int e = 0; e < 6; ++e) F[e] = toep_frag(Tr32, obase - 16 * (4 * dl_lo - 2 + e));
  for (int dl = dl_lo; dl <= dl_hi; ++dl) {
    int lo = dl > 0 ? dl : 0, hi = dl < 0 ? 127 + dl : 127;
    bf16x8 Fn[4];
    {
      int dn = dl < dl_hi ? dl + 1 : dl;
#pragma unroll
      for (int e = 0; e < 4; ++e) Fn[e] = toep_frag(Tr32, obase - 16 * (4 * dn + e));
    }
#pragma unroll
    for (int nt = 0; nt < 4; ++nt) {
      int t1lo = 64 * hw + 16 * nt;
      if (t1lo + 15 < lo || t1lo > hi) continue;
      int s1 = t1lo + r16 - dl;
      bool ok = (s1 >= 0) && (s1 < 128);
      int s1c = ok ? s1 : 0;
#pragma unroll
      for (int ks = 0; ks < 2; ++ks) {
        U4 q = *(const U4*)(Zb + 64 * s1c + 32 * ks + 8 * g);
        if (!ok) q = mk4(0, 0, 0, 0);
        bf16x8 bfr = __builtin_bit_cast(bf16x8, q);
#pragma unroll
        for (int mt = 0; mt < 4; ++mt) acc[mt][nt] = mfma16(F[mt - 2 * ks + 2], bfr, acc[mt][nt]);
      }
    }
    F[0] = F[4]; F[1] = F[5]; F[2] = Fn[0]; F[3] = Fn[1]; F[4] = Fn[2]; F[5] = Fn[3];
  }
  {
    int b = 2 * bp + bb, choff = (cv == 0) ? 0 : 512;
    const u16* xr = uhyT + ((size_t)(b * 1536 + choff + c)) * LT;
    float w0 = p.hy_conv_w[choff + c], w1 = p.hy_conv_w[1536 + choff + c], w2 = p.hy_conv_w[2 * 1536 + choff + c];
    u16* dst = (cv == 0 ? zT : yhyT) + ((size_t)(b * 512 + c)) * LT;
#pragma unroll
    for (int mt = 0; mt < 4; ++mt)
#pragma unroll
      for (int nt = 0; nt < 4; ++nt) {
        int t = 64 * (64 * hw + 16 * nt + r16) + 16 * mt + 4 * g;
        U2 q = *(const U2*)(xr + t);
        float u[6];
        u[0] = t > 0 ? bf2f(xr[t - 1]) : 0.f;
        u[5] = t + 4 < SEQL ? bf2f(xr[t + 4]) : 0.f;
        u[1] = __uint_as_float(q.x << 16); u[2] = __uint_as_float(q.x & 0xffff0000u);
        u[3] = __uint_as_float(q.y << 16); u[4] = __uint_as_float(q.y & 0xffff0000u);
        float o[4];
#pragma unroll
        for (int r = 0; r < 4; ++r) o[r] = (w0 * u[r] + w1 * u[r + 1] + w2 * u[r + 2]) * acc[mt][nt][r];
        *(U2*)(dst + t) = mk2(pack2(o[0], o[1]), pack2(o[2], o[3]));
      }
  }
}

DI void toep_ctx_item(const Params& p, char* smem, int cv, int c) {
  const int tid = tidx();
  float* Tf = (float*)smem;
  float* zf = Tf + 512;
  const u16* uhyT = (const u16*)(wsp(p) + O_UHYT);
  u16* zT = (u16*)(wsp(p) + O_ZT);
  u16* yhyT = (u16*)(wsp(p) + O_YHYT);
  const u16* Tg = (const u16*)(wsp(p) + O_TCTX) + (size_t)(cv * 512 + c) * 512;
  Tf[256 - tid] = bf2f(Tg[tid]);
  if (tid > 0) Tf[256 + tid] = bf2f(Tg[256 + tid]);
  if (tid == 0) Tf[0] = 0.f;
  for (int b = 0; b < 4; ++b) {
    float zv;
    if (cv == 0) {
      const u16* src = uhyT + ((size_t)(b * 1536 + 1024 + c)) * LT + SEQL;
      float w0 = p.hy_conv_w[1024 + c], w1 = p.hy_conv_w[1536 + 1024 + c], w2 = p.hy_conv_w[2 * 1536 + 1024 + c];
      float um = tid > 0 ? bf2f(src[tid - 1]) : 0.f, u0 = bf2f(src[tid]), up = tid < 255 ? bf2f(src[tid + 1]) : 0.f;
      zv = bf2f(f2bf(w0 * um + w1 * u0 + w2 * up));
    } else {
      zv = bf2f(zT[((size_t)(b * 512 + c)) * LT + SEQL + tid]);
    }
    zf[b * 256 + tid] = zv;
  }
  __syncthreads();
  int choff = (cv == 0) ? 0 : 512;
  float w0 = p.hy_conv_w[choff + c], w1 = p.hy_conv_w[1536 + choff + c], w2 = p.hy_conv_w[2 * 1536 + choff + c];
  for (int b = 0; b < 4; ++b) {
    float y = 0.f;
    for (int s = 0; s < 256; ++s) y += Tf[256 - (tid - s)] * zf[b * 256 + s];
    const u16* xr = uhyT + ((size_t)(b * 1536 + choff + c)) * LT + SEQL;
    float um = tid > 0 ? bf2f(xr[tid - 1]) : 0.f, u0 = bf2f(xr[tid]), up = tid < 255 ? bf2f(xr[tid + 1]) : 0.f;
    float o = (w0 * um + w1 * u0 + w2 * up) * y;
    u16* dst = (cv == 0 ? zT : yhyT) + ((size_t)(b * 512 + c)) * LT + SEQL;
    dst[tid] = f2bf(o);
  }
}

DI void natten_wave(const Params& p, u16* Pw, int b, int h, bool lat, int r, int j, int qt) {
  const int lane = tidx() & 63, r16 = lane & 15, g = lane >> 4;
  const u16* uqk = (const u16*)(wsp(p) + O_UQK);
  const u16* vT = (const u16*)(wsp(p) + O_VT0);
  u16* yna = (u16*)(wsp(p) + O_YNA);
  const int qm0 = lat ? b * 8192 + r * 64 + 16 * j : NLAT + b * 256 + 16 * qt;
  bf16x8 qa[2];
#pragma unroll
  for (int ks = 0; ks < 2; ++ks) qa[ks] = *(const bf16x8*)(uqk + (size_t)(qm0 + r16) * 1024 + h * 64 + 32 * ks + 8 * g);
  int rs = r - 4; rs = rs < 0 ? 0 : (rs > 120 ? 120 : rs);
  int kb = 16 * j - 8; kb = kb < 0 ? 0 : (kb > 32 ? 32 : kb);
  f32x4 S[32];
  const float NEG = -1e30f;
  const float* rpb = p.na_rpb + h * 15 * 31;
#pragma unroll
  for (int nt = 0; nt < 32; ++nt) {
    if (nt < 16 && !lat) { S[nt] = f32x4{NEG, NEG, NEG, NEG}; continue; }
    if ((nt & 7) == 0) __builtin_amdgcn_sched_barrier(0);
    int keytok;
    if (nt < 16) keytok = b * 8192 + (rs + (nt >> 1)) * 64 + kb + 16 * (nt & 1) + r16;
    else keytok = NLAT + b * 256 + 16 * (nt - 16) + r16;
    const u16* kp = uqk + (size_t)keytok * 1024 + 512 + h * 64 + 8 * g;
    f32x4 a = f32x4{0.f, 0.f, 0.f, 0.f};
    a = mfma16(qa[0], *(const bf16x8*)(kp), a);
    a = mfma16(qa[1], *(const bf16x8*)(kp + 32), a);
    if (nt < 16) {
      int rr = nt >> 1, kcol = kb + 16 * (nt & 1) + r16, dr = rs + rr - r + 7;
#pragma unroll
      for (int q = 0; q < 4; ++q) {
        int qcol = 16 * j + 4 * g + q;
        int cs = qcol - 8; cs = cs < 0 ? 0 : (cs > 48 ? 48 : cs);
        bool valid = (kcol >= cs) && (kcol < cs + 16);
        int dc = kcol - qcol + 15; dc = dc < 0 ? 0 : (dc > 30 ? 30 : dc);
        float bias = rpb[dr * 31 + dc];
        a[q] = valid ? (a[q] * 0.125f + bias) * LOG2E : NEG;
      }
    } else {
#pragma unroll
      for (int q = 0; q < 4; ++q) a[q] = a[q] * (0.125f * LOG2E);
    }
    S[nt] = a;
  }
  float mx[4], sm[4];
#pragma unroll
  for (int q = 0; q < 4; ++q) {
    float m = NEG;
#pragma unroll
    for (int nt = 0; nt < 32; ++nt) m = fmaxf(m, S[nt][q]);
    m = fmaxf(m, __shfl_xor(m, 1)); m = fmaxf(m, __shfl_xor(m, 2)); m = fmaxf(m, __shfl_xor(m, 4)); m = fmaxf(m, __shfl_xor(m, 8));
    mx[q] = m; sm[q] = 0.f;
  }
#pragma unroll
  for (int nt = 0; nt < 32; ++nt) {
    if (nt < 16 && !lat) continue;
#pragma unroll
    for (int q = 0; q < 4; ++q) {
      float pv = __builtin_amdgcn_exp2f(S[nt][q] - mx[q]);
      u16 pb = f2bf(pv);
      sm[q] += bf2f(pb);
      Pw[(4 * g + q) * 520 + 16 * nt + r16] = pb;
    }
  }
#pragma unroll
  for (int q = 0; q < 4; ++q) {
    float s = sm[q];
    s += __shfl_xor(s, 1); s += __shfl_xor(s, 2); s += __shfl_xor(s, 4); s += __shfl_xor(s, 8);
    sm[q] = 1.f / s;
  }
  __syncthreads();
  f32x4 O[4];
#pragma unroll
  for (int nt = 0; nt < 4; ++nt) O[nt] = f32x4{0.f, 0.f, 0.f, 0.f};
#pragma unroll
  for (int ks = 0; ks < 16; ++ks) {
    if (ks < 8 && !lat) continue;
    bf16x8 pa = *(const bf16x8*)(Pw + r16 * 520 + 32 * ks + 8 * g);
    size_t vcol = ks < 8 ? (size_t)(rs + ks) * 64 + kb + 8 * g : (size_t)SEQL + 32 * (ks - 8) + 8 * g;
#pragma unroll
    for (int nt = 0; nt < 4; ++nt) {
      bf16x8 vb = *(const bf16x8*)(vT + ((size_t)(b * 512 + h * 64 + 16 * nt + r16)) * LT + vcol);
      O[nt] = mfma16(pa, vb, O[nt]);
    }
  }
#pragma unroll
  for (int nt = 0; nt < 4; ++nt)
#pragma unroll
    for (int q = 0; q < 4; ++q) yna[(size_t)(qm0 + 4 * g + q) * 512 + h * 64 + 16 * nt + r16] = f2bf(O[nt][q] * sm[q]);
}

constexpr int SK_ROW = 104, SV_ROW = 68;
constexpr int MLA_STAGE = 64 * SK_ROW + 96 * SV_ROW;
DI void mla_part1(const u16* sK, const bf16x8 (&qf)[6], f32x16 (&O)[3], float& mrun, float& lrun, bf16x8 (&pf)[4], int c32, int h2) {
  f32x16 S[2];
#pragma unroll
  for (int mt = 0; mt < 2; ++mt) {
    f32x16 a;
#pragma unroll
    for (int i = 0; i < 16; ++i) a[i] = 0.f;
#pragma unroll
    for (int ks = 0; ks < 6; ++ks) {
      bf16x8 kf = *(const bf16x8*)(sK + (32 * mt + c32) * SK_ROW + 16 * ks + 8 * h2);
      a = mfma32(kf, qf[ks], a);
    }
    S[mt] = a;
  }
  float mx = -1e30f;
#pragma unroll
  for (int mt = 0; mt < 2; ++mt)
#pragma unroll
    for (int i = 0; i < 16; ++i) mx = fmaxf(mx, S[mt][i]);
  mx = fmaxf(mx, __shfl_xor(mx, 32));
  float mnew = fmaxf(mrun, mx);
  float alpha = __builtin_amdgcn_exp2f(mrun - mnew);
  mrun = mnew;
  f32x2 ps2 = f32x2{0.f, 0.f};
  f32x16 Sd[2];
  Sd[0] = S[0] - mnew; Sd[1] = S[1] - mnew;
#pragma unroll
  for (int mt = 0; mt < 2; ++mt)
#pragma unroll
    for (int s = 0; s < 2; ++s) {
      float e[8];
#pragma unroll
      for (int jj = 0; jj < 8; ++jj) e[jj] = __builtin_amdgcn_exp2f(Sd[mt][8 * s + jj]);
      ps2 += f32x2{e[0], e[1]}; ps2 += f32x2{e[2], e[3]}; ps2 += f32x2{e[4], e[5]}; ps2 += f32x2{e[6], e[7]};
      U4 q = mk4(pack2(e[0], e[1]), pack2(e[2], e[3]), pack2(e[4], e[5]), pack2(e[6], e[7]));
      pf[mt * 2 + s] = __builtin_bit_cast(bf16x8, q);
    }
  lrun = lrun * alpha + (ps2[0] + ps2[1]);
  if (__any(alpha != 1.f)) {
#pragma unroll
    for (int d = 0; d < 3; ++d)
#pragma unroll
      for (int i = 0; i < 16; ++i) O[d][i] *= alpha;
  }
}
DI void mla_part2(const u16* sV, const bf16x8 (&pf)[4], f32x16 (&O)[3], int c32, int h2) {
#pragma unroll
  for (int kk = 0; kk < 4; ++kk) {
    int keybase = 16 * kk + 4 * h2;
#pragma unroll
    for (int d = 0; d < 3; ++d) {
      const u16* vp = sV + (32 * d + c32) * SV_ROW + keybase;
      U2 lo = *(const U2*)(vp), hi = *(const U2*)(vp + 8);
      U4 q = mk4(lo.x, lo.y, hi.x, hi.y);
      O[d] = mfma32(__builtin_bit_cast(bf16x8, q), pf[kk], O[d]);
    }
  }
}

DI void mla_item512(const Params& p, char* smem_all, int b, int h, int qb) {
  const int tid = tid512(), lane = tid & 63, w = tid >> 6, c32 = lane & 31, h2 = lane >> 5;
  const u16* Q = (const u16*)(wsp(p) + O_Q);
  const u16* KNg = (const u16*)(wsp(p) + O_KB) + (size_t)(b * 8 + h) * LT * 64;
  const u16* KPg = (const u16*)(wsp(p) + O_KP) + (size_t)b * LT * 32;
  const u16* Vg = (const u16*)(wsp(p) + O_VT1) + (size_t)(b * 8 + h) * 96 * LT;
  u16* Y1 = (u16*)(wsp(p) + O_Y1);
  u16* sb = (u16*)smem_all;
  const int qrow = b * 8192 + qb * 256 + w * 32 + c32;
  bf16x8 qf[6];
#pragma unroll
  for (int ks = 0; ks < 6; ++ks) qf[ks] = *(const bf16x8*)(Q + (size_t)qrow * 768 + h * 96 + 16 * ks + 8 * h2);
  f32x16 O[3];
#pragma unroll
  for (int d = 0; d < 3; ++d)
#pragma unroll
    for (int i = 0; i < 16; ++i) O[d][i] = 0.f;
  float mrun = -1e30f, lrun = 0.f;
  const int kkey = tid / 12, kkc = tid % 12;
  const u16* kp0 = kkc < 8 ? KNg + kkey * 64 + kkc * 8 : KPg + kkey * 32 + (kkc - 8) * 8;
  const int kstep0 = kkc < 8 ? 64 * 64 : 64 * 32;
  const int kdst = kkey * SK_ROW + kkc * 8;
  const u16* vp0 = Vg + (size_t)(tid >> 3) * LT + (tid & 7) * 8;
  const int vdst = 64 * SK_ROW + (tid >> 3) * SV_ROW + (tid & 7) * 8;
  const bool xk = tid < 256;
  const int xc = xk ? 512 + tid : tid + 256;
  const int xkey = xc / 12, xkc = xc % 12;
  const u16* xp0 = xk ? (xkc < 8 ? KNg + xkey * 64 + xkc * 8 : KPg + xkey * 32 + (xkc - 8) * 8) : Vg + (size_t)(xc >> 3) * LT + (xc & 7) * 8;
  const int xstep = xk ? (xkc < 8 ? 64 * 64 : 64 * 32) : 64;
  const int xdst = xk ? (xc / 12) * SK_ROW + (xc % 12) * 8 : 64 * SK_ROW + (xc >> 3) * SV_ROW + (xc & 7) * 8;
  U4 ka, va, xa, kb2, vb2, xb2;
#define MLA5_FETCH(K_, V_, X_, kt_) { K_ = *(const U4*)(kp0 + (size_t)(kt_) * kstep0); V_ = *(const U4*)(vp0 + (kt_) * 64); X_ = *(const U4*)(xp0 + (size_t)(kt_) * xstep); }
#define MLA5_COMMIT(K_, V_, X_, st_) { *(U4*)((st_) + kdst) = K_; *(U2*)((st_) + vdst) = mk2(V_.x, V_.y); *(U2*)((st_) + vdst + 4) = mk2(V_.z, V_.w); *(U2*)((st_) + xdst) = mk2(X_.x, X_.y); *(U2*)((st_) + xdst + 4) = mk2(X_.z, X_.w); }
  constexpr int NKT = LT / 64;
  const int grp = w >> 2;
  u16* sc = sb; u16* sn = sb + MLA_STAGE; u16* sp = sb + 2 * MLA_STAGE;
  bf16x8 pf[4];
  MLA5_FETCH(ka, va, xa, 0);
  MLA5_FETCH(kb2, vb2, xb2, 1);
  __syncthreads();
  MLA5_COMMIT(ka, va, xa, sc);
  __syncthreads();
  for (int kt = 0; kt < NKT; kt += 2) {
    { int k2 = kt + 2 < NKT ? kt + 2 : NKT - 2; MLA5_FETCH(ka, va, xa, k2); }
    __builtin_amdgcn_sched_barrier(0);
    if (grp == 0) { mla_part1(sc, qf, O, mrun, lrun, pf, c32, h2); mla_part2(sc + 64 * SK_ROW, pf, O, c32, h2); }
    else { if (kt > 0) mla_part2(sp + 64 * SK_ROW, pf, O, c32, h2); mla_part1(sc, qf, O, mrun, lrun, pf, c32, h2); }
    MLA5_COMMIT(kb2, vb2, xb2, sn);
    __syncthreads();
    { u16* t_ = sp; sp = sc; sc = sn; sn = t_; }
    { int k3 = kt + 3 < NKT ? kt + 3 : NKT - 1; MLA5_FETCH(kb2, vb2, xb2, k3); }
    __builtin_amdgcn_sched_barrier(0);
    if (grp == 0) { mla_part1(sc, qf, O, mrun, lrun, pf, c32, h2); mla_part2(sc + 64 * SK_ROW, pf, O, c32, h2); }
    else { mla_part2(sp + 64 * SK_ROW, pf, O, c32, h2); mla_part1(sc, qf, O, mrun, lrun, pf, c32, h2); }
    MLA5_COMMIT(ka, va, xa, sn);
    __syncthreads();
    { u16* t_ = sp; sp = sc; sc = sn; sn = t_; }
  }
  if (grp == 1) mla_part2(sp + 64 * SK_ROW, pf, O, c32, h2);
#undef MLA5_FETCH
#undef MLA5_COMMIT
  float l = lrun + __shfl_xor(lrun, 32);
  float inv = 1.f / l;
#pragma unroll
  for (int d = 0; d < 3; ++d)
#pragma unroll
    for (int i4 = 0; i4 < 4; ++i4) {
      int dd = 32 * d + 8 * i4 + 4 * h2;
      U2 o = mk2(pack2(O[d][4 * i4] * inv, O[d][4 * i4 + 1] * inv), pack2(O[d][4 * i4 + 2] * inv, O[d][4 * i4 + 3] * inv));
      *(U2*)(Y1 + (size_t)qrow * 1024 + h * 96 + dd) = o;
    }
}

DI void kpe_item(const Params& p, int it) {
  const int tid = tidx();
  const u16* u1 = (const u16*)(wsp(p) + O_U1);
  u16* kp = (u16*)(wsp(p) + O_KP);
#pragma unroll
  for (int ps = 0; ps < 8; ++ps) {
    int m = it * 64 + ps * 8 + (tid >> 5), i = tid & 31;
    float v = bf2f(u1[(size_t)m * 1024 + 640 + i]);
    float pr = bf2f(u1[(size_t)m * 1024 + 640 + (i ^ 8)]);
    int b, s; bs_of(m, b, s);
    float o = v;
    if (m < NLAT) {
      int axis = i >> 4, second = (i >> 3) & 1, idx = i & 7;
      float inv = exp2f(-(float)idx * (13.287712379549449f / 8.f));
      float pos = (float)(axis ? (s & 63) : (s >> 6));
      float rv = pos * inv * 0.15915494309189535f; float sn = __builtin_amdgcn_sinf(rv), cs = __builtin_amdgcn_cosf(rv);
      o = second ? (v * cs + pr * sn) : (v * cs - pr * sn);
    }
    kp[((size_t)b * LT + s) * 32 + i] = f2bf(o);
  }
}

DI void fnet1_item(const Params& p, char* smem, int it) {
  const int tid = tidx(), lane = tid & 63, w = tid >> 6, r16 = lane & 15, g4 = lane >> 4;
  constexpr int XROW = 264, TROW = 72;
  u16* xb = (u16*)smem;
  u16* tt = xb + 64 * XROW;
  const u16* u1 = (const u16*)(wsp(p) + O_U1);
  u16* XT = (u16*)(wsp(p) + O_XT);
  const int m0 = it * 64;
  for (int e = tid; e < 64 * 32; e += 256) {
    int tok = e >> 5, c8 = e & 31;
    *(U4*)(xb + tok * XROW + c8 * 8) = *(const U4*)(u1 + (size_t)(m0 + tok) * 1024 + 672 + c8 * 8);
  }
  for (int e = tid; e < 128 * 64; e += 256) {
    int n = e >> 6, j = e & 63;
    float rv = (float)((n * j) & 63) * (1.f / 64.f);
    float v = (n < 64) ? __builtin_amdgcn_cosf(rv) : __builtin_amdgcn_sinf(rv);
    tt[n * TROW + j] = f2bf(v);
  }
  __syncthreads();
  {
    const int tok = tid & 63, gq = tid >> 6;
    u16* xp = xb + tok * XROW + gq * 64;
    float xr[64];
#pragma unroll
    for (int c = 0; c < 8; ++c) {
      U4 q = *(const U4*)(xp + c * 8);
      u32 ww[4] = {q.x, q.y, q.z, q.w};
#pragma unroll
      for (int k = 0; k < 4; ++k) { xr[c * 8 + 2 * k] = __uint_as_float(ww[k] << 16); xr[c * 8 + 2 * k + 1] = __uint_as_float(ww[k] & 0xffff0000u); }
    }
    float sm = 0.f;
#pragma unroll
    for (int jj = 0; jj < 64; ++jj) sm += xr[jj];
    float mu = sm * (1.f / 64.f), q2 = 0.f;
#pragma unroll
    for (int jj = 0; jj < 64; ++jj) { float d = xr[jj] - mu; q2 += d * d; }
    float rstd = rsqrtf(q2 * (1.f / 64.f) + LN_EPS);
#pragma unroll
    for (int c = 0; c < 8; ++c) {
      float o[8];
#pragma unroll
      for (int k = 0; k < 8; ++k) o[k] = (xr[c * 8 + k] - mu) * rstd * p.fn_g[gq * 64 + c * 8 + k] + p.fn_b[gq * 64 + c * 8 + k];
      *(U4*)(xp + c * 8) = mk4(pack2(o[0], o[1]), pack2(o[2], o[3]), pack2(o[4], o[5]), pack2(o[6], o[7]));
    }
  }
  __syncthreads();
  bf16x8 af[4][2];
#pragma unroll
  for (int mt = 0; mt < 4; ++mt)
#pragma unroll
    for (int ks = 0; ks < 2; ++ks) af[mt][ks] = *(const bf16x8*)(xb + (16 * mt + r16) * XROW + w * 64 + 32 * ks + 8 * g4);
  const int b = m0 >> 13, t0 = (m0 & 8191);
#pragma unroll 2
  for (int nt = 0; nt < 8; ++nt) {
    bf16x8 b0 = *(const bf16x8*)(tt + (16 * nt + r16) * TROW + 8 * g4);
    bf16x8 b1 = *(const bf16x8*)(tt + (16 * nt + r16) * TROW + 32 + 8 * g4);
    int n = 16 * nt + r16;
    size_t row = (size_t)(b * 256 + w * 64 + (n & 63)) * 16384 + (n >= 64 ? 8192 : 0) + t0;
#pragma unroll
    for (int mt = 0; mt < 4; ++mt) {
      f32x4 acc = f32x4{0.f, 0.f, 0.f, 0.f};
      acc = mfma16(af[mt][0], b0, acc);
      acc = mfma16(af[mt][1], b1, acc);
      *(U2*)(XT + row + 16 * mt + 4 * g4) = mk2(pack2g(acc[0], acc[1]), pack2g(acc[2], acc[3]));
    }
  }
}

DI void gbar(unsigned* ctr, unsigned& target, unsigned nblk) {
  asm volatile("s_waitcnt vmcnt(0)" ::: "memory");
  __syncthreads();
  target += nblk;
  if (__builtin_amdgcn_workitem_id_x() == 0) {
    __builtin_amdgcn_s_waitcnt(0);
    __builtin_amdgcn_fence(__ATOMIC_RELEASE, "agent");
    asm volatile("s_waitcnt vmcnt(0)" ::: "memory");
    __hip_atomic_fetch_add(ctr, 1u, __ATOMIC_RELAXED, __HIP_MEMORY_SCOPE_AGENT);
    while (__hip_atomic_load(ctr, __ATOMIC_RELAXED, __HIP_MEMORY_SCOPE_AGENT) < target) __builtin_amdgcn_s_sleep(1);
    __builtin_amdgcn_fence(__ATOMIC_ACQUIRE, "agent");
    asm volatile("s_waitcnt vmcnt(0)" ::: "memory");
  }
  __syncthreads();
}


#define XB_TMO      128
#define XB_XCNT(j)  (256  + 64 * (j))
#define XB_XSUB(j)  (1280 + 64 * (j))
#define XB_XGEN(j)  (2304 + 64 * (j))
#define XB_TOP      3328
#define XB_TOPGEN   3392
#define XCD_BAR_WORDS 3456
#define XB_SPIN_CAP (1u << 18)
#define LAS __attribute__((address_space(3)))

__device__ __forceinline__ unsigned xb_ld(unsigned* p)              { return __hip_atomic_load(p, __ATOMIC_RELAXED, __HIP_MEMORY_SCOPE_AGENT); }
__device__ __forceinline__ unsigned xb_add(unsigned* p, unsigned v) { return __hip_atomic_fetch_add(p, v, __ATOMIC_RELAXED, __HIP_MEMORY_SCOPE_AGENT); }
__device__ __forceinline__ unsigned xb_xcc_id() { return (unsigned)__builtin_amdgcn_s_getreg((3 << 11) | 20) & 0xFu; }
#define XB_SPIN(cond, bar) do { unsigned _sp = 0; while (cond) { __builtin_amdgcn_s_sleep(1); \
    if ((++_sp & 255u) == 0u) { if (xb_ld(&(bar)[XB_TMO])) break; if (_sp > XB_SPIN_CAP) { atomicAdd(&(bar)[XB_TMO], 1u); break; } } } } while (0)

struct XcdBarrier {
    unsigned* bar; unsigned x;
    volatile LAS unsigned* st;
};

__device__ __forceinline__ XcdBarrier xcd_barrier_post(unsigned* bar, volatile LAS unsigned* st) {
    XcdBarrier b; b.bar = bar; b.x = xb_xcc_id(); b.st = st;
    if (threadIdx.x == 0) (void)xb_add(&bar[XB_XCNT(b.x)], 1u);
    return b;
}
__device__ __forceinline__ void xcd_barrier_complete(unsigned* bar, unsigned x, unsigned& nloc, unsigned& nx) {
    const unsigned G = gridDim.x * gridDim.y * gridDim.z;
    unsigned sum, cnt, mine, sp = 0u;
    for (;;) {
        sum = 0u; cnt = 0u; mine = 0u;
#pragma unroll
        for (unsigned j = 0; j < 16; ++j) { const unsigned c = xb_ld(&bar[XB_XCNT(j)]); sum += c; cnt += (c > 0u) ? 1u : 0u; mine = (j == x) ? c : mine; }
        if (sum == G) break;
        __builtin_amdgcn_s_sleep(1);
        if ((++sp & 255u) == 0u) { if (xb_ld(&bar[XB_TMO])) break; if (sp > XB_SPIN_CAP) { atomicAdd(&bar[XB_TMO], 1u); break; } }
    }
    nloc = mine > 0u ? mine : 1u; nx = cnt > 0u ? cnt : 1u;
}

__device__ __forceinline__ void xcd_barrier(const XcdBarrier& b) {
    asm volatile("s_waitcnt vmcnt(0)" ::: "memory");
    __syncthreads();
    if (threadIdx.x == 0) {
        unsigned* bar = b.bar;
        __builtin_amdgcn_s_waitcnt(0);
        unsigned nloc = b.st[0], nx = b.st[1];
        if (nloc == 0u) { xcd_barrier_complete(bar, b.x, nloc, nx); b.st[0] = nloc; b.st[1] = nx; }
        const unsigned old = xb_add(&bar[XB_XSUB(b.x)], 1u);
        const unsigned gen = old / nloc;
        if (old + 1u == (gen + 1u) * nloc) {
            __builtin_amdgcn_fence(__ATOMIC_RELEASE, "agent");
            asm volatile("s_waitcnt vmcnt(0)" ::: "memory");
            const unsigned og = xb_add(&bar[XB_TOP], 1u);
            const unsigned tg = og / nx;
            if (og + 1u == (tg + 1u) * nx) xb_add(&bar[XB_TOPGEN], 1u);
            else XB_SPIN(xb_ld(&bar[XB_TOPGEN]) == tg, bar);
            __builtin_amdgcn_fence(__ATOMIC_ACQUIRE, "agent");
            xb_add(&bar[XB_XGEN(b.x)], 1u);
            asm volatile("s_waitcnt vmcnt(0)" ::: "memory");
        } else {
            XB_SPIN(xb_ld(&bar[XB_XGEN(b.x)]) == gen, bar);
            __builtin_amdgcn_fence(__ATOMIC_ACQUIRE, "agent");
            asm volatile("s_waitcnt vmcnt(0)" ::: "memory");
        }
    }
    __syncthreads();
}

#define USE_PG8_WIN 0
#define USE_PG8_L1IN 1
#define USE_PG8_L1OUT 1
#define USE_PG8_MLP1 1
#define USE_PG8_MLP2 1
#ifndef REP_MLA
#define REP_MLA 1
#endif
#ifndef REP_TOEP
#define REP_TOEP 1
#endif
#ifndef REP_MLP1
#define REP_MLP1 1
#endif
#ifndef REP_NAT
#define REP_NAT 1
#endif
#ifndef REP_FNG
#define REP_FNG 1
#endif
#ifndef REP_WIN
#define REP_WIN 1
#endif

__global__ void __launch_bounds__(512, 2) mega(Params p) {
  cg::grid_group grid = cg::this_grid();
  __shared__ __attribute__((aligned(16))) char smem_all[2 * SMEM_BYTES];
  char* smem = smem_all + halfx() * SMEM_BYTES;
  char* ws = wsp(p);
  const int nblk = NVB, bid = bidx();
  const int rnblk = gridDim.x, rbid = rbidx();
  float* S = (float*)(ws + O_S);
  u16* hbuf = (u16*)(ws + O_HBUF);
  unsigned* barp = (unsigned*)(ws + O_BAR);
  __shared__ __attribute__((aligned(16))) unsigned xb_words[4];
  if (__builtin_amdgcn_workitem_id_x() == 0) { xb_words[0] = 0u; xb_words[1] = 0u; }
  __syncthreads();
  const XcdBarrier xbar = xcd_barrier_post(barp, (volatile LAS unsigned*)xb_words);
#define SYNC() xcd_barrier(xbar)

  phase_prep(p, smem);
  grid.sync();
  phase_ln<true, false, true>(p, R, nullptr, nullptr, nullptr, false, 0, 0, 1024);
  SYNC();

#pragma unroll
  for (int l = 0; l < 2; ++l) {
    const int rows = (l == 0) ? R : NLAT;
    const float* mod = modp(p, l, 0);
    if (l == 0) {
      {
        EpWin0 ep; ep.uhyT = (u16*)(ws + O_UHYT); ep.uqk = (u16*)(ws + O_UQK); ep.vT = (u16*)(ws + O_VT0);
        const u16* W = (const u16*)(ws + O_WT_ABIN);
#if USE_PG8_WIN
        run_phase<EpWin0, true>(smem_all, W, hbuf, 1536, NLAT, 1024, ep, 0, 0);
        run_phase<EpWin0, false>(smem_all, hbuf, W + (size_t)1536 * 1024, NLAT, 1024, 1024, ep, 0, 1536);
        run_phase<EpWin0, true>(smem_all, W + (size_t)2560 * 1024, hbuf, 512, NLAT, 1024, ep, 2560, 0);
#else
        {
          LoadRowB al; al.A = hbuf; al.lda = 1024;
          for (int t = rbid; t < 128 * 12; t += rnblk) {
            int nt = t % 12;
            if (nt >= 6 && nt < 10) gemm_big<true>(al, W, 1024, 1024, (t / 12) * 256, nt * 256, ep, smem_all);
            else gemm_big<false>(al, W, 1024, 1024, (t / 12) * 256, nt * 256, ep, smem_all);
          }
        }
#endif
        {
          ALoadRow al; al.A = hbuf; al.lda = 1024;
          for (int t = bid; t < 8 * 24; t += nblk) {
            int nt = t % 24;
            if (nt >= 12 && nt < 20) gemm_tile<true>(al, W, 1024, 1024, NLAT + (t / 24) * 128, nt * 128, ep, smem);
            else gemm_tile<false>(al, W, 1024, 1024, NLAT + (t / 24) * 128, nt * 128, ep, smem);
          }
        }
      }
      SYNC();
      {
        const int n_toep = 1024, n_na = 4096, n_nac = 128, n_tc = 512;
        for (int it = bid; it < n_toep + n_na + n_nac + n_tc; it += nblk) {
          __syncthreads();
          int t = it;
          if (t < n_toep) { toep_item(p, smem, 0, t >> 1, t & 1); continue; }
          t -= n_toep;
          u16* Pw = (u16*)smem + (tidx() >> 6) * (16 * 520);
          if (t < n_na) { int b = t >> 10, r = (t >> 3) & 127, h = t & 7; natten_wave(p, Pw, b, h, true, r, tidx() >> 6, 0); continue; }
          t -= n_na;
          if (t < n_nac) { int b = t >> 5, h = (t >> 2) & 7, q4 = t & 3; natten_wave(p, Pw, b, h, false, 0, 0, q4 * 4 + (tidx() >> 6)); continue; }
          t -= n_nac;
          toep_ctx_item(p, smem, 0, t);
        }
      }
      SYNC();
      {
        for (int it = bid; it < 1024 + 512; it += nblk) {
          __syncthreads();
          if (it < 1024) toep_item(p, smem, 1, it >> 1, it & 1);
          else toep_ctx_item(p, smem, 1, it - 1024);
        }
      }
      SYNC();
      {
        EpResid ep; ep.xlat = p.x; ep.xctx = p.ctx; ep.S = S; ep.mod = mod; ep.goff = 2048;
        const u16* W = (const u16*)(ws + O_WT_ABOUT);
        {
          ALoadMixB al; al.YT = (const u16*)(ws + O_YHYT); al.YN = (const u16*)(ws + O_YNA);
          for (int t = rbid; t < 128 * 4; t += rnblk) gemm_big<true>(al, W, 1024, 1024, (t / 4) * 256, (t % 4) * 256, ep, smem_all);
        }
        {
          ALoadMix al; al.YT = (const u16*)(ws + O_YHYT); al.YN = (const u16*)(ws + O_YNA);
          for (int t = bid; t < 8 * 8; t += nblk) gemm_tile<true>(al, W, 1024, 1024, NLAT + (t / 8) * 128, (t % 8) * 128, ep, smem);
        }
      }
      SYNC();
    } else {
      {
        EpPlain ep; ep.dst = (u16*)(ws + O_U1); ep.ld = 1024;
        const u16* W = (const u16*)(ws + O_WT_CDIN);
#if USE_PG8_L1IN
        run_phase<EpPlain, false>(smem_all, hbuf, W, NLAT, 1024, 1024, ep, 0, 0);
#else
        {
          LoadRowB al; al.A = hbuf; al.lda = 1024;
          for (int t = rbid; t < 128 * 4; t += rnblk) gemm_big<true>(al, W, 1024, 1024, (t / 4) * 256, (t % 4) * 256, ep, smem_all);
        }
#endif
        {
          ALoadRow al; al.A = hbuf; al.lda = 1024;
          for (int t = bid; t < 8 * 8; t += nblk) gemm_tile<true>(al, W, 1024, 1024, NLAT + (t / 8) * 128, (t % 8) * 128, ep, smem);
        }
      }
      SYNC();
      {
        const int n_q = (NLAT / 128) * 6, n_kv = (R / 128) * 10, n_kpe = R / 64, n_f1 = NLAT / 64;
        float* srow = (float*)(smem + 73728);
        const u16* u1 = (const u16*)(ws + O_U1);
        for (int it = bid; it < n_q + n_kv + n_kpe + n_f1; it += nblk) {
          __syncthreads();
          int t = it;
          if (t < n_q) {
            int m0 = (t / 6) * 128, n0 = (t % 6) * 128;
            rms_rows(u1, 1024, 384, m0, srow);
            ALoadRow al; al.A = u1; al.lda = 1024;
            EpQ ep; ep.q = (u16*)(ws + O_Q); ep.srow = srow; ep.m0 = m0;
            gemm_tile<true>(al, (const u16*)(ws + O_WT_UQ), 384, 384, m0, n0, ep, smem);
            continue;
          }
          t -= n_q;
          if (t < n_kv) {
            int m0 = (t / 10) * 128, n0 = (t % 10) * 128;
            rms_rows(u1 + 384, 1024, 256, m0, srow);
            ALoadRow al; al.A = u1 + 384; al.lda = 1024;
            EpKV ep; ep.kn = (u16*)(ws + O_KB); ep.vT = (u16*)(ws + O_VT1); ep.srow = srow; ep.m0 = m0;
            gemm_tile<false>(al, (const u16*)(ws + O_WT_UKV), 256, 256, m0, n0, ep, smem);
            continue;
          }
          t -= n_kv;
          if (t < n_kpe) { kpe_item(p, t); continue; }
          t -= n_kpe;
          fnet1_item(p, smem, t);
        }
      }
      SYNC();
      {
        for (int it = rbid; it < 512; it += rnblk) {
          int b = it >> 7, hp = (it >> 5) & 3, qb = it & 31;
          __syncthreads();
          mla_item512(p, smem_all, b, 2 * hp, qb);
          __syncthreads();
          mla_item512(p, smem_all, b, 2 * hp + 1, qb);
        }
        for (int t = rbid; t < 256; t += rnblk) {
          __syncthreads();
          const int hf = halfx();
          const int m0 = (t >> 3) * 128, n0 = (t & 7) * 128;
          ALoadDFT al; al.kofs = hf * 8192;
          EpLds ep; ep.buf = (float*)smem; ep.m0 = m0; ep.n0 = n0;
          gemm_tile<true>(al, (const u16*)(ws + O_XT) + hf * 8192, 16384, 8192, m0, n0, ep, smem);
          __syncthreads();
          const float* Pb = (const float*)smem_all;
          const float* Qb = (const float*)(smem_all + SMEM_BYTES);
          u16* y1 = (u16*)(ws + O_Y1);
          const float sc = 0.0013810679320049757f;
          const int tid = tidx(), bb = n0 >> 8, ch0 = n0 & 255;
#pragma unroll 4
          for (int i = 0; i < 16; ++i) {
            int e = tid + 256 * i, row = e >> 5, c4 = (e & 31) * 4;
            F4 pv = *(const F4*)(Pb + row * 132 + c4), qv = *(const F4*)(Qb + row * 132 + c4);
            int k = m0 + row;
            if (hf == 0) {
              *(U2*)(y1 + ((size_t)(bb * 8192 + k)) * 1024 + 768 + ch0 + c4) = mk2(pack2((pv.x + qv.x) * sc, (pv.y + qv.y) * sc), pack2((pv.z + qv.z) * sc, (pv.w + qv.w) * sc));
            } else if (k > 0) {
              *(U2*)(y1 + ((size_t)(bb * 8192 + 8192 - k)) * 1024 + 768 + ch0 + c4) = mk2(pack2((pv.x - qv.x) * sc, (pv.y - qv.y) * sc), pack2((pv.z - qv.z) * sc, (pv.w - qv.w) * sc));
            }
          }
        }
        for (int i = bid; i < 16; i += nblk) {
          const int tid = tidx(), lane = tid & 63, w = tid >> 6;
          const u16* XT = (const u16*)(ws + O_XT);
          u16* y1 = (u16*)(ws + O_Y1);
          float res = 0.f;
          for (int c = 0; c < 16; ++c) {
            int n = i * 64 + w * 16 + c;
            const U4* row = (const U4*)(XT + (size_t)n * 16384);
            float sacc = 0.f;
#pragma unroll 4
            for (int j = 0; j < 16; ++j) {
              U4 q = row[lane + 64 * j];
              u32 ww[4] = {q.x, q.y, q.z, q.w};
#pragma unroll
              for (int k2 = 0; k2 < 4; ++k2) sacc += __uint_as_float(ww[k2] << 16) - __uint_as_float(ww[k2] & 0xffff0000u);
            }
            sacc = wave_sum(sacc);
            if (lane == c) res = sacc;
          }
          if (lane < 16) {
            int n = i * 64 + w * 16 + lane;
            y1[((size_t)((n >> 8) * 8192 + 4096)) * 1024 + 768 + (n & 255)] = f2bf(res * 0.0013810679320049757f);
          }
        }
      }
      SYNC();
      {
        EpResid ep; ep.xlat = S; ep.xctx = S + (size_t)NLAT * 1024; ep.S = S; ep.mod = mod; ep.goff = 2048;
#if USE_PG8_L1OUT
        run_phase<EpResid, false>(smem_all, (const u16*)(ws + O_Y1), (const u16*)(ws + O_WT_CDOUT), NLAT, 1024, 1024, ep, 0, 0);
#else
        {
          LoadRowB al; al.A = (const u16*)(ws + O_Y1); al.lda = 1024;
          for (int t = rbid; t < 128 * 4; t += rnblk) gemm_big<true>(al, (const u16*)(ws + O_WT_CDOUT), 1024, 1024, (t / 4) * 256, (t % 4) * 256, ep, smem_all);
        }
#endif
      }
      SYNC();
    }
    phase_ln<false, true, true>(p, rows, p.ln_g + (size_t)(l * 2 + 0) * 1024, p.ln_b + (size_t)(l * 2 + 0) * 1024, nullptr, true, l, 3072, 4096);
    SYNC();
    {
      EpRelu2 ep; ep.a1 = (u16*)(ws + O_A1);
      const u16* W = (const u16*)(ws + O_WT_W1) + (size_t)l * 4096 * 1024;
#if USE_PG8_MLP1
      run_phase<EpRelu2, false>(smem_all, hbuf, W, NLAT, 4096, 1024, ep, 0, 0);
#else
      {
        LoadRowB al; al.A = hbuf; al.lda = 1024;
        for (int t = rbid; t < 128 * 16; t += rnblk) gemm_big<true>(al, W, 1024, 1024, (t / 16) * 256, (t % 16) * 256, ep, smem_all);
      }
#endif
      if (l == 0) {
        ALoadRow al; al.A = hbuf; al.lda = 1024;
        for (int t = bid; t < 8 * 32; t += nblk) gemm_tile<true>(al, W, 1024, 1024, NLAT + (t / 32) * 128, (t % 32) * 128, ep, smem);
      }
    }
    SYNC();
    {
      EpResid ep; ep.xlat = S; ep.xctx = S + (size_t)NLAT * 1024; ep.S = S; ep.mod = mod; ep.goff = 5120;
      const u16* W = (const u16*)(ws + O_WT_W2) + (size_t)l * 4096 * 1024;
#if USE_PG8_MLP2
      run_phase<EpResid, false>(smem_all, (const u16*)(ws + O_A1), W, NLAT, 1024, 4096, ep, 0, 0);
#else
      {
        LoadRowB al; al.A = (const u16*)(ws + O_A1); al.lda = 4096;
        for (int t = rbid; t < 128 * 4; t += rnblk) gemm_big<true>(al, W, 4096, 4096, (t / 4) * 256, (t % 4) * 256, ep, smem_all);
      }
#endif
      if (l == 0) {
        ALoadRow al; al.A = (const u16*)(ws + O_A1); al.lda = 4096;
        for (int t = bid; t < 8 * 8; t += nblk) gemm_tile<true>(al, W, 4096, 4096, NLAT + (t / 8) * 128, (t % 8) * 128, ep, smem);
      }
    }
    SYNC();
    if (l == 0) phase_ln<false, true, true>(p, R, p.ln_g + 1024, p.ln_b + 1024, nullptr, true, 1, 0, 1024);
    else phase_ln<false, true, false>(p, NLAT, p.ln_g + 3 * 1024, p.ln_b + 3 * 1024, p.out, false, 0, 0, 0);
    if (l == 0) SYNC();
  }
}

extern "C" void kernel_launch(void* const* d_in, const int* in_sizes, int n_in, void* d_out, int out_size, void* d_ws,
                              size_t ws_size, hipStream_t stream) {
  static int grid_blocks = 0;
  if (!grid_blocks) {
    int dev = 0, cus = 0, per_cu = 0;
    hipGetDevice(&dev);
    hipDeviceGetAttribute(&cus, hipDeviceAttributeMultiprocessorCount, dev);
    hipOccupancyMaxActiveBlocksPerMultiprocessor(&per_cu, mega, 512, 0);
    if (per_cu > 1) per_cu = 1;
    if (per_cu < 1) per_cu = 1;
    grid_blocks = cus * per_cu;
  }
  Params p{};
  const float** f = (const float**)&p;
  for (int i = 0; i < 30; ++i) f[i] = (const float*)d_in[i];
  p.out = (float*)d_out;
  p.ws = (char*)d_ws;
  hipMemsetAsync((char*)d_ws + O_BAR, 0, 16384, stream);
  void* args[] = {&p};
  hipError_t e = hipLaunchCooperativeKernel((void*)mega, dim3(grid_blocks), dim3(512), args, 0, stream);
  if (e != hipSuccess) fprintf(stderr, "cooperative launch failed: %s (grid %d)\n", hipGetErrorString(e), grid_blocks);
}
```

```cpp
#include <hip/hip_runtime.h>
#include <hip/hip_cooperative_groups.h>
#include <cstdio>
namespace cg = cooperative_groups;

#define DI __device__ __forceinline__
typedef unsigned short u16;
typedef unsigned int u32;
using bf16x8 = __attribute__((ext_vector_type(8))) short;
using f32x4 = __attribute__((ext_vector_type(4))) float;
using f32x16 = __attribute__((ext_vector_type(16))) float;
using U4 = __attribute__((ext_vector_type(4))) unsigned int;
using U2 = __attribute__((ext_vector_type(2))) unsigned int;
using F4 = __attribute__((ext_vector_type(4))) float;
using f32x2 = __attribute__((ext_vector_type(2))) float;
#define mk4(a, b, c, d) (U4{(u32)(a), (u32)(b), (u32)(c), (u32)(d)})
#define mk2(a, b) (U2{(u32)(a), (u32)(b)})
#define mkf4(a, b, c, d) (F4{(a), (b), (c), (d)})

constexpr int NB = 4, SEQL = 8192, LC = 256;
constexpr int NLAT = NB * SEQL;
constexpr int NCTX = NB * LC;
constexpr int R = NLAT + NCTX;
constexpr int LT = SEQL + LC;
constexpr float ALPHA = 1.4142135623730951f;
constexpr float LN_EPS = 1e-5f;
constexpr float LOG2E = 1.4426950408889634f;

constexpr size_t O_WT_ABIN = 0;
constexpr size_t O_WT_ABOUT = O_WT_ABIN + 3072ull * 1024 * 2;
constexpr size_t O_WT_W1 = O_WT_ABOUT + 1024ull * 1024 * 2;
constexpr size_t O_WT_W2 = O_WT_W1 + 2ull * 4096 * 1024 * 2;
constexpr size_t O_WT_CDIN = O_WT_W2 + 2ull * 4096 * 1024 * 2;
constexpr size_t O_WT_CDOUT = O_WT_CDIN + 1024ull * 1024 * 2;
constexpr size_t O_WT_UQ = O_WT_CDOUT + 1024ull * 1024 * 2;
constexpr size_t O_WT_UKV = O_WT_UQ + 768ull * 384 * 2;
constexpr size_t O_MOD = O_WT_UKV + 1280ull * 256 * 2;
constexpr size_t O_TCTX = O_MOD + 2ull * 5 * 6144 * 4;
constexpr size_t O_S = (O_TCTX + 2ull * 512 * 512 * 2 + 255) & ~(size_t)255;
constexpr size_t O_D = O_S + (size_t)R * 1024 * 4;
constexpr size_t O_HBUF = O_D;
constexpr size_t O_UQK = O_D + (size_t)R * 1024 * 2;
constexpr size_t O_VT0 = O_UQK + (size_t)R * 1024 * 2;
constexpr size_t O_UHYT = O_VT0 + 4ull * 512 * LT * 2;
constexpr size_t O_TLAT = O_UHYT + 4ull * 1536 * LT * 2;
constexpr size_t O_ZT = O_D;
constexpr size_t O_YNA = O_D + 4ull * 512 * LT * 2;
constexpr size_t O_YHYT = O_UQK;
constexpr size_t O_A1 = O_UQK;
constexpr size_t O_U1 = O_UQK;
constexpr size_t O_Q = O_U1 + (size_t)R * 1024 * 2;
constexpr size_t O_KB = O_Q + (size_t)NLAT * 768 * 2;
constexpr size_t O_KP = O_KB + 32ull * LT * 64 * 2;
constexpr size_t O_VT1 = O_KB + 32ull * LT * 96 * 2;
constexpr size_t O_XT = O_VT1 + 32ull * LT * 96 * 2;
constexpr size_t O_Y1 = O_D;
constexpr size_t WS_NEED = O_A1 + (size_t)R * 4096 * 2;
constexpr size_t O_BAR = (WS_NEED + 255) & ~(size_t)255;
static_assert(O_BAR + 256 <= 536870912ull, "ws too large");
static_assert(O_TLAT + 2ull * 512 * 16384 * 2 <= WS_NEED, "l0 region");
static_assert(O_XT + 1024ull * 16384 * 2 <= WS_NEED, "l1 region");

constexpr int SMEM_BYTES = 73728 + 1024;

struct Params {
  const float *x, *c, *ctx, *c_ctx, *mod_w, *mod_b, *ln_g, *ln_b, *mlp_w1, *mlp_w2, *ab_w_in, *ab_w_out, *hy_conv_w,
      *hy_w1, *hy_b1, *hy_freq, *hy_w2, *hy_b2, *hy_w3, *hy_log_decay, *hy_skip, *na_rpb, *cd_w_in, *cd_w_out,
      *mla_q_norm, *mla_w_uq, *mla_kv_norm, *mla_w_ukv, *fn_g, *fn_b;
  float* out;
  char* ws;
};

DI int tidx() { int t = __builtin_amdgcn_workitem_id_x() & 255; asm volatile("" : "+v"(t)); return t; }
DI int tid512() { int t = __builtin_amdgcn_workitem_id_x(); asm volatile("" : "+v"(t)); return t; }
DI int halfx() { return __builtin_amdgcn_readfirstlane(__builtin_amdgcn_workitem_id_x() >> 8); }
DI int bidx() { int b = __builtin_amdgcn_workgroup_id_x() * 2 + halfx(); asm volatile("" : "+s"(b)); return b; }
DI int rbidx() { int b = __builtin_amdgcn_workgroup_id_x(); asm volatile("" : "+s"(b)); return b; }
#define NVB ((int)gridDim.x * 2)
DI char* wsp(const Params& p) { char* w = p.ws; asm volatile("" : "+s"(w)); return w; }

DI u32 pack2(float a, float b) { u32 r; asm("v_cvt_pk_bf16_f32 %0, %1, %2" : "=v"(r) : "v"(a), "v"(b)); return r; }
DI u32 pack2g(float a, float b) { return pack2(a + 0.0f, b + 0.0f); }
DI u16 f2bf(float x) { return (u16)pack2(x, 0.f); }
DI float bf2f(u16 h) { return __uint_as_float(((u32)h) << 16); }
DI float wave_sum(float v) {
#pragma unroll
  for (int o = 32; o >= 1; o >>= 1) v += __shfl_xor(v, o);
  return v;
}
DI f32x4 mfma16(bf16x8 a, bf16x8 b, f32x4 c) { return __builtin_amdgcn_mfma_f32_16x16x32_bf16(a, b, c, 0, 0, 0); }
DI f32x16 mfma32(bf16x8 a, bf16x8 b, f32x16 c) { return __builtin_amdgcn_mfma_f32_32x32x16_bf16(a, b, c, 0, 0, 0); }

DI const float* modp(const Params& p, int l, int bidx) { return (const float*)(wsp(p) + O_MOD) + ((size_t)l * 5 + bidx) * 6144; }
DI int bidx_of(int m) { return m < NLAT ? (m >> 13) : 4; }
DI void bs_of(int m, int& b, int& s) {
  if (m < NLAT) { b = m >> 13; s = m & 8191; }
  else { int t = m - NLAT; b = t >> 8; s = SEQL + (t & 255); }
}

constexpr int BK = 64, LROW = BK + 8;
constexpr int STAGE_U16 = 2 * 128 * LROW;

struct ALoadRow {
  const u16* A; int lda; U4 r0, r1, r2, r3;
  DI void fetch(int m0, int k0, int tid) {
    const u16* base = A + (size_t)(m0 + (tid >> 3)) * lda + k0 + (tid & 7) * 8;
    r0 = *(const U4*)(base);
    r1 = *(const U4*)(base + (size_t)32 * lda);
    r2 = *(const U4*)(base + (size_t)64 * lda);
    r3 = *(const U4*)(base + (size_t)96 * lda);
  }
  DI void commit(u16* sA, int tid) {
    u16* d = sA + (tid >> 3) * LROW + (tid & 7) * 8;
    *(U4*)(d) = r0; *(U4*)(d + 32 * LROW) = r1; *(U4*)(d + 64 * LROW) = r2; *(U4*)(d + 96 * LROW) = r3;
  }
};

struct ALoadMix {
  const u16* YT; const u16* YN; U4 r0, r1, r2, r3; bool tr;
  DI void fetch(int m0, int k0, int tid) {
    tr = (k0 < 512);
    if (tr) {
      int b, s; bs_of(m0, b, s);
      const u16* base = YT + ((size_t)(b * 512 + k0 + (tid >> 4))) * LT + s + (tid & 15) * 8;
      r0 = *(const U4*)(base);
      r1 = *(const U4*)(base + (size_t)16 * LT);
      r2 = *(const U4*)(base + (size_t)32 * LT);
      r3 = *(const U4*)(base + (size_t)48 * LT);
    } else {
      const u16* base = YN + (size_t)(m0 + (tid >> 3)) * 512 + (k0 - 512) + (tid & 7) * 8;
      r0 = *(const U4*)(base);
      r1 = *(const U4*)(base + (size_t)32 * 512);
      r2 = *(const U4*)(base + (size_t)64 * 512);
      r3 = *(const U4*)(base + (size_t)96 * 512);
    }
  }
  static DI void scat(u16* d, U4 q) {
    d[0 * LROW] = (u16)(q.x); d[1 * LROW] = (u16)(q.x >> 16);
    d[2 * LROW] = (u16)(q.y); d[3 * LROW] = (u16)(q.y >> 16);
    d[4 * LROW] = (u16)(q.z); d[5 * LROW] = (u16)(q.z >> 16);
    d[6 * LROW] = (u16)(q.w); d[7 * LROW] = (u16)(q.w >> 16);
  }
  DI void commit(u16* sA, int tid) {
    if (tr) {
      u16* d = sA + ((tid & 15) * 8) * LROW + (tid >> 4);
      scat(d, r0); scat(d + 16, r1); scat(d + 32, r2); scat(d + 48, r3);
    } else {
      u16* d = sA + (tid >> 3) * LROW + (tid & 7) * 8;
      *(U4*)(d) = r0; *(U4*)(d + 32 * LROW) = r1; *(U4*)(d + 64 * LROW) = r2; *(U4*)(d + 96 * LROW) = r3;
    }
  }
};

struct ALoadDFT {
  static DI U4 gen(int k, int kk) {
    int t0 = kk & 8191;
    int idx = k * t0 + (kk >= 8192 ? 2048 : 0);
    float v0 = __builtin_amdgcn_cosf((float)((idx) & 8191) * (1.f / 8192.f));
    float v1 = __builtin_amdgcn_cosf((float)((idx + k) & 8191) * (1.f / 8192.f));
    float v2 = __builtin_amdgcn_cosf((float)((idx + 2 * k) & 8191) * (1.f / 8192.f));
    float v3 = __builtin_amdgcn_cosf((float)((idx + 3 * k) & 8191) * (1.f / 8192.f));
    float v4 = __builtin_amdgcn_cosf((float)((idx + 4 * k) & 8191) * (1.f / 8192.f));
    float v5 = __builtin_amdgcn_cosf((float)((idx + 5 * k) & 8191) * (1.f / 8192.f));
    float v6 = __builtin_amdgcn_cosf((float)((idx + 6 * k) & 8191) * (1.f / 8192.f));
    float v7 = __builtin_amdgcn_cosf((float)((idx + 7 * k) & 8191) * (1.f / 8192.f));
    return mk4(pack2(v0, v1), pack2(v2, v3), pack2(v4, v5), pack2(v6, v7));
  }
  int kofs; int k_, kk_;
  DI void fetch(int m0, int k0, int tid) { k_ = m0 + (tid >> 3); kk_ = kofs + k0 + (tid & 7) * 8; }
  DI void commit(u16* sA, int tid) {
    u16* d = sA + (tid >> 3) * LROW + (tid & 7) * 8;
    __builtin_amdgcn_sched_barrier(0);
    *(U4*)(d) = gen(k_, kk_);
    __builtin_amdgcn_sched_barrier(0);
    *(U4*)(d + 32 * LROW) = gen(k_ + 32, kk_);
    __builtin_amdgcn_sched_barrier(0);
    *(U4*)(d + 64 * LROW) = gen(k_ + 64, kk_);
    __builtin_amdgcn_sched_barrier(0);
    *(U4*)(d + 96 * LROW) = gen(k_ + 96, kk_);
    __builtin_amdgcn_sched_barrier(0);
  }
};

struct BLoadRow {
  const u16* B; int ldb; U4 r0, r1, r2, r3;
  DI void fetch(int n0, int k0, int tid) {
    const u16* base = B + (size_t)(n0 + (tid >> 3)) * ldb + k0 + (tid & 7) * 8;
    r0 = *(const U4*)(base);
    r1 = *(const U4*)(base + (size_t)32 * ldb);
    r2 = *(const U4*)(base + (size_t)64 * ldb);
    r3 = *(const U4*)(base + (size_t)96 * ldb);
  }
  DI void commit(u16* sB, int tid) {
    u16* d = sB + (tid >> 3) * LROW + (tid & 7) * 8;
    *(U4*)(d) = r0; *(U4*)(d + 32 * LROW) = r1; *(U4*)(d + 64 * LROW) = r2; *(U4*)(d + 96 * LROW) = r3;
  }
};

template <bool SWAP>
DI void gemm_compute(f32x4 (&acc)[4][4], const u16* sA, const u16* sB, int wm, int wn, int r16, int g) {
#pragma unroll
  for (int ks = 0; ks < 2; ++ks) {
    bf16x8 a[4], b[4];
#pragma unroll
    for (int i = 0; i < 4; ++i) a[i] = *(const bf16x8*)(sA + (wm * 64 + i * 16 + r16) * LROW + ks * 32 + g * 8);
#pragma unroll
    for (int j = 0; j < 4; ++j) b[j] = *(const bf16x8*)(sB + (wn * 64 + j * 16 + r16) * LROW + ks * 32 + g * 8);
#pragma unroll
    for (int i = 0; i < 4; ++i)
#pragma unroll
      for (int j = 0; j < 4; ++j) {
        if (SWAP) acc[i][j] = mfma16(b[j], a[i], acc[i][j]);
        else acc[i][j] = mfma16(a[i], b[j], acc[i][j]);
      }
  }
}

template <bool SWAP, class AL, class EP, int VAR = 0>
DI void gemm_tile(AL& al0, const u16* __restrict__ Bt, int ldb, int K, int m0, int n0, EP& ep, char* smem) {
  const int tid = tidx(), lane = tid & 63, w = tid >> 6, wm = w >> 1, wn = w & 1, r16 = lane & 15, g = lane >> 4;
  u16* sbase = (u16*)smem;
  f32x4 acc[4][4];
#pragma unroll
  for (int i = 0; i < 4; ++i)
#pragma unroll
    for (int j = 0; j < 4; ++j) acc[i][j] = f32x4{0.f, 0.f, 0.f, 0.f};
  AL al1 = al0;
  BLoadRow bl0, bl1; bl0.B = Bt; bl0.ldb = ldb; bl1.B = Bt; bl1.ldb = ldb;
  const int nk = K / BK;
  al0.fetch(m0, 0, tid); bl0.fetch(n0, 0, tid);
  al1.fetch(m0, BK, tid); bl1.fetch(n0, BK, tid);
  __syncthreads();
  al0.commit(sbase, tid); bl0.commit(sbase + 128 * LROW, tid);
  __syncthreads();
  u16* const sA0 = sbase; u16* const sB0 = sbase + 128 * LROW;
  u16* const sA1 = sbase + STAGE_U16; u16* const sB1 = sA1 + 128 * LROW;
  for (int kt = 0; kt < nk; kt += 2) {
    if (VAR != 1) { int k2 = (kt + 2 < nk ? kt + 2 : nk - 2) * BK; al0.fetch(m0, k2, tid); bl0.fetch(n0, k2, tid); }
    __builtin_amdgcn_sched_barrier(0);
    if (VAR != 2) gemm_compute<SWAP>(acc, sA0, sB0, wm, wn, r16, g);
    al1.commit(sA1, tid); bl1.commit(sB1, tid);
    __syncthreads();
    if (VAR != 1) { int k3 = (kt + 3 < nk ? kt + 3 : nk - 1) * BK; al1.fetch(m0, k3, tid); bl1.fetch(n0, k3, tid); }
    __builtin_amdgcn_sched_barrier(0);
    if (VAR != 2) gemm_compute<SWAP>(acc, sA1, sB1, wm, wn, r16, g);
    al0.commit(sA0, tid); bl0.commit(sB0, tid);
    __syncthreads();
  }
#pragma unroll
  for (int i = 0; i < 4; ++i)
#pragma unroll
    for (int j = 0; j < 4; ++j) {
      if (VAR == 3) { if (acc[i][j][0] == 1.2345f) ep.apply_t(m0, n0, acc[i][j]); }
      else if (SWAP) ep.apply_t(m0 + wm * 64 + i * 16 + r16, n0 + wn * 64 + j * 16 + g * 4, acc[i][j]);
      else ep.apply(m0 + wm * 64 + i * 16 + g * 4, n0 + wn * 64 + j * 16 + r16, acc[i][j]);
    }
}

struct LoadRowB {
  const u16* A; int lda; U4 r0, r1, r2, r3;
  DI void fetch(int m0, int k0, int tid) {
    const u16* base = A + (size_t)(m0 + (tid >> 3)) * lda + k0 + (tid & 7) * 8;
    r0 = *(const U4*)(base);
    r1 = *(const U4*)(base + (size_t)64 * lda);
    r2 = *(const U4*)(base + (size_t)128 * lda);
    r3 = *(const U4*)(base + (size_t)192 * lda);
  }
  DI void commit(u16* sA, int tid) {
    u16* d = sA + (tid >> 3) * LROW + (tid & 7) * 8;
    *(U4*)(d) = r0; *(U4*)(d + 64 * LROW) = r1; *(U4*)(d + 128 * LROW) = r2; *(U4*)(d + 192 * LROW) = r3;
  }
};
struct ALoadMixB {
  const u16* YT; const u16* YN; U4 r0, r1, r2, r3; bool tr;
  DI void fetch(int m0, int k0, int tid) {
    tr = (k0 < 512);
    if (tr) {
      int b, s; bs_of(m0, b, s);
      const u16* base = YT + ((size_t)(b * 512 + k0 + (tid >> 5))) * LT + s + (tid & 31) * 8;
      r0 = *(const U4*)(base);
      r1 = *(const U4*)(base + (size_t)16 * LT);
      r2 = *(const U4*)(base + (size_t)32 * LT);
      r3 = *(const U4*)(base + (size_t)48 * LT);
    } else {
      const u16* base = YN + (size_t)(m0 + (tid >> 3)) * 512 + (k0 - 512) + (tid & 7) * 8;
      r0 = *(const U4*)(base);
      r1 = *(const U4*)(base + (size_t)64 * 512);
      r2 = *(const U4*)(base + (size_t)128 * 512);
      r3 = *(const U4*)(base + (size_t)192 * 512);
    }
  }
  DI void commit(u16* sA, int tid) {
    if (tr) {
      u16* d = sA + ((tid & 31) * 8) * LROW + (tid >> 5);
      ALoadMix::scat(d, r0); ALoadMix::scat(d + 16, r1); ALoadMix::scat(d + 32, r2); ALoadMix::scat(d + 48, r3);
    } else {
      u16* d = sA + (tid >> 3) * LROW + (tid & 7) * 8;
      *(U4*)(d) = r0; *(U4*)(d + 64 * LROW) = r1; *(U4*)(d + 128 * LROW) = r2; *(U4*)(d + 192 * LROW) = r3;
    }
  }
};

template <bool SWAP, class AL, class EP>
DI void gemm_big(AL& al, const u16* __restrict__ Bt, int ldb, int K, int m0, int n0, EP& ep, char* smem_all) {
  const int tid = tid512(), lane = tid & 63, w = tid >> 6, wm = w >> 2, wn = w & 3, r16 = lane & 15, g = lane >> 4;
  u16* sbase = (u16*)smem_all;
  constexpr int STG = 2 * 256 * LROW;
  f32x4 acc[8][4];
#pragma unroll
  for (int i = 0; i < 8; ++i)
#pragma unroll
    for (int j = 0; j < 4; ++j) acc[i][j] = f32x4{0.f, 0.f, 0.f, 0.f};
  LoadRowB bl; bl.A = Bt; bl.lda = ldb;
  const int nk = K / BK;
  al.fetch(m0, 0, tid); bl.fetch(n0, 0, tid);
  __syncthreads();
  al.commit(sbase, tid); bl.commit(sbase + 256 * LROW, tid);
  __syncthreads();
  for (int kt = 0; kt < nk; ++kt) {
    const u16* sA = sbase + (kt & 1) * STG;
    const u16* sB = sA + 256 * LROW;
    { int kn = (kt + 1 < nk ? kt + 1 : kt) * BK; al.fetch(m0, kn, tid); bl.fetch(n0, kn, tid); }
    __builtin_amdgcn_sched_barrier(0);
#pragma unroll
    for (int ks = 0; ks < 2; ++ks) {
      bf16x8 b[4];
#pragma unroll
      for (int j = 0; j < 4; ++j) b[j] = *(const bf16x8*)(sB + (wn * 64 + j * 16 + r16) * LROW + ks * 32 + g * 8);
#pragma unroll
      for (int ih = 0; ih < 2; ++ih) {
        bf16x8 a[4];
#pragma unroll
        for (int i = 0; i < 4; ++i) a[i] = *(const bf16x8*)(sA + (wm * 128 + (ih * 4 + i) * 16 + r16) * LROW + ks * 32 + g * 8);
#pragma unroll
        for (int i = 0; i < 4; ++i)
#pragma unroll
          for (int j = 0; j < 4; ++j) {
            if (SWAP) acc[ih * 4 + i][j] = mfma16(b[j], a[i], acc[ih * 4 + i][j]);
            else acc[ih * 4 + i][j] = mfma16(a[i], b[j], acc[ih * 4 + i][j]);
          }
        __builtin_amdgcn_sched_barrier(0);
      }
    }
    u16* nA = sbase + ((kt + 1) & 1) * STG;
    al.commit(nA, tid); bl.commit(nA + 256 * LROW, tid);
    __syncthreads();
  }
#pragma unroll
  for (int i = 0; i < 8; ++i)
#pragma unroll
    for (int j = 0; j < 4; ++j) {
      if (SWAP) ep.apply_t(m0 + wm * 128 + i * 16 + r16, n0 + wn * 64 + j * 16 + g * 4, acc[i][j]);
      else ep.apply(m0 + wm * 128 + i * 16 + g * 4, n0 + wn * 64 + j * 16 + r16, acc[i][j]);
    }
}

struct EpWin0 {
  u16 *uhyT, *uqk, *vT;
  DI void apply_t(int m, int nb, f32x4 v) const { *(U2*)(uqk + (size_t)m * 1024 + (nb - 1536)) = mk2(pack2g(v[0], v[1]), pack2g(v[2], v[3])); }
  DI void apply(int mb, int n, f32x4 v) const {
    int b, s; bs_of(mb, b, s);
    if (n < 1536) {
      U2 o = mk2(pack2g(v[0], v[1]), pack2g(v[2], v[3]));
      *(U2*)(uhyT + ((size_t)(b * 1536 + n)) * LT + s) = o;
    } else if (n < 2560) {
#pragma unroll
      for (int r = 0; r < 4; ++r) uqk[(size_t)(mb + r) * 1024 + (n - 1536)] = (u16)pack2g(v[r], 0.f);
    } else {
      U2 o = mk2(pack2g(v[0], v[1]), pack2g(v[2], v[3]));
      *(U2*)(vT + ((size_t)(b * 512 + (n - 2560))) * LT + s) = o;
    }
  }
};
struct EpResid {
  const float* xlat; const float* xctx; float* S; const float* mod; int goff;
  DI void apply_t(int m, int nb, f32x4 v) const {
    F4 gt = *(const F4*)(mod + (size_t)bidx_of(m) * 6144 + goff + nb);
    const float* xp = (m < NLAT) ? xlat + (size_t)m * 1024 + nb : xctx + (size_t)(m - NLAT) * 1024 + nb;
    F4 xi = *(const F4*)xp;
    *(F4*)(S + (size_t)m * 1024 + nb) = mkf4(ALPHA * xi.x + gt.x * v[0], ALPHA * xi.y + gt.y * v[1], ALPHA * xi.z + gt.z * v[2], ALPHA * xi.w + gt.w * v[3]);
  }
  DI void apply(int mb, int n, f32x4 v) const {
    float gt = mod[(size_t)bidx_of(mb) * 6144 + goff + n];
#pragma unroll
    for (int r = 0; r < 4; ++r) {
      int m = mb + r;
      float xi = (m < NLAT) ? xlat[(size_t)m * 1024 + n] : xctx[(size_t)(m - NLAT) * 1024 + n];
      S[(size_t)m * 1024 + n] = ALPHA * xi + gt * v[r];
    }
  }
};
struct EpRelu2 {
  u16* a1;
  DI void apply_t8(int m, int nb, f32x4 v0, f32x4 v1) const {
    float t0 = fmaxf(v0[0], 0.f), t1 = fmaxf(v0[1], 0.f), t2 = fmaxf(v0[2], 0.f), t3 = fmaxf(v0[3], 0.f);
    float t4 = fmaxf(v1[0], 0.f), t5 = fmaxf(v1[1], 0.f), t6 = fmaxf(v1[2], 0.f), t7 = fmaxf(v1[3], 0.f);
    *(U4*)(a1 + (size_t)m * 4096 + nb) = mk4(pack2(t0 * t0, t1 * t1), pack2(t2 * t2, t3 * t3), pack2(t4 * t4, t5 * t5), pack2(t6 * t6, t7 * t7));
  }
  DI void apply_t(int m, int nb, f32x4 v) const {
    float t0 = fmaxf(v[0], 0.f), t1 = fmaxf(v[1], 0.f), t2 = fmaxf(v[2], 0.f), t3 = fmaxf(v[3], 0.f);
    *(U2*)(a1 + (size_t)m * 4096 + nb) = mk2(pack2(t0 * t0, t1 * t1), pack2(t2 * t2, t3 * t3));
  }
  DI void apply(int mb, int n, f32x4 v) const {
#pragma unroll
    for (int r = 0; r < 4; ++r) { float t = fmaxf(v[r], 0.f); a1[(size_t)(mb + r) * 4096 + n] = f2bf(t * t); }
  }
};
struct EpPlain {
  u16* dst; int ld;
  DI void apply_t8(int m, int nb, f32x4 v0, f32x4 v1) const {
    *(U4*)(dst + (size_t)m * ld + nb) = mk4(pack2g(v0[0], v0[1]), pack2g(v0[2], v0[3]), pack2g(v1[0], v1[1]), pack2g(v1[2], v1[3]));
  }
  DI void apply_t(int m, int nb, f32x4 v) const { *(U2*)(dst + (size_t)m * ld + nb) = mk2(pack2g(v[0], v[1]), pack2g(v[2], v[3])); }
  DI void apply(int mb, int n, f32x4 v) const {
#pragma unroll
    for (int r = 0; r < 4; ++r) dst[(size_t)(mb + r) * ld + n] = (u16)pack2g(v[r], 0.f);
  }
};
struct EpQ {
  u16* q; const float* srow; int m0;
  DI void apply_t(int m, int nb, f32x4 v) const {
    int hc = nb % 96;
    float sr = srow[m - m0];
    float val[4], par[4];
#pragma unroll
    for (int r = 0; r < 4; ++r) { val[r] = v[r] * sr; par[r] = __shfl_xor(val[r], 32); }
    if (hc >= 64) {
      int i0 = hc - 64, axis = i0 >> 4, second = (i0 >> 3) & 1;
      int s = m & 8191;
      float pos = (float)(axis ? (s & 63) : (s >> 6));
#pragma unroll
      for (int r = 0; r < 4; ++r) {
        int idx = (i0 + r) & 7;
        float inv = exp2f(-(float)idx * (13.287712379549449f / 8.f));
        float rv = pos * inv * 0.15915494309189535f; float sn = __builtin_amdgcn_sinf(rv), cs = __builtin_amdgcn_cosf(rv);
        val[r] = second ? (val[r] * cs + par[r] * sn) : (val[r] * cs - par[r] * sn);
      }
    }
    const float qs = 0.10206207261596575f * LOG2E;
    *(U2*)(q + (size_t)m * 768 + nb) = mk2(pack2(val[0] * qs, val[1] * qs), pack2(val[2] * qs, val[3] * qs));
  }
  DI void apply(int mb, int n, f32x4 v) const {
    int hc = n % 96;
    float val[4], par[4];
#pragma unroll
    for (int r = 0; r < 4; ++r) { val[r] = v[r] * srow[mb - m0 + r]; par[r] = __shfl_xor(val[r], 8); }
    if (hc >= 64) {
      int i = hc - 64, axis = i >> 4, second = (i >> 3) & 1, idx = i & 7;
      float inv = exp2f(-(float)idx * (13.287712379549449f / 8.f));
#pragma unroll
      for (int r = 0; r < 4; ++r) {
        int s = (mb + r) & 8191;
        float pos = (float)(axis ? (s & 63) : (s >> 6));
        float rv = pos * inv * 0.15915494309189535f; float sn = __builtin_amdgcn_sinf(rv), cs = __builtin_amdgcn_cosf(rv);
        val[r] = second ? (val[r] * cs + par[r] * sn) : (val[r] * cs - par[r] * sn);
      }
    }
    const float qs = 0.10206207261596575f * LOG2E;
#pragma unroll
    for (int r = 0; r < 4; ++r) q[(size_t)(mb + r) * 768 + n] = f2bf(val[r] * qs);
  }
};
struct EpKV {
  u16 *kn, *vT; const float* srow; int m0;
  DI void apply_t(int, int, f32x4) const {}
  DI void apply(int mb, int n, f32x4 v) const {
    int b, s; bs_of(mb, b, s);
    float val[4];
#pragma unroll
    for (int r = 0; r < 4; ++r) val[r] = v[r] * srow[mb - m0 + r];
    if (n < 512) {
      int hh = n >> 6, cc = n & 63;
#pragma unroll
      for (int r = 0; r < 4; ++r) kn[((size_t)(b * 8 + hh) * LT + s + r) * 64 + cc] = f2bf(val[r]);
    } else {
      int j = n - 512, hh = j / 96, d = j % 96;
      U2 o = mk2(pack2(val[0], val[1]), pack2(val[2], val[3]));
      *(U2*)(vT + ((size_t)((b * 8 + hh) * 96 + d)) * LT + s) = o;
    }
  }
};
struct EpLds {
  float* buf; int m0, n0;
  DI void apply_t(int m, int nb, f32x4 v) const { *(F4*)(buf + (m - m0) * 132 + (nb - n0)) = mkf4(v[0], v[1], v[2], v[3]); }
  DI void apply(int, int, f32x4) const {}
};
struct EpFnet {
  u16* y1;
  DI void apply_t(int m, int nb, f32x4 v) const {
    int b = nb >> 8, ch = nb & 255;
    const float sc = 0.0013810679320049757f;
    *(U2*)(y1 + ((size_t)(b * 8192 + m)) * 1024 + 768 + ch) = mk2(pack2(v[0] * sc, v[1] * sc), pack2(v[2] * sc, v[3] * sc));
  }
  DI void apply(int mb, int n, f32x4 v) const {
    int b = n >> 8, ch = n & 255;
    const float sc = 0.0013810679320049757f;
#pragma unroll
    for (int r = 0; r < 4; ++r) y1[((size_t)(b * 8192 + mb + r)) * 1024 + 768 + ch] = f2bf(v[r] * sc);
  }
};

DI void rms_rows(const u16* A, int lda, int K, int m0, float* srow) {
  int tid = tidx(), row = tid >> 1, half = tid & 1;
  const u16* a = A + (size_t)(m0 + row) * lda + half * (K / 2);
  float ss = 0.f;
  for (int k = 0; k < K / 2; k += 8) {
    U4 q = *(const U4*)(a + k);
    u32 w[4] = {q.x, q.y, q.z, q.w};
#pragma unroll
    for (int e = 0; e < 4; ++e) { float lo = __uint_as_float(w[e] << 16), hi = __uint_as_float(w[e] & 0xffff0000u); ss += lo * lo + hi * hi; }
  }
  ss += __shfl_xor(ss, 1);
  if (half == 0) srow[row] = rsqrtf(ss / (float)K + LN_EPS);
}


namespace pg8 {
#define PG8_LAS __attribute__((address_space(3)))
typedef unsigned short bf16_t;
typedef short bf16x8 __attribute__((ext_vector_type(8)));
typedef float f32x4 __attribute__((ext_vector_type(4)));
typedef unsigned u32x4 __attribute__((ext_vector_type(4)));
constexpr int BM = 256, BK = 64, HALF = 128, HTB = HALF * BK * 2  , STAGE_BYTES = 8 * HTB, NXCD = 8, WGM = 8;

__host__ __device__ __forceinline__ int lds_byte(int r, int c) { const int st = (r >> 4) * 2 + (c >> 5), rr = r & 15, cc = c & 31, ob = rr * 64 + cc * 2; return st * 1024 + (ob ^ (((ob >> 9) & 1) << 5)); }
__host__ __device__ __forceinline__ void stage_rc(int b, int& R, int& C) { const int st = b / 1024, sb = b % 1024, swz = sb ^ (((sb >> 9) & 1) << 5); R = (st >> 1) * 16 + swz / 64; C = (st & 1) * 32 + (swz % 64) / 2; }
__host__ __device__ __forceinline__ int perm32(int rho) { const int n = rho >> 4, i = rho & 15; return 8 * (i >> 2) + 4 * n + (i & 3); }

struct Unit { int pm, pn; };
struct Gemm { const bf16_t* A; const bf16_t* Bt; int M, N, K; };

struct StaticOrder {
    int nM, nN, nwg, G, c;
    __host__ __device__ void init(int M, int N, int G_, int c_) { nM = M / BM; nN = N / BM; nwg = nM * nN; G = G_; c = c_; }
    __host__ __device__ bool next(int i, Unit& u) const {
        const long L = (long)i * G + c; if (L >= nwg) return false;
        int wgid = (int)L; { const int q = nwg / NXCD, r = nwg % NXCD, xcd = wgid % NXCD, off = wgid / NXCD; wgid = (xcd < r ? xcd * (q + 1) : r * (q + 1) + (xcd - r) * q) + off; }
        const int nig = WGM * nN, gid = wgid / nig, fm = gid * WGM, gsz = (nM - fm) < WGM ? (nM - fm) : WGM;
        u.pm = fm + ((wgid % nig) % gsz); u.pn = (wgid % nig) / gsz; return true;
    }
    __device__ __forceinline__ void a_ready(const Unit&) const {}
    __device__ __forceinline__ void done(const Unit&) const {}
};
template <class Epi, class Sched, bool STAMP = false>
__device__ __forceinline__ void gemm_phase(PG8_LAS unsigned char* lds, const Gemm g, const Sched& S, const Epi& E, unsigned long long* stamps) {
    const int tid = tid512(), wid = __builtin_amdgcn_readfirstlane(tid >> 6), lane = tid & 63, wr = wid >> 2, wc = wid & 3, fr = lane & 15, fq = lane >> 4;
    const int K = g.K, nt = K / BK;
    int ts_lo = 0, ts_hi = 0, nts = 0; const unsigned long long rt_entry = STAMP ? (unsigned long long)wall_clock64() : 0ull;
#define PG8_STAMP() do { if (STAMP && wid == 0 && nts < 64) { const unsigned long long _c = (unsigned long long)clock64(); \
        ts_lo = (lane == nts) ? (int)(unsigned)_c : ts_lo; ts_hi = (lane == nts) ? (int)(unsigned)(_c >> 32) : ts_hi; ++nts; } } while (0)
    PG8_STAMP();
    unsigned voffA[2], voffB[2];
#pragma unroll
    for (int i = 0; i < 2; ++i) { int R, C; stage_rc(tid * 16 + i * 8192, R, C); const int Rb = Epi::PERM ? ((R & ~31) + perm32(R & 31)) : R;
        voffA[i] = (unsigned)(R * K + C) * 2u; voffB[i] = (unsigned)(Rb * K + C) * 2u; }
    const size_t kstep = (size_t)(BK * 2);
    const size_t hstep = (size_t)HALF * K * 2;
    const size_t tstep = 2 * hstep;
    const unsigned ldsw = (unsigned)wid * 1024u;
    const int aoff = lds_byte(wr * 64 + fr, fq * 8), boff = lds_byte(wc * 32 + fr, fq * 8);
#define PG8_SA(b, h) (((b) * 2 + (h)) * HTB)
#define PG8_SB(b, h) ((4 + (b) * 2 + (h)) * HTB)
#define PG8_STAGE(bufoff, gbase, voff) do { _Pragma("unroll") for (int _i = 0; _i < 2; ++_i) \
        __builtin_amdgcn_global_load_lds((const unsigned*)((const char*)(gbase) + (voff)[_i]), (PG8_LAS unsigned*)(lds + (bufoff) + ldsw + _i * 8192), 16, 0, 0); } while (0)
#define PG8_LDA(dst, b, h) do { _Pragma("unroll") for (int m = 0; m < 4; ++m) _Pragma("unroll") for (int k = 0; k < 2; ++k) dst[m][k] = *(const PG8_LAS bf16x8*)(lds + PG8_SA(b, h) + aoff + m * 2048 + k * 1024); } while (0)
#define PG8_LDB(dst, b, h) do { _Pragma("unroll") for (int n = 0; n < 2; ++n) _Pragma("unroll") for (int k = 0; k < 2; ++k) dst[n][k] = *(const PG8_LAS bf16x8*)(lds + PG8_SB(b, h) + boff + n * 2048 + k * 1024); } while (0)
#define PG8_MMA(ai, bj, At, Bt) do { __builtin_amdgcn_s_setprio(1); _Pragma("unroll") for (int m = 0; m < 4; ++m) _Pragma("unroll") for (int n = 0; n < 2; ++n) _Pragma("unroll") for (int k = 0; k < 2; ++k) \
        acc[ai][bj][m][n] = __builtin_amdgcn_mfma_f32_16x16x32_bf16(Bt[n][k], At[m][k], acc[ai][bj][m][n], 0, 0, 0); __builtin_amdgcn_s_setprio(0); } while (0)
#define PG8_WAIT_V(n) asm volatile("s_waitcnt vmcnt(" #n ")" ::: "memory")
#define PG8_WAIT_L(n) asm volatile("s_waitcnt lgkmcnt(" #n ")" ::: "memory")
#define PG8_BAR __builtin_amdgcn_s_barrier()
#define PG8_SCHED __builtin_amdgcn_sched_barrier(0)
    Unit cur, nxt; int ui = 0;
    if (!S.next(0, cur)) return;
    f32x4 acc[2][2][4][2];
#pragma unroll
    for (int a = 0; a < 2; ++a)
#pragma unroll
        for (int b = 0; b < 2; ++b)
#pragma unroll
            for (int m = 0; m < 4; ++m)
#pragma unroll
                for (int n = 0; n < 2; ++n) acc[a][b][m][n] = (f32x4){0.f, 0.f, 0.f, 0.f};
    bf16x8 At[4][2], B0[2][2], B1[2][2];
    const char* cA = (const char*)g.A + (size_t)cur.pm * tstep; const char* cB = (const char*)g.Bt + (size_t)cur.pn * tstep;
    S.a_ready(cur);
    PG8_STAGE(PG8_SB(0, 0), cB, voffB); PG8_STAGE(PG8_SA(0, 0), cA, voffA); PG8_STAGE(PG8_SB(0, 1), cB + hstep, voffB); PG8_STAGE(PG8_SA(0, 1), cA + hstep, voffA);
    if (wr == 1) PG8_BAR;
    PG8_WAIT_V(4); PG8_BAR;
    PG8_STAGE(PG8_SB(1, 0), cB + kstep, voffB); PG8_STAGE(PG8_SA(1, 0), cA + kstep, voffA); PG8_STAGE(PG8_SB(1, 1), cB + hstep + kstep, voffB);
    PG8_WAIT_V(6); PG8_BAR;
    PG8_STAMP();
    for (;;) {
        const bool has_next = S.next(ui + 1, nxt);
        const char* nA = has_next ? (const char*)g.A + (size_t)nxt.pm * tstep : cA; const char* nB = has_next ? (const char*)g.Bt + (size_t)nxt.pn * tstep : cB;
        for (int t = 0; t < nt; t += 2) {
            const bool last = (t == nt - 2);
            const char* a1 = cA + (size_t)(t + 1) * kstep;
            const char* a2 = last ? nA : cA + (size_t)(t + 2) * kstep; const char* b2 = last ? nB : cB + (size_t)(t + 2) * kstep;
            const char* a3 = a2 + kstep; const char* b3 = b2 + kstep;
            if (last && has_next) S.a_ready(nxt);
            PG8_LDB(B0, 0, 0); PG8_SCHED; PG8_LDA(At, 0, 0); PG8_STAGE(PG8_SA(1, 1), a1 + hstep, voffA);
            PG8_WAIT_L(8); PG8_BAR; PG8_WAIT_L(0); PG8_MMA(0, 0, At, B0); PG8_BAR; PG8_SCHED;
            PG8_LDB(B1, 0, 1); PG8_STAGE(PG8_SB(0, 0), b2, voffB);
            PG8_BAR; PG8_WAIT_L(0); PG8_MMA(0, 1, At, B1); PG8_BAR;
            PG8_LDA(At, 0, 1); PG8_STAGE(PG8_SA(0, 0), a2, voffA);
            PG8_BAR; PG8_WAIT_L(0); PG8_MMA(1, 0, At, B0); PG8_BAR; PG8_SCHED;
            PG8_STAGE(PG8_SB(0, 1), b2 + hstep, voffB);
            PG8_WAIT_V(6); PG8_BAR; PG8_MMA(1, 1, At, B1); PG8_BAR;
            PG8_LDB(B0, 1, 0); PG8_SCHED; PG8_LDA(At, 1, 0); PG8_STAGE(PG8_SA(0, 1), a2 + hstep, voffA);
            PG8_WAIT_L(8); PG8_BAR; PG8_WAIT_L(0); PG8_MMA(0, 0, At, B0); PG8_BAR; PG8_SCHED;
            PG8_LDB(B1, 1, 1); PG8_STAGE(PG8_SB(1, 0), b3, voffB);
            PG8_BAR; PG8_WAIT_L(0); PG8_MMA(0, 1, At, B1); PG8_BAR;
            PG8_LDA(At, 1, 1); PG8_STAGE(PG8_SA(1, 0), a3, voffA);
            PG8_BAR; PG8_WAIT_L(0); PG8_MMA(1, 0, At, B0); PG8_BAR; PG8_SCHED;
            PG8_STAGE(PG8_SB(1, 1), b3 + hstep, voffB);
            PG8_WAIT_V(6); PG8_BAR; PG8_MMA(1, 1, At, B1); PG8_BAR;
        }
        PG8_STAMP();
        if constexpr (!Epi::AFTER_DRAIN) { E(acc, cur, wr, wc, fr, fq); S.done(cur); }
        PG8_STAMP();
        if (!has_next) break;
#pragma unroll
        for (int a = 0; a < 2; ++a)
#pragma unroll
            for (int b = 0; b < 2; ++b)
#pragma unroll
                for (int m = 0; m < 4; ++m)
#pragma unroll
                    for (int n = 0; n < 2; ++n) acc[a][b][m][n] = (f32x4){0.f, 0.f, 0.f, 0.f};
        cur = nxt; cA = nA; cB = nB; ++ui;
    }
    PG8_WAIT_V(0);
    if (wr == 0) PG8_BAR;
    PG8_BAR;
    if constexpr (Epi::AFTER_DRAIN) { E.fused(acc, cur, wr, wc, fr, fq, lds, wid, lane); S.done(cur); }
    PG8_STAMP();
    if (STAMP && wid == 0) { stamps[lane] = lane < nts ? (((unsigned long long)(unsigned)ts_hi << 32) | (unsigned)ts_lo) : 0ull;
        if (lane == 62) stamps[62] = rt_entry; if (lane == 63) stamps[63] = (unsigned long long)wall_clock64(); }
#undef PG8_STAMP
#undef PG8_SA
#undef PG8_SB
#undef PG8_STAGE
#undef PG8_LDA
#undef PG8_LDB
#undef PG8_MMA
#undef PG8_WAIT_V
#undef PG8_WAIT_L
#undef PG8_BAR
#undef PG8_SCHED
}
}

template <class EP, bool SWAPROLE> struct EpiAdapt {
  static constexpr bool PERM = false, AFTER_DRAIN = false;
  EP ep; int roff, coff;
  DI void operator()(const f32x4 (&acc)[2][2][4][2], const pg8::Unit& u, int wr, int wc, int fr, int fq) const {
    const int row0 = u.pm * 256 + wr * 64 + fr + roff, col0 = u.pn * 256 + wc * 32 + 4 * fq + coff;
#pragma unroll
    for (int ai = 0; ai < 2; ++ai)
#pragma unroll
      for (int m = 0; m < 4; ++m)
#pragma unroll
        for (int bj = 0; bj < 2; ++bj)
#pragma unroll
          for (int n = 0; n < 2; ++n) {
            const int r = row0 + ai * 128 + m * 16, c = col0 + bj * 128 + n * 16;
            if (SWAPROLE) ep.apply(c, r, acc[ai][bj][m][n]);
            else ep.apply_t(r, c, acc[ai][bj][m][n]);
          }
  }
};
template <class EP> struct EpiAdaptP {
  static constexpr bool PERM = true, AFTER_DRAIN = false;
  EP ep;
  DI void operator()(const f32x4 (&acc)[2][2][4][2], const pg8::Unit& u, int wr, int wc, int fr, int fq) const {
    const int row0 = u.pm * 256 + wr * 64 + fr, col0 = u.pn * 256 + wc * 32 + 8 * fq;
#pragma unroll
    for (int ai = 0; ai < 2; ++ai)
#pragma unroll
      for (int m = 0; m < 4; ++m)
#pragma unroll
        for (int bj = 0; bj < 2; ++bj)
          ep.apply_t8(row0 + ai * 128 + m * 16, col0 + bj * 128, acc[ai][bj][m][0], acc[ai][bj][m][1]);
  }
};
template <class EP>
DI void run_phase_p(char* smem_all, const u16* A, const u16* Bt, int M, int N, int K, const EP& ep) {
  pg8::Gemm g; g.A = A; g.Bt = Bt; g.M = M; g.N = N; g.K = K;
  pg8::StaticOrder S; S.init(M, N, (int)gridDim.x, rbidx());
  EpiAdaptP<EP> E; E.ep = ep;
  __syncthreads();
  pg8::gemm_phase<EpiAdaptP<EP>, pg8::StaticOrder, false>((PG8_LAS unsigned char*)smem_all, g, S, E, nullptr);
  __syncthreads();
}
template <class EP, bool SWAPROLE>
DI void run_phase(char* smem_all, const u16* A, const u16* Bt, int M, int N, int K, const EP& ep, int roff, int coff) {
  pg8::Gemm g; g.A = A; g.Bt = Bt; g.M = M; g.N = N; g.K = K;
  pg8::StaticOrder S; S.init(M, N, (int)gridDim.x, rbidx());
  EpiAdapt<EP, SWAPROLE> E; E.ep = ep; E.roff = roff; E.coff = coff;
  __syncthreads();
  pg8::gemm_phase<EpiAdapt<EP, SWAPROLE>, pg8::StaticOrder, false>((PG8_LAS unsigned char*)smem_all, g, S, E, nullptr);
  __syncthreads();
}

DI void tr_tile(const float* src, int K, int N, int Nvalid, u16* dst, const float* gk, int tile, char* smem, bool perm_ukv) {
  float* t = (float*)smem;
  int ntn = N / 64, kt = tile / ntn, nt = tile % ntn, k0 = kt * 64, n0 = nt * 64, tid = tidx();
#pragma unroll
  for (int ps = 0; ps < 4; ++ps) {
    int i = ps * 16 + (tid >> 4), j = (tid & 15) * 4;
    F4 v = mkf4(0.f, 0.f, 0.f, 0.f);
    if (n0 + j < Nvalid) v = *(const F4*)(src + (size_t)(k0 + i) * Nvalid + n0 + j);
    float sc = gk ? gk[k0 + i] : 1.f;
    t[i * 65 + j] = v.x * sc; t[i * 65 + j + 1] = v.y * sc; t[i * 65 + j + 2] = v.z * sc; t[i * 65 + j + 3] = v.w * sc;
  }
  __syncthreads();
  int n = tid >> 2, kc = (tid & 3) * 16;
  u32 o[8];
#pragma unroll
  for (int e = 0; e < 8; ++e) o[e] = pack2(t[(kc + 2 * e) * 65 + n], t[(kc + 2 * e + 1) * 65 + n]);
  int nn = n0 + n;
  if (perm_ukv) { int hh = nn / 160, cc = nn % 160; nn = cc < 64 ? hh * 64 + cc : 512 + hh * 96 + (cc - 64); }
  U4* d = (U4*)(dst + (size_t)nn * K + k0 + kc);
  d[0] = mk4(o[0], o[1], o[2], o[3]);
  d[1] = mk4(o[4], o[5], o[6], o[7]);
}

DI void mod_item(const Params& p, int it, char* smem) {
  float* sc = (float*)smem;
  float* red = sc + 5 * 1024;
  int l = it / 96, chunk = it % 96, tid = tidx(), lane = tid & 63, w = tid >> 6;
  for (int e = tid; e < 5 * 1024; e += 256) {
    int r = e >> 10, k = e & 1023;
    float v = r < 4 ? p.c[r * 1024 + k] : p.c_ctx[k];
    sc[e] = v / (1.f + __expf(-v));
  }
  __syncthreads();
  int n = chunk * 64 + lane;
  const float* W = p.mod_w + (size_t)l * 1024 * 6144 + n;
  float a0 = 0, a1 = 0, a2 = 0, a3 = 0, a4 = 0;
#pragma unroll 16
  for (int kk = 0; kk < 256; ++kk) {
    int k = w * 256 + kk;
    float wv = W[(size_t)k * 6144];
    a0 += sc[k] * wv; a1 += sc[1024 + k] * wv; a2 += sc[2048 + k] * wv; a3 += sc[3072 + k] * wv; a4 += sc[4096 + k] * wv;
  }
  red[(w * 5 + 0) * 64 + lane] = a0; red[(w * 5 + 1) * 64 + lane] = a1; red[(w * 5 + 2) * 64 + lane] = a2;
  red[(w * 5 + 3) * 64 + lane] = a3; red[(w * 5 + 4) * 64 + lane] = a4;
  __syncthreads();
  if (w == 0) {
    float bv = p.mod_b[l * 6144 + n];
    float* o = (float*)(wsp(p) + O_MOD) + (size_t)l * 5 * 6144 + n;
#pragma unroll
    for (int r = 0; r < 5; ++r) o[r * 6144] = red[(0 * 5 + r) * 64 + lane] + red[(1 * 5 + r) * 64 + lane] + red[(2 * 5 + r) * 64 + lane] + red[(3 * 5 + r) * 64 + lane] + bv;
  }
}

DI void filt_item(const Params& p, char* smem, int Lf, int p0, u16* Tg) {
  const int TgLen = 2 * Lf, tid = tidx();
  float* zf = (float*)smem;
  float* h1 = zf + 32 * 33;
  float* w1s = h1 + 32 * 64;
  float* w2s = w1s + 33 * 64;
  float* h2 = w2s + 64 * 64;
  u16* st = (u16*)smem;
  constexpr int STR = 258;
  for (int e = tid; e < 33 * 64; e += 256) w1s[e] = p.hy_w1[e];
  for (int e = tid; e < 64 * 64; e += 256) w2s[e] = p.hy_w2[e];
#pragma unroll 1
  for (int batch = 0; batch < 2; ++batch) {
    for (int e = tid; e < 32 * 33; e += 256) {
      int pos = e / 33, f = e % 33; float pp = (float)(p0 + 32 * batch + pos);
      float t = pp / (float)(Lf - 1), wv = 6.283185307179586f * pp / (float)Lf, val;
      if (f == 0) val = t;
      else {
        int fi = (f - 1) & 15;
        float fr = 1e-4f + (float)fi * ((15.f - 1e-4f) / 15.f);
        val = (f <= 16) ? cosf(wv * fr) : -sinf(wv * fr);
      }
      zf[e] = val;
    }
    __syncthreads();
    {
      int pos = tid >> 3, ug = tid & 7;
      float acc[8];
#pragma unroll
      for (int uu = 0; uu < 8; ++uu) acc[uu] = p.hy_b1[ug + 8 * uu];
#pragma unroll 3
      for (int f = 0; f < 33; ++f) {
        float z = zf[pos * 33 + f];
#pragma unroll
        for (int uu = 0; uu < 8; ++uu) acc[uu] += z * w1s[f * 64 + ug + 8 * uu];
      }
#pragma unroll
      for (int uu = 0; uu < 8; ++uu) h1[pos * 64 + ug + 8 * uu] = sinf(p.hy_freq[ug + 8 * uu] * acc[uu]);
    }
    __syncthreads();
    {
      int pos = tid >> 3, ug = tid & 7;
      float acc[8];
#pragma unroll
      for (int uu = 0; uu < 8; ++uu) acc[uu] = p.hy_b2[ug + 8 * uu];
#pragma unroll 4
      for (int f = 0; f < 64; ++f) {
        float z = h1[pos * 64 + f];
#pragma unroll
        for (int uu = 0; uu < 8; ++uu) acc[uu] += z * w2s[f * 64 + ug + 8 * uu];
      }
#pragma unroll
      for (int uu = 0; uu < 8; ++uu) h2[(32 * batch + pos) * 64 + ug + 8 * uu] = sinf(p.hy_freq[ug + 8 * uu] * acc[uu]);
    }
    __syncthreads();
  }
#pragma unroll 1
  for (int cc = 0; cc < 8; ++cc) {
    int col = cc * 256 + tid;
    float w3r[64];
#pragma unroll
    for (int u = 0; u < 64; ++u) w3r[u] = p.hy_w3[u * 2048 + col];
    float ld = __expf(p.hy_log_decay[col]);
    int conv = col >> 10, dir = (col >> 9) & 1, c = col & 511;
    float skipv = p.hy_skip[conv * 512 + c];
#pragma unroll 1
    for (int pos = 0; pos < 64; ++pos) {
      float a = 0.f;
#pragma unroll
      for (int u = 0; u < 64; ++u) a += h2[pos * 64 + u] * w3r[u];
      int pp = p0 + pos;
      float t = (float)pp / (float)(Lf - 1);
      float val = a * __expf(-t * ld);
      if (pp == 0) val = (dir == 0) ? (val + skipv) : 0.f;
      st[pos * STR + tid] = f2bf(val);
    }
    __syncthreads();
#pragma unroll 1
    for (int k = 0; k < 64; ++k) {
      int cl = (tid >> 6) + 4 * k, pos = tid & 63, colw = cc * 256 + cl, pp = p0 + pos;
      int conv2 = colw >> 10, dir2 = (colw >> 9) & 1, c2 = colw & 511;
      Tg[(size_t)(conv2 * 512 + c2) * TgLen + dir2 * Lf + pp] = st[pos * STR + cl];
    }
    __syncthreads();
  }
}

constexpr int NT_TR = 768 + 256 + 1024 + 1024 + 1024 + 1024 + 256 + 256 + 72 + 80;
constexpr int N_PREP = NT_TR + 192 + 128 + 4;

DI void phase_prep(const Params& p, char* smem) {
  char* ws = wsp(p);
  for (int it = bidx(); it < N_PREP; it += NVB) {
    __syncthreads();
    int t = it;
    if (t < NT_TR) {
      const float* src; int K, N, Nv; u16* dst; const float* gk = nullptr; bool perm = false;
      if (t < 768) { src = p.ab_w_in; K = 1024; N = 3072; Nv = 3072; dst = (u16*)(ws + O_WT_ABIN); }
      else if ((t -= 768) < 256) { src = p.ab_w_out; K = 1024; N = 1024; Nv = 1024; dst = (u16*)(ws + O_WT_ABOUT); }
      else if ((t -= 256) < 2048) { int l = t >> 10; t &= 1023; src = p.mlp_w1 + (size_t)l * 1024 * 4096; K = 1024; N = 4096; Nv = 4096; dst = (u16*)(ws + O_WT_W1) + (size_t)l * 4096 * 1024; }
      else if ((t -= 2048) < 2048) { int l = t >> 10; t &= 1023; src = p.mlp_w2 + (size_t)l * 1024 * 4096; K = 4096; N = 1024; Nv = 1024; dst = (u16*)(ws + O_WT_W2) + (size_t)l * 4096 * 1024; }
      else if ((t -= 2048) < 256) { src = p.cd_w_in; K = 1024; N = 1024; Nv = 928; dst = (u16*)(ws + O_WT_CDIN); }
      else if ((t -= 256) < 256) { src = p.cd_w_out; K = 1024; N = 1024; Nv = 1024; dst = (u16*)(ws + O_WT_CDOUT); }
      else if ((t -= 256) < 72) { src = p.mla_w_uq; K = 384; N = 768; Nv = 768; dst = (u16*)(ws + O_WT_UQ); gk = p.mla_q_norm; }
      else { t -= 72; src = p.mla_w_ukv; K = 256; N = 1280; Nv = 1280; dst = (u16*)(ws + O_WT_UKV); gk = p.mla_kv_norm; perm = true; }
      tr_tile(src, K, N, Nv, dst, gk, t, smem, perm);
      continue;
    }
    t -= NT_TR;
    if (t < 192) { mod_item(p, t, smem); continue; }
    t -= 192;
    int Lf = SEQL; u16* Tg = (u16*)(ws + O_TLAT);
    if (t >= 128) { t -= 128; Lf = LC; Tg = (u16*)(ws + O_TCTX); }
    filt_item(p, smem, Lf, t * 64, Tg);
  }
}

template <bool FROM_IN, bool AFFINE, bool MOD>
DI void phase_ln(const Params& p, int nrows, const float* g, const float* bb, float* dst, bool dst_is_S, int lmod, int shoff,
                 int scoff) {
  const int lane = tidx() & 63, wv = tidx() >> 6;
  const int gw = bidx() * 4 + wv, nw = NVB * 4;
  float* S = (float*)(wsp(p) + O_S);
  u16* hbuf = (u16*)(wsp(p) + O_HBUF);
  for (int m = gw; m < nrows; m += nw) {
    const float* src;
    if (FROM_IN) src = (m < NLAT) ? p.x + (size_t)m * 1024 : p.ctx + (size_t)(m - NLAT) * 1024;
    else src = S + (size_t)m * 1024;
    float v[16];
#pragma unroll
    for (int i = 0; i < 4; ++i) {
      F4 q = *(const F4*)(src + i * 256 + lane * 4);
      v[4 * i] = q.x; v[4 * i + 1] = q.y; v[4 * i + 2] = q.z; v[4 * i + 3] = q.w;
    }
    if (AFFINE) {
      float s = 0.f;
#pragma unroll
      for (int i = 0; i < 16; ++i) s += v[i];
      float mu = wave_sum(s) * (1.f / 1024.f);
      float q2 = 0.f;
#pragma unroll
      for (int i = 0; i < 16; ++i) { float d = v[i] - mu; q2 += d * d; }
      float rstd = rsqrtf(wave_sum(q2) * (1.f / 1024.f) + LN_EPS);
      float* drow = dst_is_S ? (S + (size_t)m * 1024) : (dst + (size_t)m * 1024);
#pragma unroll
      for (int i = 0; i < 4; ++i) {
        int e = i * 256 + lane * 4;
        F4 gg = *(const F4*)(g + e), b4 = *(const F4*)(bb + e);
        v[4 * i] = (v[4 * i] - mu) * rstd * gg.x + b4.x;
        v[4 * i + 1] = (v[4 * i + 1] - mu) * rstd * gg.y + b4.y;
        v[4 * i + 2] = (v[4 * i + 2] - mu) * rstd * gg.z + b4.z;
        v[4 * i + 3] = (v[4 * i + 3] - mu) * rstd * gg.w + b4.w;
        *(F4*)(drow + e) = mkf4(v[4 * i], v[4 * i + 1], v[4 * i + 2], v[4 * i + 3]);
      }
    }
    if (MOD) {
      float s = 0.f;
#pragma unroll
      for (int i = 0; i < 16; ++i) s += v[i];
      float mu = wave_sum(s) * (1.f / 1024.f);
      float q2 = 0.f;
#pragma unroll
      for (int i = 0; i < 16; ++i) { float d = v[i] - mu; q2 += d * d; }
      float rstd = rsqrtf(wave_sum(q2) * (1.f / 1024.f) + LN_EPS);
      const float* md = modp(p, lmod, bidx_of(m));
#pragma unroll
      for (int i = 0; i < 4; ++i) {
        int e = i * 256 + lane * 4;
        F4 sh = *(const F4*)(md + shoff + e), sc = *(const F4*)(md + scoff + e);
        float o0 = (v[4 * i] - mu) * rstd * (1.f + sc.x) + sh.x;
        float o1 = (v[4 * i + 1] - mu) * rstd * (1.f + sc.y) + sh.y;
        float o2 = (v[4 * i + 2] - mu) * rstd * (1.f + sc.z) + sh.z;
        float o3 = (v[4 * i + 3] - mu) * rstd * (1.f + sc.w) + sh.w;
        *(U2*)(hbuf + (size_t)m * 1024 + e) = mk2(pack2(o0, o1), pack2(o2, o3));
      }
    }
  }
}

DI bf16x8 toep_frag(const u32* Tr32, int o) {
  int wd = o >> 1; u32 sh = (o & 1) * 16;
  u32 d0 = Tr32[wd], d1 = Tr32[wd + 1], d2 = Tr32[wd + 2], d3 = Tr32[wd + 3], d4 = Tr32[wd + 4];
  U4 q = mk4(__builtin_amdgcn_alignbit(d1, d0, sh), __builtin_amdgcn_alignbit(d2, d1, sh),
                       __builtin_amdgcn_alignbit(d3, d2, sh), __builtin_amdgcn_alignbit(d4, d3, sh));
  return __builtin_bit_cast(bf16x8, q);
}

DI void toep_item(const Params& p, char* smem, int cv, int c, int bp) {
  const int tid = tidx(), lane = tid & 63, w = tid >> 6, r16 = lane & 15, g = lane >> 4;
  u16* Tr = (u16*)smem;
  u16* Zs = Tr + 16384 + 16;
  const u16* uhyT = (const u16*)(wsp(p) + O_UHYT);
  u16* zT = (u16*)(wsp(p) + O_ZT);
  u16* yhyT = (u16*)(wsp(p) + O_YHYT);
  {
    const u16* GF = (const u16*)(wsp(p) + O_TLAT) + (size_t)(cv * 512 + c) * 16384;
    const U4* GB = (const U4*)(GF + 8192);
    const u16 t0v = GF[0];
    for (int e = tid; e < 1024; e += 256) {
      U4 q = GB[e];
      if (e == 0) q.x = (q.x & 0xffff0000u) | (u32)t0v;
      ((U4*)Tr)[1024 + e] = q;
    }
    for (int e = tid; e < 1024; e += 256) {
      U4 q = ((const U4*)GF)[e];
      u16* d = Tr + 8192 - 8 * e;
      d[0] = (u16)(q.x); d[-1] = (u16)(q.x >> 16); d[-2] = (u16)(q.y); d[-3] = (u16)(q.y >> 16);
      d[-4] = (u16)(q.z); d[-5] = (u16)(q.z >> 16); d[-6] = (u16)(q.w); d[-7] = (u16)(q.w >> 16);
    }
    if (tid == 0) Tr[0] = 0;
    if (tid < 2) { u32 z = 0; asm volatile("" : "+v"(z)); ((U4*)Tr)[2048 + tid] = mk4(z, z, z, z); }
  }
  for (int bb = 0; bb < 2; ++bb) {
    int b = 2 * bp + bb;
    if (cv == 0) {
      const u16* src = uhyT + ((size_t)(b * 1536 + 1024 + c)) * LT;
      float w0 = p.hy_conv_w[1024 + c], w1 = p.hy_conv_w[1536 + 1024 + c], w2 = p.hy_conv_w[2 * 1536 + 1024 + c];
      for (int e = tid; e < 1024; e += 256) {
        int s0 = e * 8;
        U4 q = *(const U4*)(src + s0);
        float u[10];
        u[0] = s0 > 0 ? bf2f(src[s0 - 1]) : 0.f;
        u[9] = s0 + 8 < SEQL ? bf2f(src[s0 + 8]) : 0.f;
        u32 ww[4] = {q.x, q.y, q.z, q.w};
#pragma unroll
        for (int k = 0; k < 4; ++k) { u[1 + 2 * k] = __uint_as_float(ww[k] << 16); u[2 + 2 * k] = __uint_as_float(ww[k] & 0xffff0000u); }
        float o[8];
#pragma unroll
        for (int k = 0; k < 8; ++k) o[k] = w0 * u[k] + w1 * u[k + 1] + w2 * u[k + 2];
        *(U4*)(Zs + bb * 8192 + s0) = mk4(pack2(o[0], o[1]), pack2(o[2], o[3]), pack2(o[4], o[5]), pack2(o[6], o[7]));
      }
    } else {
      const U4* src = (const U4*)(zT + ((size_t)(b * 512 + c)) * LT);
      for (int e = tid; e < 1024; e += 256) ((U4*)(Zs + bb * 8192))[e] = src[e];
    }
  }
  __syncthreads();
  const int bb = w >> 1, hw = w & 1;
  const u16* Zb = Zs + bb * 8192;
  const u32* Tr32 = (const u32*)Tr;
  f32x4 acc[4][4];
#pragma unroll
  for (int i = 0; i < 4; ++i)
#pragma unroll
    for (int j = 0; j < 4; ++j) acc[i][j] = f32x4{0.f, 0.f, 0.f, 0.f};
  const int obase = 8192 - r16 + 8 * g;
  const int dl_lo = hw ? -63 : -127, dl_hi = hw ? 127 : 63;
  bf16x8 F[6];
#pragma unroll
  for (int e = 0; e < 6; ++e) F[e] = toep_frag(Tr32, obase - 16 * (4 * dl_lo - 2 + e));
  for (int dl = dl_lo; dl <= dl_hi; ++dl) {
    int lo = dl > 0 ? dl : 0, hi = dl < 0 ? 127 + dl : 127;
    bf16x8 Fn[4];
    {
      int dn = dl < dl_hi ? dl + 1 : dl;
#pragma unroll
      for (int e = 0; e < 4; ++e) Fn[e] = toep_frag(Tr32, obase - 16 * (4 * dn + e));
    }
#pragma unroll
    for (int nt = 0; nt < 4; ++nt) {
      int t1lo = 64 * hw + 16 * nt;
      if (t1lo + 15 < lo || t1lo > hi) continue;
      int s1 = t1lo + r16 - dl;
      bool ok = (s1 >= 0) && (s1 < 128);
      int s1c = ok ? s1 : 0;
#pragma unroll
      for (int ks = 0; ks < 2; ++ks) {
        U4 q = *(const U4*)(Zb + 64 * s1c + 32 * ks + 8 * g);
        if (!ok) q = mk4(0, 0, 0, 0);
        bf16x8 bfr = __builtin_bit_cast(bf16x8, q);
#pragma unroll
        for (int mt = 0; mt < 4; ++mt) acc[mt][nt] = mfma16(F[mt - 2 * ks + 2], bfr, acc[mt][nt]);
      }
    }
    F[0] = F[4]; F[1] = F[5]; F[2] = Fn[0]; F[3] = Fn[1]; F[4] = Fn[2]; F[5] = Fn[3];
  }
  {
    int b = 2 * bp + bb, choff = (cv == 0) ? 0 : 512;
    const u16* xr = uhyT + ((size_t)(b * 1536 + choff + c)) * LT;
    float w0 = p.hy_conv_w[choff + c], w1 = p.hy_conv_w[1536 + choff + c], w2 = p.hy_conv_w[2 * 1536 + choff + c];
    u16* dst = (cv == 0 ? zT : yhyT) + ((size_t)(b * 512 + c)) * LT;
#pragma unroll
    for (int mt = 0; mt < 4; ++mt)
#pragma unroll
      for (int nt = 0; nt < 4; ++nt) {
        int t = 64 * (64 * hw + 16 * nt + r16) + 16 * mt + 4 * g;
        U2 q = *(const U2*)(xr + t);
        float u[6];
        u[0] = t > 0 ? bf2f(xr[t - 1]) : 0.f;
        u[5] = t + 4 < SEQL ? bf2f(xr[t + 4]) : 0.f;
        u[1] = __uint_as_float(q.x << 16); u[2] = __uint_as_float(q.x & 0xffff0000u);
        u[3] = __uint_as_float(q.y << 16); u[4] = __uint_as_float(q.y & 0xffff0000u);
        float o[4];
#pragma unroll
        for (int r = 0; r < 4; ++r) o[r] = (w0 * u[r] + w1 * u[r + 1] + w2 * u[r + 2]) * acc[mt][nt][r];
        *(U2*)(dst + t) = mk2(pack2(o[0], o[1]), pack2(o[2], o[3]));
      }
  }
}

DI void toep_ctx_item(const Params& p, char* smem, int cv, int c) {
  const int tid = tidx();
  float* Tf = (float*)smem;
  float* zf = Tf + 512;
  const u16* uhyT = (const u16*)(wsp(p) + O_UHYT);
  u16* zT = (u16*)(wsp(p) + O_ZT);
  u16* yhyT = (u16*)(wsp(p) + O_YHYT);
  const u16* Tg = (const u16*)(wsp(p) + O_TCTX) + (size_t)(cv * 512 + c) * 512;
  Tf[256 - tid] = bf2f(Tg[tid]);
  if (tid > 0) Tf[256 + tid] = bf2f(Tg[256 + tid]);
  if (tid == 0) Tf[0] = 0.f;
  for (int b = 0; b < 4; ++b) {
    float zv;
    if (cv == 0) {
      const u16* src = uhyT + ((size_t)(b * 1536 + 1024 + c)) * LT + SEQL;
      float w0 = p.hy_conv_w[1024 + c], w1 = p.hy_conv_w[1536 + 1024 + c], w2 = p.hy_conv_w[2 * 1536 + 1024 + c];
      float um = tid > 0 ? bf2f(src[tid - 1]) : 0.f, u0 = bf2f(src[tid]), up = tid < 255 ? bf2f(src[tid + 1]) : 0.f;
      zv = bf2f(f2bf(w0 * um + w1 * u0 + w2 * up));
    } else {
      zv = bf2f(zT[((size_t)(b * 512 + c)) * LT + SEQL + tid]);
    }
    zf[b * 256 + tid] = zv;
  }
  __syncthreads();
  int choff = (cv == 0) ? 0 : 512;
  float w0 = p.hy_conv_w[choff + c], w1 = p.hy_conv_w[1536 + choff + c], w2 = p.hy_conv_w[2 * 1536 + choff + c];
  for (int b = 0; b < 4; ++b) {
    float y = 0.f;
    for (int s = 0; s < 256; ++s) y += Tf[256 - (tid - s)] * zf[b * 256 + s];
    const u16* xr = uhyT + ((size_t)(b * 1536 + choff + c)) * LT + SEQL;
    float um = tid > 0 ? bf2f(xr[tid - 1]) : 0.f, u0 = bf2f(xr[tid]), up = tid < 255 ? bf2f(xr[tid + 1]) : 0.f;
    float o = (w0 * um + w1 * u0 + w2 * up) * y;
    u16* dst = (cv == 0 ? zT : yhyT) + ((size_t)(b * 512 + c)) * LT + SEQL;
    dst[tid] = f2bf(o);
  }
}

DI void natten_wave(const Params& p, u16* Pw, int b, int h, bool lat, int r, int j, int qt) {
  const int lane = tidx() & 63, r16 = lane & 15, g = lane >> 4;
  const u16* uqk = (const u16*)(wsp(p) + O_UQK);
  const u16* vT = (const u16*)(wsp(p) + O_VT0);
  u16* yna = (u16*)(wsp(p) + O_YNA);
  const int qm0 = lat ? b * 8192 + r * 64 + 16 * j : NLAT + b * 256 + 16 * qt;
  bf16x8 qa[2];
#pragma unroll
  for (int ks = 0; ks < 2; ++ks) qa[ks] = *(const bf16x8*)(uqk + (size_t)(qm0 + r16) * 1024 + h * 64 + 32 * ks + 8 * g);
  int rs = r - 4; rs = rs < 0 ? 0 : (rs > 120 ? 120 : rs);
  int kb = 16 * j - 8; kb = kb < 0 ? 0 : (kb > 32 ? 32 : kb);
  f32x4 S[32];
  const float NEG = -1e30f;
  const float* rpb = p.na_rpb + h * 15 * 31;
#pragma unroll
  for (int nt = 0; nt < 32; ++nt) {
    if (nt < 16 && !lat) { S[nt] = f32x4{NEG, NEG, NEG, NEG}; continue; }
    if ((nt & 7) == 0) __builtin_amdgcn_sched_barrier(0);
    int keytok;
    if (nt < 16) keytok = b * 8192 + (rs + (nt >> 1)) * 64 + kb + 16 * (nt & 1) + r16;
    else keytok = NLAT + b * 256 + 16 * (nt - 16) + r16;
    const u16* kp = uqk + (size_t)keytok * 1024 + 512 + h * 64 + 8 * g;
    f32x4 a = f32x4{0.f, 0.f, 0.f, 0.f};
    a = mfma16(qa[0], *(const bf16x8*)(kp), a);
    a = mfma16(qa[1], *(const bf16x8*)(kp + 32), a);
    if (nt < 16) {
      int rr = nt >> 1, kcol = kb + 16 * (nt & 1) + r16, dr = rs + rr - r + 7;
#pragma unroll
      for (int q = 0; q < 4; ++q) {
        int qcol = 16 * j + 4 * g + q;
        int cs = qcol - 8; cs = cs < 0 ? 0 : (cs > 48 ? 48 : cs);
        bool valid = (kcol >= cs) && (kcol < cs + 16);
        int dc = kcol - qcol + 15; dc = dc < 0 ? 0 : (dc > 30 ? 30 : dc);
        float bias = rpb[dr * 31 + dc];
        a[q] = valid ? (a[q] * 0.125f + bias) * LOG2E : NEG;
      }
    } else {
#pragma unroll
      for (int q = 0; q < 4; ++q) a[q] = a[q] * (0.125f * LOG2E);
    }
    S[nt] = a;
  }
  float mx[4], sm[4];
#pragma unroll
  for (int q = 0; q < 4; ++q) {
    float m = NEG;
#pragma unroll
    for (int nt = 0; nt < 32; ++nt) m = fmaxf(m, S[nt][q]);
    m = fmaxf(m, __shfl_xor(m, 1)); m = fmaxf(m, __shfl_xor(m, 2)); m = fmaxf(m, __shfl_xor(m, 4)); m = fmaxf(m, __shfl_xor(m, 8));
    mx[q] = m; sm[q] = 0.f;
  }
#pragma unroll
  for (int nt = 0; nt < 32; ++nt) {
    if (nt < 16 && !lat) continue;
#pragma unroll
    for (int q = 0; q < 4; ++q) {
      float pv = __builtin_amdgcn_exp2f(S[nt][q] - mx[q]);
      u16 pb = f2bf(pv);
      sm[q] += bf2f(pb);
      Pw[(4 * g + q) * 520 + 16 * nt + r16] = pb;
    }
  }
#pragma unroll
  for (int q = 0; q < 4; ++q) {
    float s = sm[q];
    s += __shfl_xor(s, 1); s += __shfl_xor(s, 2); s += __shfl_xor(s, 4); s += __shfl_xor(s, 8);
    sm[q] = 1.f / s;
  }
  __syncthreads();
  f32x4 O[4];
#pragma unroll
  for (int nt = 0; nt < 4; ++nt) O[nt] = f32x4{0.f, 0.f, 0.f, 0.f};
#pragma unroll
  for (int ks = 0; ks < 16; ++ks) {
    if (ks < 8 && !lat) continue;
    bf16x8 pa = *(const bf16x8*)(Pw + r16 * 520 + 32 * ks + 8 * g);
    size_t vcol = ks < 8 ? (size_t)(rs + ks) * 64 + kb + 8 * g : (size_t)SEQL + 32 * (ks - 8) + 8 * g;
#pragma unroll
    for (int nt = 0; nt < 4; ++nt) {
      bf16x8 vb = *(const bf16x8*)(vT + ((size_t)(b * 512 + h * 64 + 16 * nt + r16)) * LT + vcol);
      O[nt] = mfma16(pa, vb, O[nt]);
    }
  }
#pragma unroll
  for (int nt = 0; nt < 4; ++nt)
#pragma unroll
    for (int q = 0; q < 4; ++q) yna[(size_t)(qm0 + 4 * g + q) * 512 + h * 64 + 16 * nt + r16] = f2bf(O[nt][q] * sm[q]);
}

constexpr int SK_ROW = 104, SV_ROW = 68;
constexpr int MLA_STAGE = 64 * SK_ROW + 96 * SV_ROW;
DI void mla_part1(const u16* sK, const bf16x8 (&qf)[6], f32x16 (&O)[3], float& mrun, float& lrun, bf16x8 (&pf)[4], int c32, int h2) {
  f32x16 S[2];
#pragma unroll
  for (int mt = 0; mt < 2; ++mt) {
    f32x16 a;
#pragma unroll
    for (int i = 0; i < 16; ++i) a[i] = 0.f;
#pragma unroll
    for (int ks = 0; ks < 6; ++ks) {
      bf16x8 kf = *(const bf16x8*)(sK + (32 * mt + c32) * SK_ROW + 16 * ks + 8 * h2);
      a = mfma32(kf, qf[ks], a);
    }
    S[mt] = a;
  }
  float mx = -1e30f;
#pragma unroll
  for (int mt = 0; mt < 2; ++mt)
#pragma unroll
    for (int i = 0; i < 16; ++i) mx = fmaxf(mx, S[mt][i]);
  mx = fmaxf(mx, __shfl_xor(mx, 32));
  float mnew = fmaxf(mrun, mx);
  float alpha = __builtin_amdgcn_exp2f(mrun - mnew);
  mrun = mnew;
  f32x2 ps2 = f32x2{0.f, 0.f};
  f32x16 Sd[2];
  Sd[0] = S[0] - mnew; Sd[1] = S[1] - mnew;
#pragma unroll
  for (int mt = 0; mt < 2; ++mt)
#pragma unroll
    for (int s = 0; s < 2; ++s) {
      float e[8];
#pragma unroll
      for (int jj = 0; jj < 8; ++jj) e[jj] = __builtin_amdgcn_exp2f(Sd[mt][8 * s + jj]);
      ps2 += f32x2{e[0], e[1]}; ps2 += f32x2{e[2], e[3]}; ps2 += f32x2{e[4], e[5]}; ps2 += f32x2{e[6], e[7]};
      U4 q = mk4(pack2(e[0], e[1]), pack2(e[2], e[3]), pack2(e[4], e[5]), pack2(e[6], e[7]));
      pf[mt * 2 + s] = __builtin_bit_cast(bf16x8, q);
    }
  lrun = lrun * alpha + (ps2[0] + ps2[1]);
  if (__any(alpha != 1.f)) {
#pragma unroll
    for (int d = 0; d < 3; ++d)
#pragma unroll
      for (int i = 0; i < 16; ++i) O[d][i] *= alpha;
  }
}
DI void mla_part2(const u16* sV, const bf16x8 (&pf)[4], f32x16 (&O)[3], int c32, int h2) {
#pragma unroll
  for (int kk = 0; kk < 4; ++kk) {
    int keybase = 16 * kk + 4 * h2;
#pragma unroll
    for (int d = 0; d < 3; ++d) {
      const u16* vp = sV + (32 * d + c32) * SV_ROW + keybase;
      U2 lo = *(const U2*)(vp), hi = *(const U2*)(vp + 8);
      U4 q = mk4(lo.x, lo.y, hi.x, hi.y);
      O[d] = mfma32(__builtin_bit_cast(bf16x8, q), pf[kk], O[d]);
    }
  }
}

DI void mla_item512(const Params& p, char* smem_all, int b, int h, int qb) {
  const int tid = tid512(), lane = tid & 63, w = tid >> 6, c32 = lane & 31, h2 = lane >> 5;
  const u16* Q = (const u16*)(wsp(p) + O_Q);
  const u16* KNg = (const u16*)(wsp(p) + O_KB) + (size_t)(b * 8 + h) * LT * 64;
  const u16* KPg = (const u16*)(wsp(p) + O_KP) + (size_t)b * LT * 32;
  const u16* Vg = (const u16*)(wsp(p) + O_VT1) + (size_t)(b * 8 + h) * 96 * LT;
  u16* Y1 = (u16*)(wsp(p) + O_Y1);
  u16* sb = (u16*)smem_all;
  const int qrow = b * 8192 + qb * 256 + w * 32 + c32;
  bf16x8 qf[6];
#pragma unroll
  for (int ks = 0; ks < 6; ++ks) qf[ks] = *(const bf16x8*)(Q + (size_t)qrow * 768 + h * 96 + 16 * ks + 8 * h2);
  f32x16 O[3];
#pragma unroll
  for (int d = 0; d < 3; ++d)
#pragma unroll
    for (int i = 0; i < 16; ++i) O[d][i] = 0.f;
  float mrun = -1e30f, lrun = 0.f;
  const int kkey = tid / 12, kkc = tid % 12;
  const u16* kp0 = kkc < 8 ? KNg + kkey * 64 + kkc * 8 : KPg + kkey * 32 + (kkc - 8) * 8;
  const int kstep0 = kkc < 8 ? 64 * 64 : 64 * 32;
  const int kdst = kkey * SK_ROW + kkc * 8;
  const u16* vp0 = Vg + (size_t)(tid >> 3) * LT + (tid & 7) * 8;
  const int vdst = 64 * SK_ROW + (tid >> 3) * SV_ROW + (tid & 7) * 8;
  const bool xk = tid < 256;
  const int xc = xk ? 512 + tid : tid + 256;
  const int xkey = xc / 12, xkc = xc % 12;
  const u16* xp0 = xk ? (xkc < 8 ? KNg + xkey * 64 + xkc * 8 : KPg + xkey * 32 + (xkc - 8) * 8) : Vg + (size_t)(xc >> 3) * LT + (xc & 7) * 8;
  const int xstep = xk ? (xkc < 8 ? 64 * 64 : 64 * 32) : 64;
  const int xdst = xk ? (xc / 12) * SK_ROW + (xc % 12) * 8 : 64 * SK_ROW + (xc >> 3) * SV_ROW + (xc & 7) * 8;
  U4 ka, va, xa, kb2, vb2, xb2;
#define MLA5_FETCH(K_, V_, X_, kt_) { K_ = *(const U4*)(kp0 + (size_t)(kt_) * kstep0); V_ = *(const U4*)(vp0 + (kt_) * 64); X_ = *(const U4*)(xp0 + (size_t)(kt_) * xstep); }
#define MLA5_COMMIT(K_, V_, X_, st_) { *(U4*)((st_) + kdst) = K_; *(U2*)((st_) + vdst) = mk2(V_.x, V_.y); *(U2*)((st_) + vdst + 4) = mk2(V_.z, V_.w); *(U2*)((st_) + xdst) = mk2(X_.x, X_.y); *(U2*)((st_) + xdst + 4) = mk2(X_.z, X_.w); }
  constexpr int NKT = LT / 64;
  const int grp = w >> 2;
  u16* sc = sb; u16* sn = sb + MLA_STAGE; u16* sp = sb + 2 * MLA_STAGE;
  bf16x8 pf[4];
  MLA5_FETCH(ka, va, xa, 0);
  MLA5_FETCH(kb2, vb2, xb2, 1);
  __syncthreads();
  MLA5_COMMIT(ka, va, xa, sc);
  __syncthreads();
  for (int kt = 0; kt < NKT; kt += 2) {
    { int k2 = kt + 2 < NKT ? kt + 2 : NKT - 2; MLA5_FETCH(ka, va, xa, k2); }
    __builtin_amdgcn_sched_barrier(0);
    if (grp == 0) { mla_part1(sc, qf, O, mrun, lrun, pf, c32, h2); mla_part2(sc + 64 * SK_ROW, pf, O, c32, h2); }
    else { if (kt > 0) mla_part2(sp + 64 * SK_ROW, pf, O, c32, h2); mla_part1(sc, qf, O, mrun, lrun, pf, c32, h2); }
    MLA5_COMMIT(kb2, vb2, xb2, sn);
    __syncthreads();
    { u16* t_ = sp; sp = sc; sc = sn; sn = t_; }
    { int k3 = kt + 3 < NKT ? kt + 3 : NKT - 1; MLA5_FETCH(kb2, vb2, xb2, k3); }
    __builtin_amdgcn_sched_barrier(0);
    if (grp == 0) { mla_part1(sc, qf, O, mrun, lrun, pf, c32, h2); mla_part2(sc + 64 * SK_ROW, pf, O, c32, h2); }
    else { mla_part2(sp + 64 * SK_ROW, pf, O, c32, h2); mla_part1(sc, qf, O, mrun, lrun, pf, c32, h2); }
    MLA5_COMMIT(ka, va, xa, sn);
    __syncthreads();
    { u16* t_ = sp; sp = sc; sc = sn; sn = t_; }
  }
  if (grp == 1) mla_part2(sp + 64 * SK_ROW, pf, O, c32, h2);
#undef MLA5_FETCH
#undef MLA5_COMMIT
  float l = lrun + __shfl_xor(lrun, 32);
  float inv = 1.f / l;
#pragma unroll
  for (int d = 0; d < 3; ++d)
#pragma unroll
    for (int i4 = 0; i4 < 4; ++i4) {
      int dd = 32 * d + 8 * i4 + 4 * h2;
      U2 o = mk2(pack2(O[d][4 * i4] * inv, O[d][4 * i4 + 1] * inv), pack2(O[d][4 * i4 + 2] * inv, O[d][4 * i4 + 3] * inv));
      *(U2*)(Y1 + (size_t)qrow * 1024 + h * 96 + dd) = o;
    }
}

DI void kpe_item(const Params& p, int it) {
  const int tid = tidx();
  const u16* u1 = (const u16*)(wsp(p) + O_U1);
  u16* kp = (u16*)(wsp(p) + O_KP);
#pragma unroll
  for (int ps = 0; ps < 8; ++ps) {
    int m = it * 64 + ps * 8 + (tid >> 5), i = tid & 31;
    float v = bf2f(u1[(size_t)m * 1024 + 640 + i]);
    float pr = bf2f(u1[(size_t)m * 1024 + 640 + (i ^ 8)]);
    int b, s; bs_of(m, b, s);
    float o = v;
    if (m < NLAT) {
      int axis = i >> 4, second = (i >> 3) & 1, idx = i & 7;
      float inv = exp2f(-(float)idx * (13.287712379549449f / 8.f));
      float pos = (float)(axis ? (s & 63) : (s >> 6));
      float rv = pos * inv * 0.15915494309189535f; float sn = __builtin_amdgcn_sinf(rv), cs = __builtin_amdgcn_cosf(rv);
      o = second ? (v * cs + pr * sn) : (v * cs - pr * sn);
    }
    kp[((size_t)b * LT + s) * 32 + i] = f2bf(o);
  }
}

DI void fnet1_item(const Params& p, char* smem, int it) {
  const int tid = tidx(), lane = tid & 63, w = tid >> 6, r16 = lane & 15, g4 = lane >> 4;
  constexpr int XROW = 264, TROW = 72;
  u16* xb = (u16*)smem;
  u16* tt = xb + 64 * XROW;
  const u16* u1 = (const u16*)(wsp(p) + O_U1);
  u16* XT = (u16*)(wsp(p) + O_XT);
  const int m0 = it * 64;
  for (int e = tid; e < 64 * 32; e += 256) {
    int tok = e >> 5, c8 = e & 31;
    *(U4*)(xb + tok * XROW + c8 * 8) = *(const U4*)(u1 + (size_t)(m0 + tok) * 1024 + 672 + c8 * 8);
  }
  for (int e = tid; e < 128 * 64; e += 256) {
    int n = e >> 6, j = e & 63;
    float rv = (float)((n * j) & 63) * (1.f / 64.f);
    float v = (n < 64) ? __builtin_amdgcn_cosf(rv) : __builtin_amdgcn_sinf(rv);
    tt[n * TROW + j] = f2bf(v);
  }
  __syncthreads();
  {
    const int tok = tid & 63, gq = tid >> 6;
    u16* xp = xb + tok * XROW + gq * 64;
    float xr[64];
#pragma unroll
    for (int c = 0; c < 8; ++c) {
      U4 q = *(const U4*)(xp + c * 8);
      u32 ww[4] = {q.x, q.y, q.z, q.w};
#pragma unroll
      for (int k = 0; k < 4; ++k) { xr[c * 8 + 2 * k] = __uint_as_float(ww[k] << 16); xr[c * 8 + 2 * k + 1] = __uint_as_float(ww[k] & 0xffff0000u); }
    }
    float sm = 0.f;
#pragma unroll
    for (int jj = 0; jj < 64; ++jj) sm += xr[jj];
    float mu = sm * (1.f / 64.f), q2 = 0.f;
#pragma unroll
    for (int jj = 0; jj < 64; ++jj) { float d = xr[jj] - mu; q2 += d * d; }
    float rstd = rsqrtf(q2 * (1.f / 64.f) + LN_EPS);
#pragma unroll
    for (int c = 0; c < 8; ++c) {
      float o[8];
#pragma unroll
      for (int k = 0; k < 8; ++k) o[k] = (xr[c * 8 + k] - mu) * rstd * p.fn_g[gq * 64 + c * 8 + k] + p.fn_b[gq * 64 + c * 8 + k];
      *(U4*)(xp + c * 8) = mk4(pack2(o[0], o[1]), pack2(o[2], o[3]), pack2(o[4], o[5]), pack2(o[6], o[7]));
    }
  }
  __syncthreads();
  bf16x8 af[4][2];
#pragma unroll
  for (int mt = 0; mt < 4; ++mt)
#pragma unroll
    for (int ks = 0; ks < 2; ++ks) af[mt][ks] = *(const bf16x8*)(xb + (16 * mt + r16) * XROW + w * 64 + 32 * ks + 8 * g4);
  const int b = m0 >> 13, t0 = (m0 & 8191);
#pragma unroll 2
  for (int nt = 0; nt < 8; ++nt) {
    bf16x8 b0 = *(const bf16x8*)(tt + (16 * nt + r16) * TROW + 8 * g4);
    bf16x8 b1 = *(const bf16x8*)(tt + (16 * nt + r16) * TROW + 32 + 8 * g4);
    int n = 16 * nt + r16;
    size_t row = (size_t)(b * 256 + w * 64 + (n & 63)) * 16384 + (n >= 64 ? 8192 : 0) + t0;
#pragma unroll
    for (int mt = 0; mt < 4; ++mt) {
      f32x4 acc = f32x4{0.f, 0.f, 0.f, 0.f};
      acc = mfma16(af[mt][0], b0, acc);
      acc = mfma16(af[mt][1], b1, acc);
      *(U2*)(XT + row + 16 * mt + 4 * g4) = mk2(pack2g(acc[0], acc[1]), pack2g(acc[2], acc[3]));
    }
  }
}

DI void gbar(unsigned* ctr, unsigned& target, unsigned nblk) {
  asm volatile("s_waitcnt vmcnt(0)" ::: "memory");
  __syncthreads();
  target += nblk;
  if (__builtin_amdgcn_workitem_id_x() == 0) {
    __builtin_amdgcn_s_waitcnt(0);
    __builtin_amdgcn_fence(__ATOMIC_RELEASE, "agent");
    asm volatile("s_waitcnt vmcnt(0)" ::: "memory");
    __hip_atomic_fetch_add(ctr, 1u, __ATOMIC_RELAXED, __HIP_MEMORY_SCOPE_AGENT);
    while (__hip_atomic_load(ctr, __ATOMIC_RELAXED, __HIP_MEMORY_SCOPE_AGENT) < target) __builtin_amdgcn_s_sleep(1);
    __builtin_amdgcn_fence(__ATOMIC_ACQUIRE, "agent");
    asm volatile("s_waitcnt vmcnt(0)" ::: "memory");
  }
  __syncthreads();
}

#define USE_PG8_WIN 0
#define USE_PG8_L1IN 1
#define USE_PG8_L1OUT 1
#define USE_PG8_MLP1 1
#define USE_PG8_MLP2 1
#ifndef REP_MLA
#define REP_MLA 1
#endif
#ifndef REP_TOEP
#define REP_TOEP 1
#endif
#ifndef REP_MLP1
#define REP_MLP1 1
#endif
#ifndef REP_NAT
#define REP_NAT 1
#endif
#ifndef REP_FNG
#define REP_FNG 1
#endif
#ifndef REP_WIN
#define REP_WIN 1
#endif

__global__ void __launch_bounds__(512, 2) mega(Params p) {
  cg::grid_group grid = cg::this_grid();
  __shared__ __attribute__((aligned(16))) char smem_all[2 * SMEM_BYTES];
  char* smem = smem_all + halfx() * SMEM_BYTES;
  char* ws = wsp(p);
  const int nblk = NVB, bid = bidx();
  const int rnblk = gridDim.x, rbid = rbidx();
  float* S = (float*)(ws + O_S);
  u16* hbuf = (u16*)(ws + O_HBUF);
  unsigned* barp = (unsigned*)(ws + O_BAR);
  unsigned bar_target = 0;
#define SYNC() gbar(barp, bar_target, (unsigned)rnblk)

  phase_prep(p, smem);
  grid.sync();
  phase_ln<true, false, true>(p, R, nullptr, nullptr, nullptr, false, 0, 0, 1024);
  SYNC();

#pragma unroll
  for (int l = 0; l < 2; ++l) {
    const int rows = (l == 0) ? R : NLAT;
    const float* mod = modp(p, l, 0);
    if (l == 0) {
      {
        EpWin0 ep; ep.uhyT = (u16*)(ws + O_UHYT); ep.uqk = (u16*)(ws + O_UQK); ep.vT = (u16*)(ws + O_VT0);
        const u16* W = (const u16*)(ws + O_WT_ABIN);
#if USE_PG8_WIN
        run_phase<EpWin0, true>(smem_all, W, hbuf, 1536, NLAT, 1024, ep, 0, 0);
        run_phase<EpWin0, false>(smem_all, hbuf, W + (size_t)1536 * 1024, NLAT, 1024, 1024, ep, 0, 1536);
        run_phase<EpWin0, true>(smem_all, W + (size_t)2560 * 1024, hbuf, 512, NLAT, 1024, ep, 2560, 0);
#else
        {
          LoadRowB al; al.A = hbuf; al.lda = 1024;
          for (int t = rbid; t < 128 * 12; t += rnblk) {
            int nt = t % 12;
            if (nt >= 6 && nt < 10) gemm_big<true>(al, W, 1024, 1024, (t / 12) * 256, nt * 256, ep, smem_all);
            else gemm_big<false>(al, W, 1024, 1024, (t / 12) * 256, nt * 256, ep, smem_all);
          }
        }
#endif
        {
          ALoadRow al; al.A = hbuf; al.lda = 1024;
          for (int t = bid; t < 8 * 24; t += nblk) {
            int nt = t % 24;
            if (nt >= 12 && nt < 20) gemm_tile<true>(al, W, 1024, 1024, NLAT + (t / 24) * 128, nt * 128, ep, smem);
            else gemm_tile<false>(al, W, 1024, 1024, NLAT + (t / 24) * 128, nt * 128, ep, smem);
          }
        }
      }
      SYNC();
      {
        const int n_toep = 1024, n_na = 4096, n_nac = 128, n_tc = 512;
        for (int it = bid; it < n_toep + n_na + n_nac + n_tc; it += nblk) {
          __syncthreads();
          int t = it;
          if (t < n_toep) { toep_item(p, smem, 0, t >> 1, t & 1); continue; }
          t -= n_toep;
          u16* Pw = (u16*)smem + (tidx() >> 6) * (16 * 520);
          if (t < n_na) { int b = t >> 10, r = (t >> 3) & 127, h = t & 7; natten_wave(p, Pw, b, h, true, r, tidx() >> 6, 0); continue; }
          t -= n_na;
          if (t < n_nac) { int b = t >> 5, h = (t >> 2) & 7, q4 = t & 3; natten_wave(p, Pw, b, h, false, 0, 0, q4 * 4 + (tidx() >> 6)); continue; }
          t -= n_nac;
          toep_ctx_item(p, smem, 0, t);
        }
      }
      SYNC();
      {
        for (int it = bid; it < 1024 + 512; it += nblk) {
          __syncthreads();
          if (it < 1024) toep_item(p, smem, 1, it >> 1, it & 1);
          else toep_ctx_item(p, smem, 1, it - 1024);
        }
      }
      SYNC();
      {
        EpResid ep; ep.xlat = p.x; ep.xctx = p.ctx; ep.S = S; ep.mod = mod; ep.goff = 2048;
        const u16* W = (const u16*)(ws + O_WT_ABOUT);
        {
          ALoadMixB al; al.YT = (const u16*)(ws + O_YHYT); al.YN = (const u16*)(ws + O_YNA);
          for (int t = rbid; t < 128 * 4; t += rnblk) gemm_big<true>(al, W, 1024, 1024, (t / 4) * 256, (t % 4) * 256, ep, smem_all);
        }
        {
          ALoadMix al; al.YT = (const u16*)(ws + O_YHYT); al.YN = (const u16*)(ws + O_YNA);
          for (int t = bid; t < 8 * 8; t += nblk) gemm_tile<true>(al, W, 1024, 1024, NLAT + (t / 8) * 128, (t % 8) * 128, ep, smem);
        }
      }
      SYNC();
    } else {
      {
        EpPlain ep; ep.dst = (u16*)(ws + O_U1); ep.ld = 1024;
        const u16* W = (const u16*)(ws + O_WT_CDIN);
#if USE_PG8_L1IN
        run_phase_p<EpPlain>(smem_all, hbuf, W, NLAT, 1024, 1024, ep);
#else
        {
          LoadRowB al; al.A = hbuf; al.lda = 1024;
          for (int t = rbid; t < 128 * 4; t += rnblk) gemm_big<true>(al, W, 1024, 1024, (t / 4) * 256, (t % 4) * 256, ep, smem_all);
        }
#endif
        {
          ALoadRow al; al.A = hbuf; al.lda = 1024;
          for (int t = bid; t < 8 * 8; t += nblk) gemm_tile<true>(al, W, 1024, 1024, NLAT + (t / 8) * 128, (t % 8) * 128, ep, smem);
        }
      }
      SYNC();
      {
        const int n_q = (NLAT / 128) * 6, n_kv = (R / 128) * 10, n_kpe = R / 64, n_f1 = NLAT / 64;
        float* srow = (float*)(smem + 73728);
        const u16* u1 = (const u16*)(ws + O_U1);
        for (int it = bid; it < n_q + n_kv + n_kpe + n_f1; it += nblk) {
          __syncthreads();
          int t = it;
          if (t < n_q) {
            int m0 = (t / 6) * 128, n0 = (t % 6) * 128;
            rms_rows(u1, 1024, 384, m0, srow);
            ALoadRow al; al.A = u1; al.lda = 1024;
            EpQ ep; ep.q = (u16*)(ws + O_Q); ep.srow = srow; ep.m0 = m0;
            gemm_tile<true>(al, (const u16*)(ws + O_WT_UQ), 384, 384, m0, n0, ep, smem);
            continue;
          }
          t -= n_q;
          if (t < n_kv) {
            int m0 = (t / 10) * 128, n0 = (t % 10) * 128;
            rms_rows(u1 + 384, 1024, 256, m0, srow);
            ALoadRow al; al.A = u1 + 384; al.lda = 1024;
            EpKV ep; ep.kn = (u16*)(ws + O_KB); ep.vT = (u16*)(ws + O_VT1); ep.srow = srow; ep.m0 = m0;
            gemm_tile<false>(al, (const u16*)(ws + O_WT_UKV), 256, 256, m0, n0, ep, smem);
            continue;
          }
          t -= n_kv;
          if (t < n_kpe) { kpe_item(p, t); continue; }
          t -= n_kpe;
          fnet1_item(p, smem, t);
        }
      }
      SYNC();
      {
        for (int it = rbid; it < 512; it += rnblk) {
          int b = it >> 7, hp = (it >> 5) & 3, qb = it & 31;
          __syncthreads();
          mla_item512(p, smem_all, b, 2 * hp, qb);
          __syncthreads();
          mla_item512(p, smem_all, b, 2 * hp + 1, qb);
        }
        for (int t = rbid; t < 256; t += rnblk) {
          __syncthreads();
          const int hf = halfx();
          const int m0 = (t >> 3) * 128, n0 = (t & 7) * 128;
          ALoadDFT al; al.kofs = hf * 8192;
          EpLds ep; ep.buf = (float*)smem; ep.m0 = m0; ep.n0 = n0;
          gemm_tile<true>(al, (const u16*)(ws + O_XT) + hf * 8192, 16384, 8192, m0, n0, ep, smem);
          __syncthreads();
          const float* Pb = (const float*)smem_all;
          const float* Qb = (const float*)(smem_all + SMEM_BYTES);
          u16* y1 = (u16*)(ws + O_Y1);
          const float sc = 0.0013810679320049757f;
          const int tid = tidx(), bb = n0 >> 8, ch0 = n0 & 255;
#pragma unroll 4
          for (int i = 0; i < 16; ++i) {
            int e = tid + 256 * i, row = e >> 5, c4 = (e & 31) * 4;
            F4 pv = *(const F4*)(Pb + row * 132 + c4), qv = *(const F4*)(Qb + row * 132 + c4);
            int k = m0 + row;
            if (hf == 0) {
              *(U2*)(y1 + ((size_t)(bb * 8192 + k)) * 1024 + 768 + ch0 + c4) = mk2(pack2((pv.x + qv.x) * sc, (pv.y + qv.y) * sc), pack2((pv.z + qv.z) * sc, (pv.w + qv.w) * sc));
            } else if (k > 0) {
              *(U2*)(y1 + ((size_t)(bb * 8192 + 8192 - k)) * 1024 + 768 + ch0 + c4) = mk2(pack2((pv.x - qv.x) * sc, (pv.y - qv.y) * sc), pack2((pv.z - qv.z) * sc, (pv.w - qv.w) * sc));
            }
          }
        }
        for (int i = bid; i < 16; i += nblk) {
          const int tid = tidx(), lane = tid & 63, w = tid >> 6;
          const u16* XT = (const u16*)(ws + O_XT);
          u16* y1 = (u16*)(ws + O_Y1);
          float res = 0.f;
          for (int c = 0; c < 16; ++c) {
            int n = i * 64 + w * 16 + c;
            const U4* row = (const U4*)(XT + (size_t)n * 16384);
            float sacc = 0.f;
#pragma unroll 4
            for (int j = 0; j < 16; ++j) {
              U4 q = row[lane + 64 * j];
              u32 ww[4] = {q.x, q.y, q.z, q.w};
#pragma unroll
              for (int k2 = 0; k2 < 4; ++k2) sacc += __uint_as_float(ww[k2] << 16) - __uint_as_float(ww[k2] & 0xffff0000u);
            }
            sacc = wave_sum(sacc);
            if (lane == c) res = sacc;
          }
          if (lane < 16) {
            int n = i * 64 + w * 16 + lane;
            y1[((size_t)((n >> 8) * 8192 + 4096)) * 1024 + 768 + (n & 255)] = f2bf(res * 0.0013810679320049757f);
          }
        }
      }
      SYNC();
      {
        EpResid ep; ep.xlat = S; ep.xctx = S + (size_t)NLAT * 1024; ep.S = S; ep.mod = mod; ep.goff = 2048;
#if USE_PG8_L1OUT
        run_phase<EpResid, false>(smem_all, (const u16*)(ws + O_Y1), (const u16*)(ws + O_WT_CDOUT), NLAT, 1024, 1024, ep, 0, 0);
#else
        {
          LoadRowB al; al.A = (const u16*)(ws + O_Y1); al.lda = 1024;
          for (int t = rbid; t < 128 * 4; t += rnblk) gemm_big<true>(al, (const u16*)(ws + O_WT_CDOUT), 1024, 1024, (t / 4) * 256, (t % 4) * 256, ep, smem_all);
        }
#endif
      }
      SYNC();
    }
    phase_ln<false, true, true>(p, rows, p.ln_g + (size_t)(l * 2 + 0) * 1024, p.ln_b + (size_t)(l * 2 + 0) * 1024, nullptr, true, l, 3072, 4096);
    SYNC();
    {
      EpRelu2 ep; ep.a1 = (u16*)(ws + O_A1);
      const u16* W = (const u16*)(ws + O_WT_W1) + (size_t)l * 4096 * 1024;
#if USE_PG8_MLP1
      run_phase_p<EpRelu2>(smem_all, hbuf, W, NLAT, 4096, 1024, ep);
#else
      {
        LoadRowB al; al.A = hbuf; al.lda = 1024;
        for (int t = rbid; t < 128 * 16; t += rnblk) gemm_big<true>(al, W, 1024, 1024, (t / 16) * 256, (t % 16) * 256, ep, smem_all);
      }
#endif
      if (l == 0) {
        ALoadRow al; al.A = hbuf; al.lda = 1024;
        for (int t = bid; t < 8 * 32; t += nblk) gemm_tile<true>(al, W, 1024, 1024, NLAT + (t / 32) * 128, (t % 32) * 128, ep, smem);
      }
    }
    SYNC();
    {
      EpResid ep; ep.xlat = S; ep.xctx = S + (size_t)NLAT * 1024; ep.S = S; ep.mod = mod; ep.goff = 5120;
      const u16* W = (const u16*)(ws + O_WT_W2) + (size_t)l * 4096 * 1024;
#if USE_PG8_MLP2
      run_phase<EpResid, false>(smem_all, (const u16*)(ws + O_A1), W, NLAT, 1024, 4096, ep, 0, 0);
#else
      {
        LoadRowB al; al.A = (const u16*)(ws + O_A1); al.lda = 4096;
        for (int t = rbid; t < 128 * 4; t += rnblk) gemm_big<true>(al, W, 4096, 4096, (t / 4) * 256, (t % 4) * 256, ep, smem_all);
      }
#endif
      if (l == 0) {
        ALoadRow al; al.A = (const u16*)(ws + O_A1); al.lda = 4096;
        for (int t = bid; t < 8 * 8; t += nblk) gemm_tile<true>(al, W, 4096, 4096, NLAT + (t / 8) * 128, (t % 8) * 128, ep, smem);
      }
    }
    SYNC();
    if (l == 0) phase_ln<false, true, true>(p, R, p.ln_g + 1024, p.ln_b + 1024, nullptr, true, 1, 0, 1024);
    else phase_ln<false, true, false>(p, NLAT, p.ln_g + 3 * 1024, p.ln_b + 3 * 1024, p.out, false, 0, 0, 0);
    if (l == 0) SYNC();
  }
}

extern "C" void kernel_launch(void* const* d_in, const int* in_sizes, int n_in, void* d_out, int out_size, void* d_ws,
                              size_t ws_size, hipStream_t stream) {
  static int grid_blocks = 0;
  if (!grid_blocks) {
    int dev = 0, cus = 0, per_cu = 0;
    hipGetDevice(&dev);
    hipDeviceGetAttribute(&cus, hipDeviceAttributeMultiprocessorCount, dev);
    hipOccupancyMaxActiveBlocksPerMultiprocessor(&per_cu, mega, 512, 0);
    if (per_cu > 1) per_cu = 1;
    if (per_cu < 1) per_cu = 1;
    grid_blocks = cus * per_cu;
  }
  Params p{};
  const float** f = (const float**)&p;
  for (int i = 0; i < 30; ++i) f[i] = (const float*)d_in[i];
  p.out = (float*)d_out;
  p.ws = (char*)d_ws;
  hipMemsetAsync((char*)d_ws + O_BAR, 0, 256, stream);
  void* args[] = {&p};
  hipError_t e = hipLaunchCooperativeKernel((void*)mega, dim3(grid_blocks), dim3(512), args, 0, stream);
  if (e != hipSuccess) fprintf(stderr, "cooperative launch failed: %s (grid %d)\n", hipGetErrorString(e), grid_blocks);
}
```

```cpp
#include <hip/hip_runtime.h>
#include <hip/hip_cooperative_groups.h>
#include <cstdio>
namespace cg = cooperative_groups;

#define DI __device__ __forceinline__
typedef unsigned short u16;
typedef unsigned int u32;
using bf16x8 = __attribute__((ext_vector_type(8))) short;
using f32x4 = __attribute__((ext_vector_type(4))) float;
using f32x16 = __attribute__((ext_vector_type(16))) float;
using U4 = __attribute__((ext_vector_type(4))) unsigned int;
using U2 = __attribute__((ext_vector_type(2))) unsigned int;
using F4 = __attribute__((ext_vector_type(4))) float;
using f32x2 = __attribute__((ext_vector_type(2))) float;
#define mk4(a, b, c, d) (U4{(u32)(a), (u32)(b), (u32)(c), (u32)(d)})
#define mk2(a, b) (U2{(u32)(a), (u32)(b)})
#define mkf4(a, b, c, d) (F4{(a), (b), (c), (d)})

constexpr int NB = 4, SEQL = 8192, LC = 256;
constexpr int NLAT = NB * SEQL;
constexpr int NCTX = NB * LC;
constexpr int R = NLAT + NCTX;
constexpr int LT = SEQL + LC;
constexpr float ALPHA = 1.4142135623730951f;
constexpr float LN_EPS = 1e-5f;
constexpr float LOG2E = 1.4426950408889634f;

constexpr size_t O_WT_ABIN = 0;
constexpr size_t O_WT_ABOUT = O_WT_ABIN + 3072ull * 1024 * 2;
constexpr size_t O_WT_W1 = O_WT_ABOUT + 1024ull * 1024 * 2;
constexpr size_t O_WT_W2 = O_WT_W1 + 2ull * 4096 * 1024 * 2;
constexpr size_t O_WT_CDIN = O_WT_W2 + 2ull * 4096 * 1024 * 2;
constexpr size_t O_WT_CDOUT = O_WT_CDIN + 1024ull * 1024 * 2;
constexpr size_t O_WT_UQ = O_WT_CDOUT + 1024ull * 1024 * 2;
constexpr size_t O_WT_UKV = O_WT_UQ + 768ull * 384 * 2;
constexpr size_t O_MOD = O_WT_UKV + 1280ull * 256 * 2;
constexpr size_t O_TCTX = O_MOD + 2ull * 5 * 6144 * 4;
constexpr size_t O_S = (O_TCTX + 2ull * 512 * 512 * 2 + 255) & ~(size_t)255;
constexpr size_t O_D = O_S + (size_t)R * 1024 * 4;
constexpr size_t O_HBUF = O_D;
constexpr size_t O_UQK = O_D + (size_t)R * 1024 * 2;
constexpr size_t O_VT0 = O_UQK + (size_t)R * 1024 * 2;
constexpr size_t O_UHYT = O_VT0 + 4ull * 512 * LT * 2;
constexpr size_t O_TLAT = O_UHYT + 4ull * 1536 * LT * 2;
constexpr size_t O_ZT = O_D;
constexpr size_t O_YNA = O_D + 4ull * 512 * LT * 2;
constexpr size_t O_YHYT = O_UQK;
constexpr size_t O_A1 = O_UQK;
constexpr size_t O_U1 = O_UQK;
constexpr size_t O_Q = O_U1 + (size_t)R * 1024 * 2;
constexpr size_t O_KB = O_Q + (size_t)NLAT * 768 * 2;
constexpr size_t O_KP = O_KB + 32ull * LT * 64 * 2;
constexpr size_t O_VT1 = O_KB + 32ull * LT * 96 * 2;
constexpr size_t O_XT = O_VT1 + 32ull * LT * 96 * 2;
constexpr size_t O_Y1 = O_D;
constexpr size_t WS_NEED = O_A1 + (size_t)R * 4096 * 2;
constexpr size_t O_BAR = (WS_NEED + 255) & ~(size_t)255;
static_assert(O_BAR + 256 <= 536870912ull, "ws too large");
static_assert(O_TLAT + 2ull * 512 * 16384 * 2 <= WS_NEED, "l0 region");
static_assert(O_XT + 1024ull * 16384 * 2 <= WS_NEED, "l1 region");

constexpr int SMEM_BYTES = 73728 + 1024;

struct Params {
  const float *x, *c, *ctx, *c_ctx, *mod_w, *mod_b, *ln_g, *ln_b, *mlp_w1, *mlp_w2, *ab_w_in, *ab_w_out, *hy_conv_w,
      *hy_w1, *hy_b1, *hy_freq, *hy_w2, *hy_b2, *hy_w3, *hy_log_decay, *hy_skip, *na_rpb, *cd_w_in, *cd_w_out,
      *mla_q_norm, *mla_w_uq, *mla_kv_norm, *mla_w_ukv, *fn_g, *fn_b;
  float* out;
  char* ws;
};

DI int tidx() { int t = __builtin_amdgcn_workitem_id_x() & 255; asm volatile("" : "+v"(t)); return t; }
DI int tid512() { int t = __builtin_amdgcn_workitem_id_x(); asm volatile("" : "+v"(t)); return t; }
DI int halfx() { return __builtin_amdgcn_readfirstlane(__builtin_amdgcn_workitem_id_x() >> 8); }
DI int bidx() { int b = __builtin_amdgcn_workgroup_id_x() * 2 + halfx(); asm volatile("" : "+s"(b)); return b; }
DI int rbidx() { int b = __builtin_amdgcn_workgroup_id_x(); asm volatile("" : "+s"(b)); return b; }
#define NVB ((int)gridDim.x * 2)
DI char* wsp(const Params& p) { char* w = p.ws; asm volatile("" : "+s"(w)); return w; }

DI u32 pack2(float a, float b) { u32 r; asm("v_cvt_pk_bf16_f32 %0, %1, %2" : "=v"(r) : "v"(a), "v"(b)); return r; }
DI u32 pack2g(float a, float b) { return pack2(a + 0.0f, b + 0.0f); }
DI u16 f2bf(float x) { return (u16)pack2(x, 0.f); }
DI float bf2f(u16 h) { return __uint_as_float(((u32)h) << 16); }
DI float wave_sum(float v) {
#pragma unroll
  for (int o = 32; o >= 1; o >>= 1) v += __shfl_xor(v, o);
  return v;
}
DI f32x4 mfma16(bf16x8 a, bf16x8 b, f32x4 c) { return __builtin_amdgcn_mfma_f32_16x16x32_bf16(a, b, c, 0, 0, 0); }
DI f32x16 mfma32(bf16x8 a, bf16x8 b, f32x16 c) { return __builtin_amdgcn_mfma_f32_32x32x16_bf16(a, b, c, 0, 0, 0); }

DI const float* modp(const Params& p, int l, int bidx) { return (const float*)(wsp(p) + O_MOD) + ((size_t)l * 5 + bidx) * 6144; }
DI int bidx_of(int m) { return m < NLAT ? (m >> 13) : 4; }
DI void bs_of(int m, int& b, int& s) {
  if (m < NLAT) { b = m >> 13; s = m & 8191; }
  else { int t = m - NLAT; b = t >> 8; s = SEQL + (t & 255); }
}

constexpr int BK = 64, LROW = BK + 8;
constexpr int STAGE_U16 = 2 * 128 * LROW;

struct ALoadRow {
  const u16* A; int lda; U4 r0, r1, r2, r3;
  DI void fetch(int m0, int k0, int tid) {
    const u16* base = A + (size_t)(m0 + (tid >> 3)) * lda + k0 + (tid & 7) * 8;
    r0 = *(const U4*)(base);
    r1 = *(const U4*)(base + (size_t)32 * lda);
    r2 = *(const U4*)(base + (size_t)64 * lda);
    r3 = *(const U4*)(base + (size_t)96 * lda);
  }
  DI void commit(u16* sA, int tid) {
    u16* d = sA + (tid >> 3) * LROW + (tid & 7) * 8;
    *(U4*)(d) = r0; *(U4*)(d + 32 * LROW) = r1; *(U4*)(d + 64 * LROW) = r2; *(U4*)(d + 96 * LROW) = r3;
  }
};

struct ALoadMix {
  const u16* YT; const u16* YN; U4 r0, r1, r2, r3; bool tr;
  DI void fetch(int m0, int k0, int tid) {
    tr = (k0 < 512);
    if (tr) {
      int b, s; bs_of(m0, b, s);
      const u16* base = YT + ((size_t)(b * 512 + k0 + (tid >> 4))) * LT + s + (tid & 15) * 8;
      r0 = *(const U4*)(base);
      r1 = *(const U4*)(base + (size_t)16 * LT);
      r2 = *(const U4*)(base + (size_t)32 * LT);
      r3 = *(const U4*)(base + (size_t)48 * LT);
    } else {
      const u16* base = YN + (size_t)(m0 + (tid >> 3)) * 512 + (k0 - 512) + (tid & 7) * 8;
      r0 = *(const U4*)(base);
      r1 = *(const U4*)(base + (size_t)32 * 512);
      r2 = *(const U4*)(base + (size_t)64 * 512);
      r3 = *(const U4*)(base + (size_t)96 * 512);
    }
  }
  static DI void scat(u16* d, U4 q) {
    d[0 * LROW] = (u16)(q.x); d[1 * LROW] = (u16)(q.x >> 16);
    d[2 * LROW] = (u16)(q.y); d[3 * LROW] = (u16)(q.y >> 16);
    d[4 * LROW] = (u16)(q.z); d[5 * LROW] = (u16)(q.z >> 16);
    d[6 * LROW] = (u16)(q.w); d[7 * LROW] = (u16)(q.w >> 16);
  }
  DI void commit(u16* sA, int tid) {
    if (tr) {
      u16* d = sA + ((tid & 15) * 8) * LROW + (tid >> 4);
      scat(d, r0); scat(d + 16, r1); scat(d + 32, r2); scat(d + 48, r3);
    } else {
      u16* d = sA + (tid >> 3) * LROW + (tid & 7) * 8;
      *(U4*)(d) = r0; *(U4*)(d + 32 * LROW) = r1; *(U4*)(d + 64 * LROW) = r2; *(U4*)(d + 96 * LROW) = r3;
    }
  }
};

struct ALoadDFT {
  static DI U4 gen(int k, int kk) {
    int t0 = kk & 8191;
    int idx = k * t0 + (kk >= 8192 ? 2048 : 0);
    float v0 = __builtin_amdgcn_cosf((float)((idx) & 8191) * (1.f / 8192.f));
    float v1 = __builtin_amdgcn_cosf((float)((idx + k) & 8191) * (1.f / 8192.f));
    float v2 = __builtin_amdgcn_cosf((float)((idx + 2 * k) & 8191) * (1.f / 8192.f));
    float v3 = __builtin_amdgcn_cosf((float)((idx + 3 * k) & 8191) * (1.f / 8192.f));
    float v4 = __builtin_amdgcn_cosf((float)((idx + 4 * k) & 8191) * (1.f / 8192.f));
    float v5 = __builtin_amdgcn_cosf((float)((idx + 5 * k) & 8191) * (1.f / 8192.f));
    float v6 = __builtin_amdgcn_cosf((float)((idx + 6 * k) & 8191) * (1.f / 8192.f));
    float v7 = __builtin_amdgcn_cosf((float)((idx + 7 * k) & 8191) * (1.f / 8192.f));
    return mk4(pack2(v0, v1), pack2(v2, v3), pack2(v4, v5), pack2(v6, v7));
  }
  int kofs; int k_, kk_;
  DI void fetch(int m0, int k0, int tid) { k_ = m0 + (tid >> 3); kk_ = kofs + k0 + (tid & 7) * 8; }
  DI void commit(u16* sA, int tid) {
    u16* d = sA + (tid >> 3) * LROW + (tid & 7) * 8;
    __builtin_amdgcn_sched_barrier(0);
    *(U4*)(d) = gen(k_, kk_);
    __builtin_amdgcn_sched_barrier(0);
    *(U4*)(d + 32 * LROW) = gen(k_ + 32, kk_);
    __builtin_amdgcn_sched_barrier(0);
    *(U4*)(d + 64 * LROW) = gen(k_ + 64, kk_);
    __builtin_amdgcn_sched_barrier(0);
    *(U4*)(d + 96 * LROW) = gen(k_ + 96, kk_);
    __builtin_amdgcn_sched_barrier(0);
  }
};

struct BLoadRow {
  const u16* B; int ldb; U4 r0, r1, r2, r3;
  DI void fetch(int n0, int k0, int tid) {
    const u16* base = B + (size_t)(n0 + (tid >> 3)) * ldb + k0 + (tid & 7) * 8;
    r0 = *(const U4*)(base);
    r1 = *(const U4*)(base + (size_t)32 * ldb);
    r2 = *(const U4*)(base + (size_t)64 * ldb);
    r3 = *(const U4*)(base + (size_t)96 * ldb);
  }
  DI void commit(u16* sB, int tid) {
    u16* d = sB + (tid >> 3) * LROW + (tid & 7) * 8;
    *(U4*)(d) = r0; *(U4*)(d + 32 * LROW) = r1; *(U4*)(d + 64 * LROW) = r2; *(U4*)(d + 96 * LROW) = r3;
  }
};

template <bool SWAP>
DI void gemm_compute(f32x4 (&acc)[4][4], const u16* sA, const u16* sB, int wm, int wn, int r16, int g) {
#pragma unroll
  for (int ks = 0; ks < 2; ++ks) {
    bf16x8 a[4], b[4];
#pragma unroll
    for (int i = 0; i < 4; ++i) a[i] = *(const bf16x8*)(sA + (wm * 64 + i * 16 + r16) * LROW + ks * 32 + g * 8);
#pragma unroll
    for (int j = 0; j < 4; ++j) b[j] = *(const bf16x8*)(sB + (wn * 64 + j * 16 + r16) * LROW + ks * 32 + g * 8);
#pragma unroll
    for (int i = 0; i < 4; ++i)
#pragma unroll
      for (int j = 0; j < 4; ++j) {
        if (SWAP) acc[i][j] = mfma16(b[j], a[i], acc[i][j]);
        else acc[i][j] = mfma16(a[i], b[j], acc[i][j]);
      }
  }
}

template <bool SWAP, class AL, class EP, int VAR = 0>
DI void gemm_tile(AL& al0, const u16* __restrict__ Bt, int ldb, int K, int m0, int n0, EP& ep, char* smem) {
  const int tid = tidx(), lane = tid & 63, w = tid >> 6, wm = w >> 1, wn = w & 1, r16 = lane & 15, g = lane >> 4;
  u16* sbase = (u16*)smem;
  f32x4 acc[4][4];
#pragma unroll
  for (int i = 0; i < 4; ++i)
#pragma unroll
    for (int j = 0; j < 4; ++j) acc[i][j] = f32x4{0.f, 0.f, 0.f, 0.f};
  AL al1 = al0;
  BLoadRow bl0, bl1; bl0.B = Bt; bl0.ldb = ldb; bl1.B = Bt; bl1.ldb = ldb;
  const int nk = K / BK;
  al0.fetch(m0, 0, tid); bl0.fetch(n0, 0, tid);
  al1.fetch(m0, BK, tid); bl1.fetch(n0, BK, tid);
  __syncthreads();
  al0.commit(sbase, tid); bl0.commit(sbase + 128 * LROW, tid);
  __syncthreads();
  u16* const sA0 = sbase; u16* const sB0 = sbase + 128 * LROW;
  u16* const sA1 = sbase + STAGE_U16; u16* const sB1 = sA1 + 128 * LROW;
  for (int kt = 0; kt < nk; kt += 2) {
    if (VAR != 1) { int k2 = (kt + 2 < nk ? kt + 2 : nk - 2) * BK; al0.fetch(m0, k2, tid); bl0.fetch(n0, k2, tid); }
    __builtin_amdgcn_sched_barrier(0);
    if (VAR != 2) gemm_compute<SWAP>(acc, sA0, sB0, wm, wn, r16, g);
    al1.commit(sA1, tid); bl1.commit(sB1, tid);
    __syncthreads();
    if (VAR != 1) { int k3 = (kt + 3 < nk ? kt + 3 : nk - 1) * BK; al1.fetch(m0, k3, tid); bl1.fetch(n0, k3, tid); }
    __builtin_amdgcn_sched_barrier(0);
    if (VAR != 2) gemm_compute<SWAP>(acc, sA1, sB1, wm, wn, r16, g);
    al0.commit(sA0, tid); bl0.commit(sB0, tid);
    __syncthreads();
  }
#pragma unroll
  for (int i = 0; i < 4; ++i)
#pragma unroll
    for (int j = 0; j < 4; ++j) {
      if (VAR == 3) { if (acc[i][j][0] == 1.2345f) ep.apply_t(m0, n0, acc[i][j]); }
      else if (SWAP) ep.apply_t(m0 + wm * 64 + i * 16 + r16, n0 + wn * 64 + j * 16 + g * 4, acc[i][j]);
      else ep.apply(m0 + wm * 64 + i * 16 + g * 4, n0 + wn * 64 + j * 16 + r16, acc[i][j]);
    }
}

struct LoadRowB {
  const u16* A; int lda; U4 r0, r1, r2, r3;
  DI void fetch(int m0, int k0, int tid) {
    const u16* base = A + (size_t)(m0 + (tid >> 3)) * lda + k0 + (tid & 7) * 8;
    r0 = *(const U4*)(base);
    r1 = *(const U4*)(base + (size_t)64 * lda);
    r2 = *(const U4*)(base + (size_t)128 * lda);
    r3 = *(const U4*)(base + (size_t)192 * lda);
  }
  DI void commit(u16* sA, int tid) {
    u16* d = sA + (tid >> 3) * LROW + (tid & 7) * 8;
    *(U4*)(d) = r0; *(U4*)(d + 64 * LROW) = r1; *(U4*)(d + 128 * LROW) = r2; *(U4*)(d + 192 * LROW) = r3;
  }
};
struct ALoadMixB {
  const u16* YT; const u16* YN; U4 r0, r1, r2, r3; bool tr;
  DI void fetch(int m0, int k0, int tid) {
    tr = (k0 < 512);
    if (tr) {
      int b, s; bs_of(m0, b, s);
      const u16* base = YT + ((size_t)(b * 512 + k0 + (tid >> 5))) * LT + s + (tid & 31) * 8;
      r0 = *(const U4*)(base);
      r1 = *(const U4*)(base + (size_t)16 * LT);
      r2 = *(const U4*)(base + (size_t)32 * LT);
      r3 = *(const U4*)(base + (size_t)48 * LT);
    } else {
      const u16* base = YN + (size_t)(m0 + (tid >> 3)) * 512 + (k0 - 512) + (tid & 7) * 8;
      r0 = *(const U4*)(base);
      r1 = *(const U4*)(base + (size_t)64 * 512);
      r2 = *(const U4*)(base + (size_t)128 * 512);
      r3 = *(const U4*)(base + (size_t)192 * 512);
    }
  }
  DI void commit(u16* sA, int tid) {
    if (tr) {
      u16* d = sA + ((tid & 31) * 8) * LROW + (tid >> 5);
      ALoadMix::scat(d, r0); ALoadMix::scat(d + 16, r1); ALoadMix::scat(d + 32, r2); ALoadMix::scat(d + 48, r3);
    } else {
      u16* d = sA + (tid >> 3) * LROW + (tid & 7) * 8;
      *(U4*)(d) = r0; *(U4*)(d + 64 * LROW) = r1; *(U4*)(d + 128 * LROW) = r2; *(U4*)(d + 192 * LROW) = r3;
    }
  }
};

template <bool SWAP, class AL, class EP>
DI void gemm_big(AL& al, const u16* __restrict__ Bt, int ldb, int K, int m0, int n0, EP& ep, char* smem_all) {
  const int tid = tid512(), lane = tid & 63, w = tid >> 6, wm = w >> 2, wn = w & 3, r16 = lane & 15, g = lane >> 4;
  u16* sbase = (u16*)smem_all;
  constexpr int STG = 2 * 256 * LROW;
  f32x4 acc[8][4];
#pragma unroll
  for (int i = 0; i < 8; ++i)
#pragma unroll
    for (int j = 0; j < 4; ++j) acc[i][j] = f32x4{0.f, 0.f, 0.f, 0.f};
  LoadRowB bl; bl.A = Bt; bl.lda = ldb;
  const int nk = K / BK;
  al.fetch(m0, 0, tid); bl.fetch(n0, 0, tid);
  __syncthreads();
  al.commit(sbase, tid); bl.commit(sbase + 256 * LROW, tid);
  __syncthreads();
  for (int kt = 0; kt < nk; ++kt) {
    const u16* sA = sbase + (kt & 1) * STG;
    const u16* sB = sA + 256 * LROW;
    { int kn = (kt + 1 < nk ? kt + 1 : kt) * BK; al.fetch(m0, kn, tid); bl.fetch(n0, kn, tid); }
    __builtin_amdgcn_sched_barrier(0);
#pragma unroll
    for (int ks = 0; ks < 2; ++ks) {
      bf16x8 b[4];
#pragma unroll
      for (int j = 0; j < 4; ++j) b[j] = *(const bf16x8*)(sB + (wn * 64 + j * 16 + r16) * LROW + ks * 32 + g * 8);
#pragma unroll
      for (int ih = 0; ih < 2; ++ih) {
        bf16x8 a[4];
#pragma unroll
        for (int i = 0; i < 4; ++i) a[i] = *(const bf16x8*)(sA + (wm * 128 + (ih * 4 + i) * 16 + r16) * LROW + ks * 32 + g * 8);
#pragma unroll
        for (int i = 0; i < 4; ++i)
#pragma unroll
          for (int j = 0; j < 4; ++j) {
            if (SWAP) acc[ih * 4 + i][j] = mfma16(b[j], a[i], acc[ih * 4 + i][j]);
            else acc[ih * 4 + i][j] = mfma16(a[i], b[j], acc[ih * 4 + i][j]);
          }
        __builtin_amdgcn_sched_barrier(0);
      }
    }
    u16* nA = sbase + ((kt + 1) & 1) * STG;
    al.commit(nA, tid); bl.commit(nA + 256 * LROW, tid);
    __syncthreads();
  }
#pragma unroll
  for (int i = 0; i < 8; ++i)
#pragma unroll
    for (int j = 0; j < 4; ++j) {
      if (SWAP) ep.apply_t(m0 + wm * 128 + i * 16 + r16, n0 + wn * 64 + j * 16 + g * 4, acc[i][j]);
      else ep.apply(m0 + wm * 128 + i * 16 + g * 4, n0 + wn * 64 + j * 16 + r16, acc[i][j]);
    }
}

struct EpWin0 {
  u16 *uhyT, *uqk, *vT;
  DI void apply_t(int m, int nb, f32x4 v) const { *(U2*)(uqk + (size_t)m * 1024 + (nb - 1536)) = mk2(pack2g(v[0], v[1]), pack2g(v[2], v[3])); }
  DI void apply(int mb, int n, f32x4 v) const {
    int b, s; bs_of(mb, b, s);
    if (n < 1536) {
      U2 o = mk2(pack2g(v[0], v[1]), pack2g(v[2], v[3]));
      *(U2*)(uhyT + ((size_t)(b * 1536 + n)) * LT + s) = o;
    } else if (n < 2560) {
#pragma unroll
      for (int r = 0; r < 4; ++r) uqk[(size_t)(mb + r) * 1024 + (n - 1536)] = (u16)pack2g(v[r], 0.f);
    } else {
      U2 o = mk2(pack2g(v[0], v[1]), pack2g(v[2], v[3]));
      *(U2*)(vT + ((size_t)(b * 512 + (n - 2560))) * LT + s) = o;
    }
  }
};
struct EpResid {
  const float* xlat; const float* xctx; float* S; const float* mod; int goff;
  DI void apply_t(int m, int nb, f32x4 v) const {
    F4 gt = *(const F4*)(mod + (size_t)bidx_of(m) * 6144 + goff + nb);
    const float* xp = (m < NLAT) ? xlat + (size_t)m * 1024 + nb : xctx + (size_t)(m - NLAT) * 1024 + nb;
    F4 xi = *(const F4*)xp;
    *(F4*)(S + (size_t)m * 1024 + nb) = mkf4(ALPHA * xi.x + gt.x * v[0], ALPHA * xi.y + gt.y * v[1], ALPHA * xi.z + gt.z * v[2], ALPHA * xi.w + gt.w * v[3]);
  }
  DI void apply(int mb, int n, f32x4 v) const {
    float gt = mod[(size_t)bidx_of(mb) * 6144 + goff + n];
#pragma unroll
    for (int r = 0; r < 4; ++r) {
      int m = mb + r;
      float xi = (m < NLAT) ? xlat[(size_t)m * 1024 + n] : xctx[(size_t)(m - NLAT) * 1024 + n];
      S[(size_t)m * 1024 + n] = ALPHA * xi + gt * v[r];
    }
  }
};
struct EpRelu2 {
  u16* a1;
  DI void apply_t8(int m, int nb, f32x4 v0, f32x4 v1) const {
    float t0 = fmaxf(v0[0], 0.f), t1 = fmaxf(v0[1], 0.f), t2 = fmaxf(v0[2], 0.f), t3 = fmaxf(v0[3], 0.f);
    float t4 = fmaxf(v1[0], 0.f), t5 = fmaxf(v1[1], 0.f), t6 = fmaxf(v1[2], 0.f), t7 = fmaxf(v1[3], 0.f);
    *(U4*)(a1 + (size_t)m * 4096 + nb) = mk4(pack2(t0 * t0, t1 * t1), pack2(t2 * t2, t3 * t3), pack2(t4 * t4, t5 * t5), pack2(t6 * t6, t7 * t7));
  }
  DI void apply_t(int m, int nb, f32x4 v) const {
    float t0 = fmaxf(v[0], 0.f), t1 = fmaxf(v[1], 0.f), t2 = fmaxf(v[2], 0.f), t3 = fmaxf(v[3], 0.f);
    *(U2*)(a1 + (size_t)m * 4096 + nb) = mk2(pack2(t0 * t0, t1 * t1), pack2(t2 * t2, t3 * t3));
  }
  DI void apply(int mb, int n, f32x4 v) const {
#pragma unroll
    for (int r = 0; r < 4; ++r) { float t = fmaxf(v[r], 0.f); a1[(size_t)(mb + r) * 4096 + n] = f2bf(t * t); }
  }
};
struct EpPlain {
  u16* dst; int ld;
  DI void apply_t8(int m, int nb, f32x4 v0, f32x4 v1) const {
    *(U4*)(dst + (size_t)m * ld + nb) = mk4(pack2g(v0[0], v0[1]), pack2g(v0[2], v0[3]), pack2g(v1[0], v1[1]), pack2g(v1[2], v1[3]));
  }
  DI void apply_t(int m, int nb, f32x4 v) const { *(U2*)(dst + (size_t)m * ld + nb) = mk2(pack2g(v[0], v[1]), pack2g(v[2], v[3])); }
  DI void apply(int mb, int n, f32x4 v) const {
#pragma unroll
    for (int r = 0; r < 4; ++r) dst[(size_t)(mb + r) * ld + n] = (u16)pack2g(v[r], 0.f);
  }
};
struct EpQ {
  u16* q; const float* srow; int m0;
  DI void apply_t(int m, int nb, f32x4 v) const {
    int hc = nb % 96;
    float sr = srow[m - m0];
    float val[4], par[4];
#pragma unroll
    for (int r = 0; r < 4; ++r) { val[r] = v[r] * sr; par[r] = __shfl_xor(val[r], 32); }
    if (hc >= 64) {
      int i0 = hc - 64, axis = i0 >> 4, second = (i0 >> 3) & 1;
      int s = m & 8191;
      float pos = (float)(axis ? (s & 63) : (s >> 6));
#pragma unroll
      for (int r = 0; r < 4; ++r) {
        int idx = (i0 + r) & 7;
        float inv = exp2f(-(float)idx * (13.287712379549449f / 8.f));
        float rv = pos * inv * 0.15915494309189535f; float sn = __builtin_amdgcn_sinf(rv), cs = __builtin_amdgcn_cosf(rv);
        val[r] = second ? (val[r] * cs + par[r] * sn) : (val[r] * cs - par[r] * sn);
      }
    }
    const float qs = 0.10206207261596575f * LOG2E;
    *(U2*)(q + (size_t)m * 768 + nb) = mk2(pack2(val[0] * qs, val[1] * qs), pack2(val[2] * qs, val[3] * qs));
  }
  DI void apply(int mb, int n, f32x4 v) const {
    int hc = n % 96;
    float val[4], par[4];
#pragma unroll
    for (int r = 0; r < 4; ++r) { val[r] = v[r] * srow[mb - m0 + r]; par[r] = __shfl_xor(val[r], 8); }
    if (hc >= 64) {
      int i = hc - 64, axis = i >> 4, second = (i >> 3) & 1, idx = i & 7;
      float inv = exp2f(-(float)idx * (13.287712379549449f / 8.f));
#pragma unroll
      for (int r = 0; r < 4; ++r) {
        int s = (mb + r) & 8191;
        float pos = (float)(axis ? (s & 63) : (s >> 6));
        float rv = pos * inv * 0.15915494309189535f; float sn = __builtin_amdgcn_sinf(rv), cs = __builtin_amdgcn_cosf(rv);
        val[r] = second ? (val[r] * cs + par[r] * sn) : (val[r] * cs - par[r] * sn);
      }
    }
    const float qs = 0.10206207261596575f * LOG2E;
#pragma unroll
    for (int r = 0; r < 4; ++r) q[(size_t)(mb + r) * 768 + n] = f2bf(val[r] * qs);
  }
};
struct EpKV {
  u16 *kn, *vT; const float* srow; int m0;
  DI void apply_t(int, int, f32x4) const {}
  DI void apply(int mb, int n, f32x4 v) const {
    int b, s; bs_of(mb, b, s);
    float val[4];
#pragma unroll
    for (int r = 0; r < 4; ++r) val[r] = v[r] * srow[mb - m0 + r];
    if (n < 512) {
      int hh = n >> 6, cc = n & 63;
#pragma unroll
      for (int r = 0; r < 4; ++r) kn[((size_t)(b * 8 + hh) * LT + s + r) * 64 + cc] = f2bf(val[r]);
    } else {
      int j = n - 512, hh = j / 96, d = j % 96;
      U2 o = mk2(pack2(val[0], val[1]), pack2(val[2], val[3]));
      *(U2*)(vT + ((size_t)((b * 8 + hh) * 96 + d)) * LT + s) = o;
    }
  }
};
struct EpLds {
  float* buf; int m0, n0;
  DI void apply_t(int m, int nb, f32x4 v) const { *(F4*)(buf + (m - m0) * 132 + (nb - n0)) = mkf4(v[0], v[1], v[2], v[3]); }
  DI void apply(int, int, f32x4) const {}
};
struct EpFnet {
  u16* y1;
  DI void apply_t(int m, int nb, f32x4 v) const {
    int b = nb >> 8, ch = nb & 255;
    const float sc = 0.0013810679320049757f;
    *(U2*)(y1 + ((size_t)(b * 8192 + m)) * 1024 + 768 + ch) = mk2(pack2(v[0] * sc, v[1] * sc), pack2(v[2] * sc, v[3] * sc));
  }
  DI void apply(int mb, int n, f32x4 v) const {
    int b = n >> 8, ch = n & 255;
    const float sc = 0.0013810679320049757f;
#pragma unroll
    for (int r = 0; r < 4; ++r) y1[((size_t)(b * 8192 + mb + r)) * 1024 + 768 + ch] = f2bf(v[r] * sc);
  }
};

DI void rms_rows(const u16* A, int lda, int K, int m0, float* srow) {
  int tid = tidx(), row = tid >> 1, half = tid & 1;
  const u16* a = A + (size_t)(m0 + row) * lda + half * (K / 2);
  float ss = 0.f;
  for (int k = 0; k < K / 2; k += 8) {
    U4 q = *(const U4*)(a + k);
    u32 w[4] = {q.x, q.y, q.z, q.w};
#pragma unroll
    for (int e = 0; e < 4; ++e) { float lo = __uint_as_float(w[e] << 16), hi = __uint_as_float(w[e] & 0xffff0000u); ss += lo * lo + hi * hi; }
  }
  ss += __shfl_xor(ss, 1);
  if (half == 0) srow[row] = rsqrtf(ss / (float)K + LN_EPS);
}


namespace pg8 {
#define PG8_LAS __attribute__((address_space(3)))
typedef unsigned short bf16_t;
typedef short bf16x8 __attribute__((ext_vector_type(8)));
typedef float f32x4 __attribute__((ext_vector_type(4)));
typedef unsigned u32x4 __attribute__((ext_vector_type(4)));
constexpr int BM = 256, BK = 64, HALF = 128, HTB = HALF * BK * 2  , STAGE_BYTES = 8 * HTB, NXCD = 8, WGM = 8;

__host__ __device__ __forceinline__ int lds_byte(int r, int c) { const int st = (r >> 4) * 2 + (c >> 5), rr = r & 15, cc = c & 31, ob = rr * 64 + cc * 2; return st * 1024 + (ob ^ (((ob >> 9) & 1) << 5)); }
__host__ __device__ __forceinline__ void stage_rc(int b, int& R, int& C) { const int st = b / 1024, sb = b % 1024, swz = sb ^ (((sb >> 9) & 1) << 5); R = (st >> 1) * 16 + swz / 64; C = (st & 1) * 32 + (swz % 64) / 2; }
__host__ __device__ __forceinline__ int perm32(int rho) { const int n = rho >> 4, i = rho & 15; return 8 * (i >> 2) + 4 * n + (i & 3); }

struct Unit { int pm, pn; };
struct Gemm { const bf16_t* A; const bf16_t* Bt; int M, N, K; };

struct StaticOrder {
    int nM, nN, nwg, G, c;
    __host__ __device__ void init(int M, int N, int G_, int c_) { nM = M / BM; nN = N / BM; nwg = nM * nN; G = G_; c = c_; }
    __host__ __device__ bool next(int i, Unit& u) const {
        const long L = (long)i * G + c; if (L >= nwg) return false;
        int wgid = (int)L; { const int q = nwg / NXCD, r = nwg % NXCD, xcd = wgid % NXCD, off = wgid / NXCD; wgid = (xcd < r ? xcd * (q + 1) : r * (q + 1) + (xcd - r) * q) + off; }
        const int nig = WGM * nN, gid = wgid / nig, fm = gid * WGM, gsz = (nM - fm) < WGM ? (nM - fm) : WGM;
        u.pm = fm + ((wgid % nig) % gsz); u.pn = (wgid % nig) / gsz; return true;
    }
    __device__ __forceinline__ void a_ready(const Unit&) const {}
    __device__ __forceinline__ void done(const Unit&) const {}
};
template <class Epi, class Sched, bool STAMP = false>
__device__ __forceinline__ void gemm_phase(PG8_LAS unsigned char* lds, const Gemm g, const Sched& S, const Epi& E, unsigned long long* stamps) {
    const int tid = tid512(), wid = __builtin_amdgcn_readfirstlane(tid >> 6), lane = tid & 63, wr = wid >> 2, wc = wid & 3, fr = lane & 15, fq = lane >> 4;
    const int K = g.K, nt = K / BK;
    int ts_lo = 0, ts_hi = 0, nts = 0; const unsigned long long rt_entry = STAMP ? (unsigned long long)wall_clock64() : 0ull;
#define PG8_STAMP() do { if (STAMP && wid == 0 && nts < 64) { const unsigned long long _c = (unsigned long long)clock64(); \
        ts_lo = (lane == nts) ? (int)(unsigned)_c : ts_lo; ts_hi = (lane == nts) ? (int)(unsigned)(_c >> 32) : ts_hi; ++nts; } } while (0)
    PG8_STAMP();
    unsigned voffA[2], voffB[2];
#pragma unroll
    for (int i = 0; i < 2; ++i) { int R, C; stage_rc(tid * 16 + i * 8192, R, C); const int Rb = Epi::PERM ? ((R & ~31) + perm32(R & 31)) : R;
        voffA[i] = (unsigned)(R * K + C) * 2u; voffB[i] = (unsigned)(Rb * K + C) * 2u; }
    const size_t kstep = (size_t)(BK * 2);
    const size_t hstep = (size_t)HALF * K * 2;
    const size_t tstep = 2 * hstep;
    const unsigned ldsw = (unsigned)wid * 1024u;
    const int aoff = lds_byte(wr * 64 + fr, fq * 8), boff = lds_byte(wc * 32 + fr, fq * 8);
#define PG8_SA(b, h) (((b) * 2 + (h)) * HTB)
#define PG8_SB(b, h) ((4 + (b) * 2 + (h)) * HTB)
#define PG8_STAGE(bufoff, gbase, voff) do { _Pragma("unroll") for (int _i = 0; _i < 2; ++_i) \
        __builtin_amdgcn_global_load_lds((const unsigned*)((const char*)(gbase) + (voff)[_i]), (PG8_LAS unsigned*)(lds + (bufoff) + ldsw + _i * 8192), 16, 0, 0); } while (0)
#define PG8_LDA(dst, b, h) do { _Pragma("unroll") for (int m = 0; m < 4; ++m) _Pragma("unroll") for (int k = 0; k < 2; ++k) dst[m][k] = *(const PG8_LAS bf16x8*)(lds + PG8_SA(b, h) + aoff + m * 2048 + k * 1024); } while (0)
#define PG8_LDB(dst, b, h) do { _Pragma("unroll") for (int n = 0; n < 2; ++n) _Pragma("unroll") for (int k = 0; k < 2; ++k) dst[n][k] = *(const PG8_LAS bf16x8*)(lds + PG8_SB(b, h) + boff + n * 2048 + k * 1024); } while (0)
#define PG8_MMA(ai, bj, At, Bt) do { __builtin_amdgcn_s_setprio(1); _Pragma("unroll") for (int m = 0; m < 4; ++m) _Pragma("unroll") for (int n = 0; n < 2; ++n) _Pragma("unroll") for (int k = 0; k < 2; ++k) \
        acc[ai][bj][m][n] = __builtin_amdgcn_mfma_f32_16x16x32_bf16(Bt[n][k], At[m][k], acc[ai][bj][m][n], 0, 0, 0); __builtin_amdgcn_s_setprio(0); } while (0)
#define PG8_WAIT_V(n) asm volatile("s_waitcnt vmcnt(" #n ")" ::: "memory")
#define PG8_WAIT_L(n) asm volatile("s_waitcnt lgkmcnt(" #n ")" ::: "memory")
#define PG8_BAR __builtin_amdgcn_s_barrier()
#define PG8_SCHED __builtin_amdgcn_sched_barrier(0)
    Unit cur, nxt; int ui = 0;
    if (!S.next(0, cur)) return;
    f32x4 acc[2][2][4][2];
#pragma unroll
    for (int a = 0; a < 2; ++a)
#pragma unroll
        for (int b = 0; b < 2; ++b)
#pragma unroll
            for (int m = 0; m < 4; ++m)
#pragma unroll
                for (int n = 0; n < 2; ++n) acc[a][b][m][n] = (f32x4){0.f, 0.f, 0.f, 0.f};
    bf16x8 At[4][2], B0[2][2], B1[2][2];
    const char* cA = (const char*)g.A + (size_t)cur.pm * tstep; const char* cB = (const char*)g.Bt + (size_t)cur.pn * tstep;
    S.a_ready(cur);
    PG8_STAGE(PG8_SB(0, 0), cB, voffB); PG8_STAGE(PG8_SA(0, 0), cA, voffA); PG8_STAGE(PG8_SB(0, 1), cB + hstep, voffB); PG8_STAGE(PG8_SA(0, 1), cA + hstep, voffA);
    if (wr == 1) PG8_BAR;
    PG8_WAIT_V(4); PG8_BAR;
    PG8_STAGE(PG8_SB(1, 0), cB + kstep, voffB); PG8_STAGE(PG8_SA(1, 0), cA + kstep, voffA); PG8_STAGE(PG8_SB(1, 1), cB + hstep + kstep, voffB);
    PG8_WAIT_V(6); PG8_BAR;
    PG8_STAMP();
    for (;;) {
        const bool has_next = S.next(ui + 1, nxt);
        const char* nA = has_next ? (const char*)g.A + (size_t)nxt.pm * tstep : cA; const char* nB = has_next ? (const char*)g.Bt + (size_t)nxt.pn * tstep : cB;
        for (int t = 0; t < nt; t += 2) {
            const bool last = (t == nt - 2);
            const char* a1 = cA + (size_t)(t + 1) * kstep;
            const char* a2 = last ? nA : cA + (size_t)(t + 2) * kstep; const char* b2 = last ? nB : cB + (size_t)(t + 2) * kstep;
            const char* a3 = a2 + kstep; const char* b3 = b2 + kstep;
            if (last && has_next) S.a_ready(nxt);
            PG8_LDB(B0, 0, 0); PG8_SCHED; PG8_LDA(At, 0, 0); PG8_STAGE(PG8_SA(1, 1), a1 + hstep, voffA);
            PG8_WAIT_L(8); PG8_BAR; PG8_WAIT_L(0); PG8_MMA(0, 0, At, B0); PG8_BAR; PG8_SCHED;
            PG8_LDB(B1, 0, 1); PG8_STAGE(PG8_SB(0, 0), b2, voffB);
            PG8_BAR; PG8_WAIT_L(0); PG8_MMA(0, 1, At, B1); PG8_BAR;
            PG8_LDA(At, 0, 1); PG8_STAGE(PG8_SA(0, 0), a2, voffA);
            PG8_BAR; PG8_WAIT_L(0); PG8_MMA(1, 0, At, B0); PG8_BAR; PG8_SCHED;
            PG8_STAGE(PG8_SB(0, 1), b2 + hstep, voffB);
            PG8_WAIT_V(6); PG8_BAR; PG8_MMA(1, 1, At, B1); PG8_BAR;
            PG8_LDB(B0, 1, 0); PG8_SCHED; PG8_LDA(At, 1, 0); PG8_STAGE(PG8_SA(0, 1), a2 + hstep, voffA);
            PG8_WAIT_L(8); PG8_BAR; PG8_WAIT_L(0); PG8_MMA(0, 0, At, B0); PG8_BAR; PG8_SCHED;
            PG8_LDB(B1, 1, 1); PG8_STAGE(PG8_SB(1, 0), b3, voffB);
            PG8_BAR; PG8_WAIT_L(0); PG8_MMA(0, 1, At, B1); PG8_BAR;
            PG8_LDA(At, 1, 1); PG8_STAGE(PG8_SA(1, 0), a3, voffA);
            PG8_BAR; PG8_WAIT_L(0); PG8_MMA(1, 0, At, B0); PG8_BAR; PG8_SCHED;
            PG8_STAGE(PG8_SB(1, 1), b3 + hstep, voffB);
            PG8_WAIT_V(6); PG8_BAR; PG8_MMA(1, 1, At, B1); PG8_BAR;
        }
        PG8_STAMP();
        if constexpr (!Epi::AFTER_DRAIN) { E(acc, cur, wr, wc, fr, fq); S.done(cur); }
        PG8_STAMP();
        if (!has_next) break;
#pragma unroll
        for (int a = 0; a < 2; ++a)
#pragma unroll
            for (int b = 0; b < 2; ++b)
#pragma unroll
                for (int m = 0; m < 4; ++m)
#pragma unroll
                    for (int n = 0; n < 2; ++n) acc[a][b][m][n] = (f32x4){0.f, 0.f, 0.f, 0.f};
        cur = nxt; cA = nA; cB = nB; ++ui;
    }
    PG8_WAIT_V(0);
    if (wr == 0) PG8_BAR;
    PG8_BAR;
    if constexpr (Epi::AFTER_DRAIN) { E.fused(acc, cur, wr, wc, fr, fq, lds, wid, lane); S.done(cur); }
    PG8_STAMP();
    if (STAMP && wid == 0) { stamps[lane] = lane < nts ? (((unsigned long long)(unsigned)ts_hi << 32) | (unsigned)ts_lo) : 0ull;
        if (lane == 62) stamps[62] = rt_entry; if (lane == 63) stamps[63] = (unsigned long long)wall_clock64(); }
#undef PG8_STAMP
#undef PG8_SA
#undef PG8_SB
#undef PG8_STAGE
#undef PG8_LDA
#undef PG8_LDB
#undef PG8_MMA
#undef PG8_WAIT_V
#undef PG8_WAIT_L
#undef PG8_BAR
#undef PG8_SCHED
}
}

template <class EP, bool SWAPROLE> struct EpiAdapt {
  static constexpr bool PERM = false, AFTER_DRAIN = false;
  EP ep; int roff, coff;
  DI void operator()(const f32x4 (&acc)[2][2][4][2], const pg8::Unit& u, int wr, int wc, int fr, int fq) const {
    const int row0 = u.pm * 256 + wr * 64 + fr + roff, col0 = u.pn * 256 + wc * 32 + 4 * fq + coff;
#pragma unroll
    for (int ai = 0; ai < 2; ++ai)
#pragma unroll
      for (int m = 0; m < 4; ++m)
#pragma unroll
        for (int bj = 0; bj < 2; ++bj)
#pragma unroll
          for (int n = 0; n < 2; ++n) {
            const int r = row0 + ai * 128 + m * 16, c = col0 + bj * 128 + n * 16;
            if (SWAPROLE) ep.apply(c, r, acc[ai][bj][m][n]);
            else ep.apply_t(r, c, acc[ai][bj][m][n]);
          }
  }
};
template <class EP> struct EpiAdaptP {
  static constexpr bool PERM = true, AFTER_DRAIN = false;
  EP ep;
  DI void operator()(const f32x4 (&acc)[2][2][4][2], const pg8::Unit& u, int wr, int wc, int fr, int fq) const {
    const int row0 = u.pm * 256 + wr * 64 + fr, col0 = u.pn * 256 + wc * 32 + 8 * fq;
#pragma unroll
    for (int ai = 0; ai < 2; ++ai)
#pragma unroll
      for (int m = 0; m < 4; ++m)
#pragma unroll
        for (int bj = 0; bj < 2; ++bj)
          ep.apply_t8(row0 + ai * 128 + m * 16, col0 + bj * 128, acc[ai][bj][m][0], acc[ai][bj][m][1]);
  }
};
template <class EP>
DI void run_phase_p(char* smem_all, const u16* A, const u16* Bt, int M, int N, int K, const EP& ep) {
  pg8::Gemm g; g.A = A; g.Bt = Bt; g.M = M; g.N = N; g.K = K;
  pg8::StaticOrder S; S.init(M, N, (int)gridDim.x, rbidx());
  EpiAdaptP<EP> E; E.ep = ep;
  __syncthreads();
  pg8::gemm_phase<EpiAdaptP<EP>, pg8::StaticOrder, false>((PG8_LAS unsigned char*)smem_all, g, S, E, nullptr);
  __syncthreads();
}
template <class EP, bool SWAPROLE>
DI void run_phase(char* smem_all, const u16* A, const u16* Bt, int M, int N, int K, const EP& ep, int roff, int coff) {
  pg8::Gemm g; g.A = A; g.Bt = Bt; g.M = M; g.N = N; g.K = K;
  pg8::StaticOrder S; S.init(M, N, (int)gridDim.x, rbidx());
  EpiAdapt<EP, SWAPROLE> E; E.ep = ep; E.roff = roff; E.coff = coff;
  __syncthreads();
  pg8::gemm_phase<EpiAdapt<EP, SWAPROLE>, pg8::StaticOrder, false>((PG8_LAS unsigned char*)smem_all, g, S, E, nullptr);
  __syncthreads();
}

DI void tr_tile(const float* src, int K, int N, int Nvalid, u16* dst, const float* gk, int tile, char* smem, bool perm_ukv) {
  float* t = (float*)smem;
  int ntn = N / 64, kt = tile / ntn, nt = tile % ntn, k0 = kt * 64, n0 = nt * 64, tid = tidx();
#pragma unroll
  for (int ps = 0; ps < 4; ++ps) {
    int i = ps * 16 + (tid >> 4), j = (tid & 15) * 4;
    F4 v = mkf4(0.f, 0.f, 0.f, 0.f);
    if (n0 + j < Nvalid) v = *(const F4*)(src + (size_t)(k0 + i) * Nvalid + n0 + j);
    float sc = gk ? gk[k0 + i] : 1.f;
    t[i * 65 + j] = v.x * sc; t[i * 65 + j + 1] = v.y * sc; t[i * 65 + j + 2] = v.z * sc; t[i * 65 + j + 3] = v.w * sc;
  }
  __syncthreads();
  int n = tid >> 2, kc = (tid & 3) * 16;
  u32 o[8];
#pragma unroll
  for (int e = 0; e < 8; ++e) o[e] = pack2(t[(kc + 2 * e) * 65 + n], t[(kc + 2 * e + 1) * 65 + n]);
  int nn = n0 + n;
  if (perm_ukv) { int hh = nn / 160, cc = nn % 160; nn = cc < 64 ? hh * 64 + cc : 512 + hh * 96 + (cc - 64); }
  U4* d = (U4*)(dst + (size_t)nn * K + k0 + kc);
  d[0] = mk4(o[0], o[1], o[2], o[3]);
  d[1] = mk4(o[4], o[5], o[6], o[7]);
}

DI void mod_item(const Params& p, int it, char* smem) {
  float* sc = (float*)smem;
  float* red = sc + 5 * 1024;
  int l = it / 96, chunk = it % 96, tid = tidx(), lane = tid & 63, w = tid >> 6;
  for (int e = tid; e < 5 * 1024; e += 256) {
    int r = e >> 10, k = e & 1023;
    float v = r < 4 ? p.c[r * 1024 + k] : p.c_ctx[k];
    sc[e] = v / (1.f + __expf(-v));
  }
  __syncthreads();
  int n = chunk * 64 + lane;
  const float* W = p.mod_w + (size_t)l * 1024 * 6144 + n;
  float a0 = 0, a1 = 0, a2 = 0, a3 = 0, a4 = 0;
#pragma unroll 16
  for (int kk = 0; kk < 256; ++kk) {
    int k = w * 256 + kk;
    float wv = W[(size_t)k * 6144];
    a0 += sc[k] * wv; a1 += sc[1024 + k] * wv; a2 += sc[2048 + k] * wv; a3 += sc[3072 + k] * wv; a4 += sc[4096 + k] * wv;
  }
  red[(w * 5 + 0) * 64 + lane] = a0; red[(w * 5 + 1) * 64 + lane] = a1; red[(w * 5 + 2) * 64 + lane] = a2;
  red[(w * 5 + 3) * 64 + lane] = a3; red[(w * 5 + 4) * 64 + lane] = a4;
  __syncthreads();
  if (w == 0) {
    float bv = p.mod_b[l * 6144 + n];
    float* o = (float*)(wsp(p) + O_MOD) + (size_t)l * 5 * 6144 + n;
#pragma unroll
    for (int r = 0; r < 5; ++r) o[r * 6144] = red[(0 * 5 + r) * 64 + lane] + red[(1 * 5 + r) * 64 + lane] + red[(2 * 5 + r) * 64 + lane] + red[(3 * 5 + r) * 64 + lane] + bv;
  }
}

DI void filt_item(const Params& p, char* smem, int Lf, int p0, u16* Tg) {
  const int TgLen = 2 * Lf, tid = tidx();
  float* zf = (float*)smem;
  float* h1 = zf + 32 * 33;
  float* w1s = h1 + 32 * 64;
  float* w2s = w1s + 33 * 64;
  float* h2 = w2s + 64 * 64;
  u16* st = (u16*)smem;
  constexpr int STR = 258;
  for (int e = tid; e < 33 * 64; e += 256) w1s[e] = p.hy_w1[e];
  for (int e = tid; e < 64 * 64; e += 256) w2s[e] = p.hy_w2[e];
#pragma unroll 1
  for (int batch = 0; batch < 2; ++batch) {
    for (int e = tid; e < 32 * 33; e += 256) {
      int pos = e / 33, f = e % 33; float pp = (float)(p0 + 32 * batch + pos);
      float t = pp / (float)(Lf - 1), wv = 6.283185307179586f * pp / (float)Lf, val;
      if (f == 0) val = t;
      else {
        int fi = (f - 1) & 15;
        float fr = 1e-4f + (float)fi * ((15.f - 1e-4f) / 15.f);
        val = (f <= 16) ? cosf(wv * fr) : -sinf(wv * fr);
      }
      zf[e] = val;
    }
    __syncthreads();
    {
      int pos = tid >> 3, ug = tid & 7;
      float acc[8];
#pragma unroll
      for (int uu = 0; uu < 8; ++uu) acc[uu] = p.hy_b1[ug + 8 * uu];
#pragma unroll 3
      for (int f = 0; f < 33; ++f) {
        float z = zf[pos * 33 + f];
#pragma unroll
        for (int uu = 0; uu < 8; ++uu) acc[uu] += z * w1s[f * 64 + ug + 8 * uu];
      }
#pragma unroll
      for (int uu = 0; uu < 8; ++uu) h1[pos * 64 + ug + 8 * uu] = sinf(p.hy_freq[ug + 8 * uu] * acc[uu]);
    }
    __syncthreads();
    {
      int pos = tid >> 3, ug = tid & 7;
      float acc[8];
#pragma unroll
      for (int uu = 0; uu < 8; ++uu) acc[uu] = p.hy_b2[ug + 8 * uu];
#pragma unroll 4
      for (int f = 0; f < 64; ++f) {
        float z = h1[pos * 64 + f];
#pragma unroll
        for (int uu = 0; uu < 8; ++uu) acc[uu] += z * w2s[f * 64 + ug + 8 * uu];
      }
#pragma unroll
      for (int uu = 0; uu < 8; ++uu) h2[(32 * batch + pos) * 64 + ug + 8 * uu] = sinf(p.hy_freq[ug + 8 * uu] * acc[uu]);
    }
    __syncthreads();
  }
#pragma unroll 1
  for (int cc = 0; cc < 8; ++cc) {
    int col = cc * 256 + tid;
    float w3r[64];
#pragma unroll
    for (int u = 0; u < 64; ++u) w3r[u] = p.hy_w3[u * 2048 + col];
    float ld = __expf(p.hy_log_decay[col]);
    int conv = col >> 10, dir = (col >> 9) & 1, c = col & 511;
    float skipv = p.hy_skip[conv * 512 + c];
#pragma unroll 1
    for (int pos = 0; pos < 64; ++pos) {
      float a = 0.f;
#pragma unroll
      for (int u = 0; u < 64; ++u) a += h2[pos * 64 + u] * w3r[u];
      int pp = p0 + pos;
      float t = (float)pp / (float)(Lf - 1);
      float val = a * __expf(-t * ld);
      if (pp == 0) val = (dir == 0) ? (val + skipv) : 0.f;
      st[pos * STR + tid] = f2bf(val);
    }
    __syncthreads();
#pragma unroll 1
    for (int k = 0; k < 64; ++k) {
      int cl = (tid >> 6) + 4 * k, pos = tid & 63, colw = cc * 256 + cl, pp = p0 + pos;
      int conv2 = colw >> 10, dir2 = (colw >> 9) & 1, c2 = colw & 511;
      Tg[(size_t)(conv2 * 512 + c2) * TgLen + dir2 * Lf + pp] = st[pos * STR + cl];
    }
    __syncthreads();
  }
}

constexpr int NT_TR = 768 + 256 + 1024 + 1024 + 1024 + 1024 + 256 + 256 + 72 + 80;
constexpr int N_PREP = NT_TR + 192 + 128 + 4;

DI void phase_prep(const Params& p, char* smem) {
  char* ws = wsp(p);
  for (int it = bidx(); it < N_PREP; it += NVB) {
    __syncthreads();
    int t = it;
    if (t < NT_TR) {
      const float* src; int K, N, Nv; u16* dst; const float* gk = nullptr; bool perm = false;
      if (t < 768) { src = p.ab_w_in; K = 1024; N = 3072; Nv = 3072; dst = (u16*)(ws + O_WT_ABIN); }
      else if ((t -= 768) < 256) { src = p.ab_w_out; K = 1024; N = 1024; Nv = 1024; dst = (u16*)(ws + O_WT_ABOUT); }
      else if ((t -= 256) < 2048) { int l = t >> 10; t &= 1023; src = p.mlp_w1 + (size_t)l * 1024 * 4096; K = 1024; N = 4096; Nv = 4096; dst = (u16*)(ws + O_WT_W1) + (size_t)l * 4096 * 1024; }
      else if ((t -= 2048) < 2048) { int l = t >> 10; t &= 1023; src = p.mlp_w2 + (size_t)l * 1024 * 4096; K = 4096; N = 1024; Nv = 1024; dst = (u16*)(ws + O_WT_W2) + (size_t)l * 4096 * 1024; }
      else if ((t -= 2048) < 256) { src = p.cd_w_in; K = 1024; N = 1024; Nv = 928; dst = (u16*)(ws + O_WT_CDIN); }
      else if ((t -= 256) < 256) { src = p.cd_w_out; K = 1024; N = 1024; Nv = 1024; dst = (u16*)(ws + O_WT_CDOUT); }
      else if ((t -= 256) < 72) { src = p.mla_w_uq; K = 384; N = 768; Nv = 768; dst = (u16*)(ws + O_WT_UQ); gk = p.mla_q_norm; }
      else { t -= 72; src = p.mla_w_ukv; K = 256; N = 1280; Nv = 1280; dst = (u16*)(ws + O_WT_UKV); gk = p.mla_kv_norm; perm = true; }
      tr_tile(src, K, N, Nv, dst, gk, t, smem, perm);
      continue;
    }
    t -= NT_TR;
    if (t < 192) { mod_item(p, t, smem); continue; }
    t -= 192;
    int Lf = SEQL; u16* Tg = (u16*)(ws + O_TLAT);
    if (t >= 128) { t -= 128; Lf = LC; Tg = (u16*)(ws + O_TCTX); }
    filt_item(p, smem, Lf, t * 64, Tg);
  }
}

template <bool FROM_IN, bool AFFINE, bool MOD>
DI void phase_ln(const Params& p, int nrows, const float* g, const float* bb, float* dst, bool dst_is_S, int lmod, int shoff,
                 int scoff) {
  const int lane = tidx() & 63, wv = tidx() >> 6;
  const int gw = bidx() * 4 + wv, nw = NVB * 4;
  float* S = (float*)(wsp(p) + O_S);
  u16* hbuf = (u16*)(wsp(p) + O_HBUF);
  for (int m = gw; m < nrows; m += nw) {
    const float* src;
    if (FROM_IN) src = (m < NLAT) ? p.x + (size_t)m * 1024 : p.ctx + (size_t)(m - NLAT) * 1024;
    else src = S + (size_t)m * 1024;
    float v[16];
#pragma unroll
    for (int i = 0; i < 4; ++i) {
      F4 q = *(const F4*)(src + i * 256 + lane * 4);
      v[4 * i] = q.x; v[4 * i + 1] = q.y; v[4 * i + 2] = q.z; v[4 * i + 3] = q.w;
    }
    if (AFFINE) {
      float s = 0.f;
#pragma unroll
      for (int i = 0; i < 16; ++i) s += v[i];
      float mu = wave_sum(s) * (1.f / 1024.f);
      float q2 = 0.f;
#pragma unroll
      for (int i = 0; i < 16; ++i) { float d = v[i] - mu; q2 += d * d; }
      float rstd = rsqrtf(wave_sum(q2) * (1.f / 1024.f) + LN_EPS);
      float* drow = dst_is_S ? (S + (size_t)m * 1024) : (dst + (size_t)m * 1024);
#pragma unroll
      for (int i = 0; i < 4; ++i) {
        int e = i * 256 + lane * 4;
        F4 gg = *(const F4*)(g + e), b4 = *(const F4*)(bb + e);
        v[4 * i] = (v[4 * i] - mu) * rstd * gg.x + b4.x;
        v[4 * i + 1] = (v[4 * i + 1] - mu) * rstd * gg.y + b4.y;
        v[4 * i + 2] = (v[4 * i + 2] - mu) * rstd * gg.z + b4.z;
        v[4 * i + 3] = (v[4 * i + 3] - mu) * rstd * gg.w + b4.w;
        *(F4*)(drow + e) = mkf4(v[4 * i], v[4 * i + 1], v[4 * i + 2], v[4 * i + 3]);
      }
    }
    if (MOD) {
      float s = 0.f;
#pragma unroll
      for (int i = 0; i < 16; ++i) s += v[i];
      float mu = wave_sum(s) * (1.f / 1024.f);
      float q2 = 0.f;
#pragma unroll
      for (int i = 0; i < 16; ++i) { float d = v[i] - mu; q2 += d * d; }
      float rstd = rsqrtf(wave_sum(q2) * (1.f / 1024.f) + LN_EPS);
      const float* md = modp(p, lmod, bidx_of(m));
#pragma unroll
      for (int i = 0; i < 4; ++i) {
        int e = i * 256 + lane * 4;
        F4 sh = *(const F4*)(md + shoff + e), sc = *(const F4*)(md + scoff + e);
        float o0 = (v[4 * i] - mu) * rstd * (1.f + sc.x) + sh.x;
        float o1 = (v[4 * i + 1] - mu) * rstd * (1.f + sc.y) + sh.y;
        float o2 = (v[4 * i + 2] - mu) * rstd * (1.f + sc.z) + sh.z;
        float o3 = (v[4 * i + 3] - mu) * rstd * (1.f + sc.w) + sh.w;
        *(U2*)(hbuf + (size_t)m * 1024 + e) = mk2(pack2(o0, o1), pack2(o2, o3));
      }
    }
  }
}

DI bf16x8 toep_frag(const u32* Tr32, int o) {
  int wd = o >> 1; u32 sh = (o & 1) * 16;
  u32 d0 = Tr32[wd], d1 = Tr32[wd + 1], d2 = Tr32[wd + 2], d3 = Tr32[wd + 3], d4 = Tr32[wd + 4];
  U4 q = mk4(__builtin_amdgcn_alignbit(d1, d0, sh), __builtin_amdgcn_alignbit(d2, d1, sh),
                       __builtin_amdgcn_alignbit(d3, d2, sh), __builtin_amdgcn_alignbit(d4, d3, sh));
  return __builtin_bit_cast(bf16x8, q);
}

DI void toep_item(const Params& p, char* smem, int cv, int c, int bp) {
  const int tid = tidx(), lane = tid & 63, w = tid >> 6, r16 = lane & 15, g = lane >> 4;
  u16* Tr = (u16*)smem;
  u16* Zs = Tr + 16384 + 16;
  const u16* uhyT = (const u16*)(wsp(p) + O_UHYT);
  u16* zT = (u16*)(wsp(p) + O_ZT);
  u16* yhyT = (u16*)(wsp(p) + O_YHYT);
  {
    const u16* GF = (const u16*)(wsp(p) + O_TLAT) + (size_t)(cv * 512 + c) * 16384;
    const U4* GB = (const U4*)(GF + 8192);
    const u16 t0v = GF[0];
    for (int e = tid; e < 1024; e += 256) {
      U4 q = GB[e];
      if (e == 0) q.x = (q.x & 0xffff0000u) | (u32)t0v;
      ((U4*)Tr)[1024 + e] = q;
    }
    for (int e = tid; e < 1024; e += 256) {
      U4 q = ((const U4*)GF)[e];
      u16* d = Tr + 8192 - 8 * e;
      d[0] = (u16)(q.x); d[-1] = (u16)(q.x >> 16); d[-2] = (u16)(q.y); d[-3] = (u16)(q.y >> 16);
      d[-4] = (u16)(q.z); d[-5] = (u16)(q.z >> 16); d[-6] = (u16)(q.w); d[-7] = (u16)(q.w >> 16);
    }
    if (tid == 0) Tr[0] = 0;
    if (tid < 2) { u32 z = 0; asm volatile("" : "+v"(z)); ((U4*)Tr)[2048 + tid] = mk4(z, z, z, z); }
  }
  for (int bb = 0; bb < 2; ++bb) {
    int b = 2 * bp + bb;
    if (cv == 0) {
      const u16* src = uhyT + ((size_t)(b * 1536 + 1024 + c)) * LT;
      float w0 = p.hy_conv_w[1024 + c], w1 = p.hy_conv_w[1536 + 1024 + c], w2 = p.hy_conv_w[2 * 1536 + 1024 + c];
      for (int e = tid; e < 1024; e += 256) {
        int s0 = e * 8;
        U4 q = *(const U4*)(src + s0);
        float u[10];
        u[0] = s0 > 0 ? bf2f(src[s0 - 1]) : 0.f;
        u[9] = s0 + 8 < SEQL ? bf2f(src[s0 + 8]) : 0.f;
        u32 ww[4] = {q.x, q.y, q.z, q.w};
#pragma unroll
        for (int k = 0; k < 4; ++k) { u[1 + 2 * k] = __uint_as_float(ww[k] << 16); u[2 + 2 * k] = __uint_as_float(ww[k] & 0xffff0000u); }
        float o[8];
#pragma unroll
        for (int k = 0; k < 8; ++k) o[k] = w0 * u[k] + w1 * u[k + 1] + w2 * u[k + 2];
        *(U4*)(Zs + bb * 8192 + s0) = mk4(pack2(o[0], o[1]), pack2(o[2], o[3]), pack2(o[4], o[5]), pack2(o[6], o[7]));
      }
    } else {
      const U4* src = (const U4*)(zT + ((size_t)(b * 512 + c)) * LT);
      for (int e = tid; e < 1024; e += 256) ((U4*)(Zs + bb * 8192))[e] = src[e];
    }
  }
  __syncthreads();
  const int bb = w >> 1, hw = w & 1;
  const u16* Zb = Zs + bb * 8192;
  const u32* Tr32 = (const u32*)Tr;
  f32x4 acc[4][4];
#pragma unroll
  for (int i = 0; i < 4; ++i)
#pragma unroll
    for (int j = 0; j < 4; ++j) acc[i][j] = f32x4{0.f, 0.f, 0.f, 0.f};
  const int obase = 8192 - r16 + 8 * g;
  const int dl_lo = hw ? -63 : -127, dl_hi = hw ? 127 : 63;
  bf16x8 F[6];
#pragma unroll
  for (int e = 0; e < 6; ++e) F[e] = toep_frag(Tr32, obase - 16 * (4 * dl_lo - 2 + e));
  for (int dl = dl_lo; dl <= dl_hi; ++dl) {
    int lo = dl > 0 ? dl : 0, hi = dl < 0 ? 127 + dl : 127;
    bf16x8 Fn[4];
    {
      int dn = dl < dl_hi ? dl + 1 : dl;
#pragma unroll
      for (int e = 0; e < 4; ++e) Fn[e] = toep_frag(Tr32, obase - 16 * (4 * dn + e));
    }
#pragma unroll
    for (int nt = 0; nt < 4; ++nt) {
      int t1lo = 64 * hw + 16 * nt;
      if (t1lo + 15 < lo || t1lo > hi) continue;
      int s1 = t1lo + r16 - dl;
      bool ok = (s1 >= 0) && (s1 < 128);
      int s1c = ok ? s1 : 0;
#pragma unroll
      for (int ks = 0; ks < 2; ++ks) {
        U4 q = *(const U4*)(Zb + 64 * s1c + 32 * ks + 8 * g);
        if (!ok) q = mk4(0, 0, 0, 0);
        bf16x8 bfr = __builtin_bit_cast(bf16x8, q);
#pragma unroll
        for (int mt = 0; mt < 4; ++mt) acc[mt][nt] = mfma16(F[mt - 2 * ks + 2], bfr, acc[mt][nt]);
      }
    }
    F[0] = F[4]; F[1] = F[5]; F[2] = Fn[0]; F[3] = Fn[1]; F[4] = Fn[2]; F[5] = Fn[3];
  }
  {
    int b = 2 * bp + bb, choff = (cv == 0) ? 0 : 512;
    const u16* xr = uhyT + ((size_t)(b * 1536 + choff + c)) * LT;
    float w0 = p.hy_conv_w[choff + c], w1 = p.hy_conv_w[1536 + choff + c], w2 = p.hy_conv_w[2 * 1536 + choff + c];
    u16* dst = (cv == 0 ? zT : yhyT) + ((size_t)(b * 512 + c)) * LT;
#pragma unroll
    for (int mt = 0; mt < 4; ++mt)
#pragma unroll
      for (int nt = 0; nt < 4; ++nt) {
        int t = 64 * (64 * hw + 16 * nt + r16) + 16 * mt + 4 * g;
        U2 q = *(const U2*)(xr + t);
        float u[6];
        u[0] = t > 0 ? bf2f(xr[t - 1]) : 0.f;
        u[5] = t + 4 < SEQL ? bf2f(xr[t + 4]) : 0.f;
        u[1] = __uint_as_float(q.x << 16); u[2] = __uint_as_float(q.x & 0xffff0000u);
        u[3] = __uint_as_float(q.y << 16); u[4] = __uint_as_float(q.y & 0xffff0000u);
        float o[4];
#pragma unroll
        for (int r = 0; r < 4; ++r) o[r] = (w0 * u[r] + w1 * u[r + 1] + w2 * u[r + 2]) * acc[mt][nt][r];
        *(U2*)(dst + t) = mk2(pack2(o[0], o[1]), pack2(o[2], o[3]));
      }
  }
}

DI void toep_ctx_item(const Params& p, char* smem, int cv, int c) {
  const int tid = tidx();
  float* Tf = (float*)smem;
  float* zf = Tf + 512;
  const u16* uhyT = (const u16*)(wsp(p) + O_UHYT);
  u16* zT = (u16*)(wsp(p) + O_ZT);
  u16* yhyT = (u16*)(wsp(p) + O_YHYT);
  const u16* Tg = (const u16*)(wsp(p) + O_TCTX) + (size_t)(cv * 512 + c) * 512;
  Tf[256 - tid] = bf2f(Tg[tid]);
  if (tid > 0) Tf[256 + tid] = bf2f(Tg[256 + tid]);
  if (tid == 0) Tf[0] = 0.f;
  for (int b = 0; b < 4; ++b) {
    float zv;
    if (cv == 0) {
      const u16* src = uhyT + ((size_t)(b * 1536 + 1024 + c)) * LT + SEQL;
      float w0 = p.hy_conv_w[1024 + c], w1 = p.hy_conv_w[1536 + 1024 + c], w2 = p.hy_conv_w[2 * 1536 + 1024 + c];
      float um = tid > 0 ? bf2f(src[tid - 1]) : 0.f, u0 = bf2f(src[tid]), up = tid < 255 ? bf2f(src[tid + 1]) : 0.f;
      zv = bf2f(f2bf(w0 * um + w1 * u0 + w2 * up));
    } else {
      zv = bf2f(zT[((size_t)(b * 512 + c)) * LT + SEQL + tid]);
    }
    zf[b * 256 + tid] = zv;
  }
  __syncthreads();
  int choff = (cv == 0) ? 0 : 512;
  float w0 = p.hy_conv_w[choff + c], w1 = p.hy_conv_w[1536 + choff + c], w2 = p.hy_conv_w[2 * 1536 + choff + c];
  for (int b = 0; b < 4; ++b) {
    float y = 0.f;
    for (int s = 0; s < 256; ++s) y += Tf[256 - (tid - s)] * zf[b * 256 + s];
    const u16* xr = uhyT + ((size_t)(b * 1536 + choff + c)) * LT + SEQL;
    float um = tid > 0 ? bf2f(xr[tid - 1]) : 0.f, u0 = bf2f(xr[tid]), up = tid < 255 ? bf2f(xr[tid + 1]) : 0.f;
    float o = (w0 * um + w1 * u0 + w2 * up) * y;
    u16* dst = (cv == 0 ? zT : yhyT) + ((size_t)(b * 512 + c)) * LT + SEQL;
    dst[tid] = f2bf(o);
  }
}

DI void natten_wave(const Params& p, u16* Pw, int b, int h, bool lat, int r, int j, int qt) {
  const int lane = tidx() & 63, r16 = lane & 15, g = lane >> 4;
  const u16* uqk = (const u16*)(wsp(p) + O_UQK);
  const u16* vT = (const u16*)(wsp(p) + O_VT0);
  u16* yna = (u16*)(wsp(p) + O_YNA);
  const int qm0 = lat ? b * 8192 + r * 64 + 16 * j : NLAT + b * 256 + 16 * qt;
  bf16x8 qa[2];
#pragma unroll
  for (int ks = 0; ks < 2; ++ks) qa[ks] = *(const bf16x8*)(uqk + (size_t)(qm0 + r16) * 1024 + h * 64 + 32 * ks + 8 * g);
  int rs = r - 4; rs = rs < 0 ? 0 : (rs > 120 ? 120 : rs);
  int kb = 16 * j - 8; kb = kb < 0 ? 0 : (kb > 32 ? 32 : kb);
  f32x4 S[32];
  const float NEG = -1e30f;
  const float* rpb = p.na_rpb + h * 15 * 31;
#pragma unroll
  for (int nt = 0; nt < 32; ++nt) {
    if (nt < 16 && !lat) { S[nt] = f32x4{NEG, NEG, NEG, NEG}; continue; }
    if ((nt & 7) == 0) __builtin_amdgcn_sched_barrier(0);
    int keytok;
    if (nt < 16) keytok = b * 8192 + (rs + (nt >> 1)) * 64 + kb + 16 * (nt & 1) + r16;
    else keytok = NLAT + b * 256 + 16 * (nt - 16) + r16;
    const u16* kp = uqk + (size_t)keytok * 1024 + 512 + h * 64 + 8 * g;
    f32x4 a = f32x4{0.f, 0.f, 0.f, 0.f};
    a = mfma16(qa[0], *(const bf16x8*)(kp), a);
    a = mfma16(qa[1], *(const bf16x8*)(kp + 32), a);
    if (nt < 16) {
      int rr = nt >> 1, kcol = kb + 16 * (nt & 1) + r16, dr = rs + rr - r + 7;
#pragma unroll
      for (int q = 0; q < 4; ++q) {
        int qcol = 16 * j + 4 * g + q;
        int cs = qcol - 8; cs = cs < 0 ? 0 : (cs > 48 ? 48 : cs);
        bool valid = (kcol >= cs) && (kcol < cs + 16);
        int dc = kcol - qcol + 15; dc = dc < 0 ? 0 : (dc > 30 ? 30 : dc);
        float bias = rpb[dr * 31 + dc];
        a[q] = valid ? (a[q] * 0.125f + bias) * LOG2E : NEG;
      }
    } else {
#pragma unroll
      for (int q = 0; q < 4; ++q) a[q] = a[q] * (0.125f * LOG2E);
    }
    S[nt] = a;
  }
  float mx[4], sm[4];
#pragma unroll
  for (int q = 0; q < 4; ++q) {
    float m = NEG;
#pragma unroll
    for (int nt = 0; nt < 32; ++nt) m = fmaxf(m, S[nt][q]);
    m = fmaxf(m, __shfl_xor(m, 1)); m = fmaxf(m, __shfl_xor(m, 2)); m = fmaxf(m, __shfl_xor(m, 4)); m = fmaxf(m, __shfl_xor(m, 8));
    mx[q] = m; sm[q] = 0.f;
  }
#pragma unroll
  for (int nt = 0; nt < 32; ++nt) {
    if (nt < 16 && !lat) continue;
#pragma unroll
    for (int q = 0; q < 4; ++q) {
      float pv = __builtin_amdgcn_exp2f(S[nt][q] - mx[q]);
      u16 pb = f2bf(pv);
      sm[q] += bf2f(pb);
      Pw[(4 * g + q) * 520 + 16 * nt + r16] = pb;
    }
  }
#pragma unroll
  for (int q = 0; q < 4; ++q) {
    float s = sm[q];
    s += __shfl_xor(s, 1); s += __shfl_xor(s, 2); s += __shfl_xor(s, 4); s += __shfl_xor(s, 8);
    sm[q] = 1.f / s;
  }
  __syncthreads();
  f32x4 O[4];
#pragma unroll
  for (int nt = 0; nt < 4; ++nt) O[nt] = f32x4{0.f, 0.f, 0.f, 0.f};
#pragma unroll
  for (int ks = 0; ks < 16; ++ks) {
    if (ks < 8 && !lat) continue;
    bf16x8 pa = *(const bf16x8*)(Pw + r16 * 520 + 32 * ks + 8 * g);
    size_t vcol = ks < 8 ? (size_t)(rs + ks) * 64 + kb + 8 * g : (size_t)SEQL + 32 * (ks - 8) + 8 * g;
#pragma unroll
    for (int nt = 0; nt < 4; ++nt) {
      bf16x8 vb = *(const bf16x8*)(vT + ((size_t)(b * 512 + h * 64 + 16 * nt + r16)) * LT + vcol);
      O[nt] = mfma16(pa, vb, O[nt]);
    }
  }
#pragma unroll
  for (int nt = 0; nt < 4; ++nt)
#pragma unroll
    for (int q = 0; q < 4; ++q) yna[(size_t)(qm0 + 4 * g + q) * 512 + h * 64 + 16 * nt + r16] = f2bf(O[nt][q] * sm[q]);
}

constexpr int SK_ROW = 104, SV_ROW = 68;
constexpr int MLA_STAGE = 64 * SK_ROW + 96 * SV_ROW;
DI void mla_part1(const u16* sK, const bf16x8 (&qf)[6], f32x16 (&O)[3], float& mrun, float& lrun, bf16x8 (&pf)[4], int c32, int h2) {
  f32x16 S[2];
#pragma unroll
  for (int mt = 0; mt < 2; ++mt) {
    f32x16 a;
#pragma unroll
    for (int i = 0; i < 16; ++i) a[i] = 0.f;
#pragma unroll
    for (int ks = 0; ks < 6; ++ks) {
      bf16x8 kf = *(const bf16x8*)(sK + (32 * mt + c32) * SK_ROW + 16 * ks + 8 * h2);
      a = mfma32(kf, qf[ks], a);
    }
    S[mt] = a;
  }
  float mx = -1e30f;
#pragma unroll
  for (int mt = 0; mt < 2; ++mt)
#pragma unroll
    for (int i = 0; i < 16; ++i) mx = fmaxf(mx, S[mt][i]);
  mx = fmaxf(mx, __shfl_xor(mx, 32));
  float mnew = fmaxf(mrun, mx);
  float alpha = __builtin_amdgcn_exp2f(mrun - mnew);
  mrun = mnew;
  f32x2 ps2 = f32x2{0.f, 0.f};
  f32x16 Sd[2];
  Sd[0] = S[0] - mnew; Sd[1] = S[1] - mnew;
#pragma unroll
  for (int mt = 0; mt < 2; ++mt)
#pragma unroll
    for (int s = 0; s < 2; ++s) {
      float e[8];
#pragma unroll
      for (int jj = 0; jj < 8; ++jj) e[jj] = __builtin_amdgcn_exp2f(Sd[mt][8 * s + jj]);
      ps2 += f32x2{e[0], e[1]}; ps2 += f32x2{e[2], e[3]}; ps2 += f32x2{e[4], e[5]}; ps2 += f32x2{e[6], e[7]};
      U4 q = mk4(pack2(e[0], e[1]), pack2(e[2], e[3]), pack2(e[4], e[5]), pack2(e[6], e[7]));
      pf[mt * 2 + s] = __builtin_bit_cast(bf16x8, q);
    }
  lrun = lrun * alpha + (ps2[0] + ps2[1]);
  if (__any(alpha != 1.f)) {
#pragma unroll
    for (int d = 0; d < 3; ++d)
#pragma unroll
      for (int i = 0; i < 16; ++i) O[d][i] *= alpha;
  }
}
DI void mla_part2(const u16* sV, const bf16x8 (&pf)[4], f32x16 (&O)[3], int c32, int h2) {
#pragma unroll
  for (int kk = 0; kk < 4; ++kk) {
    int keybase = 16 * kk + 4 * h2;
#pragma unroll
    for (int d = 0; d < 3; ++d) {
      const u16* vp = sV + (32 * d + c32) * SV_ROW + keybase;
      U2 lo = *(const U2*)(vp), hi = *(const U2*)(vp + 8);
      U4 q = mk4(lo.x, lo.y, hi.x, hi.y);
      O[d] = mfma32(__builtin_bit_cast(bf16x8, q), pf[kk], O[d]);
    }
  }
}

DI void mla_item512(const Params& p, char* smem_all, int b, int h, int qb) {
  const int tid = tid512(), lane = tid & 63, w = tid >> 6, c32 = lane & 31, h2 = lane >> 5;
  const u16* Q = (const u16*)(wsp(p) + O_Q);
  const u16* KNg = (const u16*)(wsp(p) + O_KB) + (size_t)(b * 8 + h) * LT * 64;
  const u16* KPg = (const u16*)(wsp(p) + O_KP) + (size_t)b * LT * 32;
  const u16* Vg = (const u16*)(wsp(p) + O_VT1) + (size_t)(b * 8 + h) * 96 * LT;
  u16* Y1 = (u16*)(wsp(p) + O_Y1);
  u16* sb = (u16*)smem_all;
  const int qrow = b * 8192 + qb * 256 + w * 32 + c32;
  bf16x8 qf[6];
#pragma unroll
  for (int ks = 0; ks < 6; ++ks) qf[ks] = *(const bf16x8*)(Q + (size_t)qrow * 768 + h * 96 + 16 * ks + 8 * h2);
  f32x16 O[3];
#pragma unroll
  for (int d = 0; d < 3; ++d)
#pragma unroll
    for (int i = 0; i < 16; ++i) O[d][i] = 0.f;
  float mrun = -1e30f, lrun = 0.f;
  const int kkey = tid / 12, kkc = tid % 12;
  const u16* kp0 = kkc < 8 ? KNg + kkey * 64 + kkc * 8 : KPg + kkey * 32 + (kkc - 8) * 8;
  const int kstep0 = kkc < 8 ? 64 * 64 : 64 * 32;
  const int kdst = kkey * SK_ROW + kkc * 8;
  const u16* vp0 = Vg + (size_t)(tid >> 3) * LT + (tid & 7) * 8;
  const int vdst = 64 * SK_ROW + (tid >> 3) * SV_ROW + (tid & 7) * 8;
  const bool xk = tid < 256;
  const int xc = xk ? 512 + tid : tid + 256;
  const int xkey = xc / 12, xkc = xc % 12;
  const u16* xp0 = xk ? (xkc < 8 ? KNg + xkey * 64 + xkc * 8 : KPg + xkey * 32 + (xkc - 8) * 8) : Vg + (size_t)(xc >> 3) * LT + (xc & 7) * 8;
  const int xstep = xk ? (xkc < 8 ? 64 * 64 : 64 * 32) : 64;
  const int xdst = xk ? (xc / 12) * SK_ROW + (xc % 12) * 8 : 64 * SK_ROW + (xc >> 3) * SV_ROW + (xc & 7) * 8;
  U4 ka, va, xa, kb2, vb2, xb2;
#define MLA5_FETCH(K_, V_, X_, kt_) { K_ = *(const U4*)(kp0 + (size_t)(kt_) * kstep0); V_ = *(const U4*)(vp0 + (kt_) * 64); X_ = *(const U4*)(xp0 + (size_t)(kt_) * xstep); }
#define MLA5_COMMIT(K_, V_, X_, st_) { *(U4*)((st_) + kdst) = K_; *(U2*)((st_) + vdst) = mk2(V_.x, V_.y); *(U2*)((st_) + vdst + 4) = mk2(V_.z, V_.w); *(U2*)((st_) + xdst) = mk2(X_.x, X_.y); *(U2*)((st_) + xdst + 4) = mk2(X_.z, X_.w); }
  constexpr int NKT = LT / 64;
  const int grp = w >> 2;
  u16* sc = sb; u16* sn = sb + MLA_STAGE; u16* sp = sb + 2 * MLA_STAGE;
  bf16x8 pf[4];
  MLA5_FETCH(ka, va, xa, 0);
  MLA5_FETCH(kb2, vb2, xb2, 1);
  __syncthreads();
  MLA5_COMMIT(ka, va, xa, sc);
  __syncthreads();
  for (int kt = 0; kt < NKT; kt += 2) {
    { int k2 = kt + 2 < NKT ? kt + 2 : NKT - 2; MLA5_FETCH(ka, va, xa, k2); }
    __builtin_amdgcn_sched_barrier(0);
    if (grp == 0) { mla_part1(sc, qf, O, mrun, lrun, pf, c32, h2); mla_part2(sc + 64 * SK_ROW, pf, O, c32, h2); }
    else { if (kt > 0) mla_part2(sp + 64 * SK_ROW, pf, O, c32, h2); mla_part1(sc, qf, O, mrun, lrun, pf, c32, h2); }
    MLA5_COMMIT(kb2, vb2, xb2, sn);
    __syncthreads();
    { u16* t_ = sp; sp = sc; sc = sn; sn = t_; }
    { int k3 = kt + 3 < NKT ? kt + 3 : NKT - 1; MLA5_FETCH(kb2, vb2, xb2, k3); }
    __builtin_amdgcn_sched_barrier(0);
    if (grp == 0) { mla_part1(sc, qf, O, mrun, lrun, pf, c32, h2); mla_part2(sc + 64 * SK_ROW, pf, O, c32, h2); }
    else { mla_part2(sp + 64 * SK_ROW, pf, O, c32, h2); mla_part1(sc, qf, O, mrun, lrun, pf, c32, h2); }
    MLA5_COMMIT(ka, va, xa, sn);
    __syncthreads();
    { u16* t_ = sp; sp = sc; sc = sn; sn = t_; }
  }
  if (grp == 1) mla_part2(sp + 64 * SK_ROW, pf, O, c32, h2);
#undef MLA5_FETCH
#undef MLA5_COMMIT
  float l = lrun + __shfl_xor(lrun, 32);
  float inv = 1.f / l;
#pragma unroll
  for (int d = 0; d < 3; ++d)
#pragma unroll
    for (int i4 = 0; i4 < 4; ++i4) {
      int dd = 32 * d + 8 * i4 + 4 * h2;
      U2 o = mk2(pack2(O[d][4 * i4] * inv, O[d][4 * i4 + 1] * inv), pack2(O[d][4 * i4 + 2] * inv, O[d][4 * i4 + 3] * inv));
      *(U2*)(Y1 + (size_t)qrow * 1024 + h * 96 + dd) = o;
    }
}

DI void kpe_item(const Params& p, int it) {
  const int tid = tidx();
  const u16* u1 = (const u16*)(wsp(p) + O_U1);
  u16* kp = (u16*)(wsp(p) + O_KP);
#pragma unroll
  for (int ps = 0; ps < 8; ++ps) {
    int m = it * 64 + ps * 8 + (tid >> 5), i = tid & 31;
    float v = bf2f(u1[(size_t)m * 1024 + 640 + i]);
    float pr = bf2f(u1[(size_t)m * 1024 + 640 + (i ^ 8)]);
    int b, s; bs_of(m, b, s);
    float o = v;
    if (m < NLAT) {
      int axis = i >> 4, second = (i >> 3) & 1, idx = i & 7;
      float inv = exp2f(-(float)idx * (13.287712379549449f / 8.f));
      float pos = (float)(axis ? (s & 63) : (s >> 6));
      float rv = pos * inv * 0.15915494309189535f; float sn = __builtin_amdgcn_sinf(rv), cs = __builtin_amdgcn_cosf(rv);
      o = second ? (v * cs + pr * sn) : (v * cs - pr * sn);
    }
    kp[((size_t)b * LT + s) * 32 + i] = f2bf(o);
  }
}

DI void fnet1_item(const Params& p, char* smem, int it) {
  const int tid = tidx(), lane = tid & 63, w = tid >> 6, r16 = lane & 15, g4 = lane >> 4;
  constexpr int XROW = 264, TROW = 72;
  u16* xb = (u16*)smem;
  u16* tt = xb + 64 * XROW;
  const u16* u1 = (const u16*)(wsp(p) + O_U1);
  u16* XT = (u16*)(wsp(p) + O_XT);
  const int m0 = it * 64;
  for (int e = tid; e < 64 * 32; e += 256) {
    int tok = e >> 5, c8 = e & 31;
    *(U4*)(xb + tok * XROW + c8 * 8) = *(const U4*)(u1 + (size_t)(m0 + tok) * 1024 + 672 + c8 * 8);
  }
  for (int e = tid; e < 128 * 64; e += 256) {
    int n = e >> 6, j = e & 63;
    float rv = (float)((n * j) & 63) * (1.f / 64.f);
    float v = (n < 64) ? __builtin_amdgcn_cosf(rv) : __builtin_amdgcn_sinf(rv);
    tt[n * TROW + j] = f2bf(v);
  }
  __syncthreads();
  {
    const int tok = tid & 63, gq = tid >> 6;
    u16* xp = xb + tok * XROW + gq * 64;
    float xr[64];
#pragma unroll
    for (int c = 0; c < 8; ++c) {
      U4 q = *(const U4*)(xp + c * 8);
      u32 ww[4] = {q.x, q.y, q.z, q.w};
#pragma unroll
      for (int k = 0; k < 4; ++k) { xr[c * 8 + 2 * k] = __uint_as_float(ww[k] << 16); xr[c * 8 + 2 * k + 1] = __uint_as_float(ww[k] & 0xffff0000u); }
    }
    float sm = 0.f;
#pragma unroll
    for (int jj = 0; jj < 64; ++jj) sm += xr[jj];
    float mu = sm * (1.f / 64.f), q2 = 0.f;
#pragma unroll
    for (int jj = 0; jj < 64; ++jj) { float d = xr[jj] - mu; q2 += d * d; }
    float rstd = rsqrtf(q2 * (1.f / 64.f) + LN_EPS);
#pragma unroll
    for (int c = 0; c < 8; ++c) {
      float o[8];
#pragma unroll
      for (int k = 0; k < 8; ++k) o[k] = (xr[c * 8 + k] - mu) * rstd * p.fn_g[gq * 64 + c * 8 + k] + p.fn_b[gq * 64 + c * 8 + k];
      *(U4*)(xp + c * 8) = mk4(pack2(o[0], o[1]), pack2(o[2], o[3]), pack2(o[4], o[5]), pack2(o[6], o[7]));
    }
  }
  __syncthreads();
  bf16x8 af[4][2];
#pragma unroll
  for (int mt = 0; mt < 4; ++mt)
#pragma unroll
    for (int ks = 0; ks < 2; ++ks) af[mt][ks] = *(const bf16x8*)(xb + (16 * mt + r16) * XROW + w * 64 + 32 * ks + 8 * g4);
  const int b = m0 >> 13, t0 = (m0 & 8191);
#pragma unroll 2
  for (int nt = 0; nt < 8; ++nt) {
    bf16x8 b0 = *(const bf16x8*)(tt + (16 * nt + r16) * TROW + 8 * g4);
    bf16x8 b1 = *(const bf16x8*)(tt + (16 * nt + r16) * TROW + 32 + 8 * g4);
    int n = 16 * nt + r16;
    size_t row = (size_t)(b * 256 + w * 64 + (n & 63)) * 16384 + (n >= 64 ? 8192 : 0) + t0;
#pragma unroll
    for (int mt = 0; mt < 4; ++mt) {
      f32x4 acc = f32x4{0.f, 0.f, 0.f, 0.f};
      acc = mfma16(af[mt][0], b0, acc);
      acc = mfma16(af[mt][1], b1, acc);
      *(U2*)(XT + row + 16 * mt + 4 * g4) = mk2(pack2g(acc[0], acc[1]), pack2g(acc[2], acc[3]));
    }
  }
}

DI void gbar(unsigned* ctr, unsigned& target, unsigned nblk) {
  asm volatile("s_waitcnt vmcnt(0)" ::: "memory");
  __syncthreads();
  target += nblk;
  if (__builtin_amdgcn_workitem_id_x() == 0) {
    __builtin_amdgcn_s_waitcnt(0);
    __builtin_amdgcn_fence(__ATOMIC_RELEASE, "agent");
    asm volatile("s_waitcnt vmcnt(0)" ::: "memory");
    __hip_atomic_fetch_add(ctr, 1u, __ATOMIC_RELAXED, __HIP_MEMORY_SCOPE_AGENT);
    while (__hip_atomic_load(ctr, __ATOMIC_RELAXED, __HIP_MEMORY_SCOPE_AGENT) < target) __builtin_amdgcn_s_sleep(1);
    __builtin_amdgcn_fence(__ATOMIC_ACQUIRE, "agent");
    asm volatile("s_waitcnt vmcnt(0)" ::: "memory");
  }
  __syncthreads();
}

#define USE_PG8_WIN 3
#define USE_PG8_L1IN 1
#define USE_PG8_L1OUT 1
#define USE_PG8_MLP1 1
#define USE_PG8_MLP2 1
#ifndef REP_MLA
#define REP_MLA 1
#endif
#ifndef REP_TOEP
#define REP_TOEP 1
#endif
#ifndef REP_MLP1
#define REP_MLP1 1
#endif
#ifndef REP_NAT
#define REP_NAT 1
#endif
#ifndef REP_FNG
#define REP_FNG 1
#endif
#ifndef REP_WIN
#define REP_WIN 1
#endif

__global__ void __launch_bounds__(512, 2) mega(Params p) {
  cg::grid_group grid = cg::this_grid();
  __shared__ __attribute__((aligned(16))) char smem_all[2 * SMEM_BYTES];
  char* smem = smem_all + halfx() * SMEM_BYTES;
  char* ws = wsp(p);
  const int nblk = NVB, bid = bidx();
  const int rnblk = gridDim.x, rbid = rbidx();
  float* S = (float*)(ws + O_S);
  u16* hbuf = (u16*)(ws + O_HBUF);
  unsigned* barp = (unsigned*)(ws + O_BAR);
  unsigned bar_target = 0;
#define SYNC() gbar(barp, bar_target, (unsigned)rnblk)

  phase_prep(p, smem);
  grid.sync();
  phase_ln<true, false, true>(p, R, nullptr, nullptr, nullptr, false, 0, 0, 1024);
  SYNC();

#pragma unroll
  for (int l = 0; l < 2; ++l) {
    const int rows = (l == 0) ? R : NLAT;
    const float* mod = modp(p, l, 0);
    if (l == 0) {
      {
        EpWin0 ep; ep.uhyT = (u16*)(ws + O_UHYT); ep.uqk = (u16*)(ws + O_UQK); ep.vT = (u16*)(ws + O_VT0);
        const u16* W = (const u16*)(ws + O_WT_ABIN);
#if USE_PG8_WIN == 3
        {
          LoadRowB al; al.A = hbuf; al.lda = 1024;
          for (int t = rbid; t < 128 * 8; t += rnblk) {
            int nt = t % 8; nt = nt < 6 ? nt : nt + 4;
            gemm_big<false>(al, W, 1024, 1024, (t / 8) * 256, nt * 256, ep, smem_all);
          }
        }
        asm volatile("s_waitcnt vmcnt(0) lgkmcnt(0)" ::: "memory");
        { EpPlain epq; epq.dst = (u16*)(ws + O_UQK); epq.ld = 1024;
          run_phase_p<EpPlain>(smem_all, hbuf, W + (size_t)1536 * 1024, NLAT, 1024, 1024, epq); }
#else
        {
          LoadRowB al; al.A = hbuf; al.lda = 1024;
          for (int t = rbid; t < 128 * 12; t += rnblk) {
            int nt = t % 12;
            if (nt >= 6 && nt < 10) gemm_big<true>(al, W, 1024, 1024, (t / 12) * 256, nt * 256, ep, smem_all);
            else gemm_big<false>(al, W, 1024, 1024, (t / 12) * 256, nt * 256, ep, smem_all);
          }
        }
#endif
        {
          ALoadRow al; al.A = hbuf; al.lda = 1024;
          for (int t = bid; t < 8 * 24; t += nblk) {
            int nt = t % 24;
            if (nt >= 12 && nt < 20) gemm_tile<true>(al, W, 1024, 1024, NLAT + (t / 24) * 128, nt * 128, ep, smem);
            else gemm_tile<false>(al, W, 1024, 1024, NLAT + (t / 24) * 128, nt * 128, ep, smem);
          }
        }
      }
      SYNC();
      {
        const int n_toep = 1024, n_na = 4096, n_nac = 128, n_tc = 512;
        for (int it = bid; it < n_toep + n_na + n_nac + n_tc; it += nblk) {
          __syncthreads();
          int t = it;
          if (t < n_toep) { toep_item(p, smem, 0, t >> 1, t & 1); continue; }
          t -= n_toep;
          u16* Pw = (u16*)smem + (tidx() >> 6) * (16 * 520);
          if (t < n_na) { int b = t >> 10, r = (t >> 3) & 127, h = t & 7; natten_wave(p, Pw, b, h, true, r, tidx() >> 6, 0); continue; }
          t -= n_na;
          if (t < n_nac) { int b = t >> 5, h = (t >> 2) & 7, q4 = t & 3; natten_wave(p, Pw, b, h, false, 0, 0, q4 * 4 + (tidx() >> 6)); continue; }
          t -= n_nac;
          toep_ctx_item(p, smem, 0, t);
        }
      }
      SYNC();
      {
        for (int it = bid; it < 1024 + 512; it += nblk) {
          __syncthreads();
          if (it < 1024) toep_item(p, smem, 1, it >> 1, it & 1);
          else toep_ctx_item(p, smem, 1, it - 1024);
        }
      }
      SYNC();
      {
        EpResid ep; ep.xlat = p.x; ep.xctx = p.ctx; ep.S = S; ep.mod = mod; ep.goff = 2048;
        const u16* W = (const u16*)(ws + O_WT_ABOUT);
        {
          ALoadMixB al; al.YT = (const u16*)(ws + O_YHYT); al.YN = (const u16*)(ws + O_YNA);
          for (int t = rbid; t < 128 * 4; t += rnblk) gemm_big<true>(al, W, 1024, 1024, (t / 4) * 256, (t % 4) * 256, ep, smem_all);
        }
        {
          ALoadMix al; al.YT = (const u16*)(ws + O_YHYT); al.YN = (const u16*)(ws + O_YNA);
          for (int t = bid; t < 8 * 8; t += nblk) gemm_tile<true>(al, W, 1024, 1024, NLAT + (t / 8) * 128, (t % 8) * 128, ep, smem);
        }
      }
      SYNC();
    } else {
      {
        EpPlain ep; ep.dst = (u16*)(ws + O_U1); ep.ld = 1024;
        const u16* W = (const u16*)(ws + O_WT_CDIN);
#if USE_PG8_L1IN
        run_phase_p<EpPlain>(smem_all, hbuf, W, NLAT, 1024, 1024, ep);
#else
        {
          LoadRowB al; al.A = hbuf; al.lda = 1024;
          for (int t = rbid; t < 128 * 4; t += rnblk) gemm_big<true>(al, W, 1024, 1024, (t / 4) * 256, (t % 4) * 256, ep, smem_all);
        }
#endif
        {
          ALoadRow al; al.A = hbuf; al.lda = 1024;
          for (int t = bid; t < 8 * 8; t += nblk) gemm_tile<true>(al, W, 1024, 1024, NLAT + (t / 8) * 128, (t % 8) * 128, ep, smem);
        }
      }
      SYNC();
      {
        const int n_q = (NLAT / 128) * 6, n_kv = (R / 128) * 10, n_kpe = R / 64, n_f1 = NLAT / 64;
        float* srow = (float*)(smem + 73728);
        const u16* u1 = (const u16*)(ws + O_U1);
        for (int it = bid; it < n_q + n_kv + n_kpe + n_f1; it += nblk) {
          __syncthreads();
          int t = it;
          if (t < n_q) {
            int m0 = (t / 6) * 128, n0 = (t % 6) * 128;
            rms_rows(u1, 1024, 384, m0, srow);
            ALoadRow al; al.A = u1; al.lda = 1024;
            EpQ ep; ep.q = (u16*)(ws + O_Q); ep.srow = srow; ep.m0 = m0;
            gemm_tile<true>(al, (const u16*)(ws + O_WT_UQ), 384, 384, m0, n0, ep, smem);
            continue;
          }
          t -= n_q;
          if (t < n_kv) {
            int m0 = (t / 10) * 128, n0 = (t % 10) * 128;
            rms_rows(u1 + 384, 1024, 256, m0, srow);
            ALoadRow al; al.A = u1 + 384; al.lda = 1024;
            EpKV ep; ep.kn = (u16*)(ws + O_KB); ep.vT = (u16*)(ws + O_VT1); ep.srow = srow; ep.m0 = m0;
            gemm_tile<false>(al, (const u16*)(ws + O_WT_UKV), 256, 256, m0, n0, ep, smem);
            continue;
          }
          t -= n_kv;
          if (t < n_kpe) { kpe_item(p, t); continue; }
          t -= n_kpe;
          fnet1_item(p, smem, t);
        }
      }
      SYNC();
      {
        for (int it = rbid; it < 512; it += rnblk) {
          int b = it >> 7, hp = (it >> 5) & 3, qb = it & 31;
          __syncthreads();
          mla_item512(p, smem_all, b, 2 * hp, qb);
          __syncthreads();
          mla_item512(p, smem_all, b, 2 * hp + 1, qb);
        }
        for (int t = rbid; t < 256; t += rnblk) {
          __syncthreads();
          const int hf = halfx();
          const int m0 = (t >> 3) * 128, n0 = (t & 7) * 128;
          ALoadDFT al; al.kofs = hf * 8192;
          EpLds ep; ep.buf = (float*)smem; ep.m0 = m0; ep.n0 = n0;
          gemm_tile<true>(al, (const u16*)(ws + O_XT) + hf * 8192, 16384, 8192, m0, n0, ep, smem);
          __syncthreads();
          const float* Pb = (const float*)smem_all;
          const float* Qb = (const float*)(smem_all + SMEM_BYTES);
          u16* y1 = (u16*)(ws + O_Y1);
          const float sc = 0.0013810679320049757f;
          const int tid = tidx(), bb = n0 >> 8, ch0 = n0 & 255;
#pragma unroll 4
          for (int i = 0; i < 16; ++i) {
            int e = tid + 256 * i, row = e >> 5, c4 = (e & 31) * 4;
            F4 pv = *(const F4*)(Pb + row * 132 + c4), qv = *(const F4*)(Qb + row * 132 + c4);
            int k = m0 + row;
            if (hf == 0) {
              *(U2*)(y1 + ((size_t)(bb * 8192 + k)) * 1024 + 768 + ch0 + c4) = mk2(pack2((pv.x + qv.x) * sc, (pv.y + qv.y) * sc), pack2((pv.z + qv.z) * sc, (pv.w + qv.w) * sc));
            } else if (k > 0) {
              *(U2*)(y1 + ((size_t)(bb * 8192 + 8192 - k)) * 1024 + 768 + ch0 + c4) = mk2(pack2((pv.x - qv.x) * sc, (pv.y - qv.y) * sc), pack2((pv.z - qv.z) * sc, (pv.w - qv.w) * sc));
            }
          }
        }
        for (int i = bid; i < 16; i += nblk) {
          const int tid = tidx(), lane = tid & 63, w = tid >> 6;
          const u16* XT = (const u16*)(ws + O_XT);
          u16* y1 = (u16*)(ws + O_Y1);
          float res = 0.f;
          for (int c = 0; c < 16; ++c) {
            int n = i * 64 + w * 16 + c;
            const U4* row = (const U4*)(XT + (size_t)n * 16384);
            float sacc = 0.f;
#pragma unroll 4
            for (int j = 0; j < 16; ++j) {
              U4 q = row[lane + 64 * j];
              u32 ww[4] = {q.x, q.y, q.z, q.w};
#pragma unroll
              for (int k2 = 0; k2 < 4; ++k2) sacc += __uint_as_float(ww[k2] << 16) - __uint_as_float(ww[k2] & 0xffff0000u);
            }
            sacc = wave_sum(sacc);
            if (lane == c) res = sacc;
          }
          if (lane < 16) {
            int n = i * 64 + w * 16 + lane;
            y1[((size_t)((n >> 8) * 8192 + 4096)) * 1024 + 768 + (n & 255)] = f2bf(res * 0.0013810679320049757f);
          }
        }
      }
      SYNC();
      {
        EpResid ep; ep.xlat = S; ep.xctx = S + (size_t)NLAT * 1024; ep.S = S; ep.mod = mod; ep.goff = 2048;
#if USE_PG8_L1OUT
        run_phase<EpResid, false>(smem_all, (const u16*)(ws + O_Y1), (const u16*)(ws + O_WT_CDOUT), NLAT, 1024, 1024, ep, 0, 0);
#else
        {
          LoadRowB al; al.A = (const u16*)(ws + O_Y1); al.lda = 1024;
          for (int t = rbid; t < 128 * 4; t += rnblk) gemm_big<true>(al, (const u16*)(ws + O_WT_CDOUT), 1024, 1024, (t / 4) * 256, (t % 4) * 256, ep, smem_all);
        }
#endif
      }
      SYNC();
    }
    phase_ln<false, true, true>(p, rows, p.ln_g + (size_t)(l * 2 + 0) * 1024, p.ln_b + (size_t)(l * 2 + 0) * 1024, nullptr, true, l, 3072, 4096);
    SYNC();
    {
      EpRelu2 ep; ep.a1 = (u16*)(ws + O_A1);
      const u16* W = (const u16*)(ws + O_WT_W1) + (size_t)l * 4096 * 1024;
#if USE_PG8_MLP1
      run_phase_p<EpRelu2>(smem_all, hbuf, W, NLAT, 4096, 1024, ep);
#else
      {
        LoadRowB al; al.A = hbuf; al.lda = 1024;
        for (int t = rbid; t < 128 * 16; t += rnblk) gemm_big<true>(al, W, 1024, 1024, (t / 16) * 256, (t % 16) * 256, ep, smem_all);
      }
#endif
      if (l == 0) {
        ALoadRow al; al.A = hbuf; al.lda = 1024;
        for (int t = bid; t < 8 * 32; t += nblk) gemm_tile<true>(al, W, 1024, 1024, NLAT + (t / 32) * 128, (t % 32) * 128, ep, smem);
      }
    }
    SYNC();
    {
      EpResid ep; ep.xlat = S; ep.xctx = S + (size_t)NLAT * 1024; ep.S = S; ep.mod = mod; ep.goff = 5120;
      const u16* W = (const u16*)(ws + O_WT_W2) + (size_t)l * 4096 * 1024;
#if USE_PG8_MLP2
      run_phase<EpResid, false>(smem_all, (const u16*)(ws + O_A1), W, NLAT, 1024, 4096, ep, 0, 0);
#else
      {
        LoadRowB al; al.A = (const u16*)(ws + O_A1); al.lda = 4096;
        for (int t = rbid; t < 128 * 4; t += rnblk) gemm_big<true>(al, W, 4096, 4096, (t / 4) * 256, (t % 4) * 256, ep, smem_all);
      }
#endif
      if (l == 0) {
        ALoadRow al; al.A = (const u16*)(ws + O_A1); al.lda = 4096;
        for (int t = bid; t < 8 * 8; t += nblk) gemm_tile<true>(al, W, 4096, 4096, NLAT + (t / 8) * 128, (t % 8) * 128, ep, smem);
      }
    }
    SYNC();
    if (l == 0) phase_ln<false, true, true>(p, R, p.ln_g + 1024, p.ln_b + 1024, nullptr, true, 1, 0, 1024);
    else phase_ln<false, true, false>(p, NLAT, p.ln_g + 3 * 1024, p.ln_b + 3 * 1024, p.out, false, 0, 0, 0);
    if (l == 0) SYNC();
  }
}

extern "C" void kernel_launch(void* const* d_in, const int* in_sizes, int n_in, void* d_out, int out_size, void* d_ws,
                              size_t ws_size, hipStream_t stream) {
  static int grid_blocks = 0;
  if (!grid_blocks) {
    int dev = 0, cus = 0, per_cu = 0;
    hipGetDevice(&dev);
    hipDeviceGetAttribute(&cus, hipDeviceAttributeMultiprocessorCount, dev);
    hipOccupancyMaxActiveBlocksPerMultiprocessor(&per_cu, mega, 512, 0);
    if (per_cu > 1) per_cu = 1;
    if (per_cu < 1) per_cu = 1;
    grid_blocks = cus * per_cu;
  }
  Params p{};
  const float** f = (const float**)&p;
  for (int i = 0; i < 30; ++i) f[i] = (const float*)d_in[i];
  p.out = (float*)d_out;
  p.ws = (char*)d_ws;
  hipMemsetAsync((char*)d_ws + O_BAR, 0, 256, stream);
  void* args[] = {&p};
  hipError_t e = hipLaunchCooperativeKernel((void*)mega, dim3(grid_blocks), dim3(512), args, 0, stream);
  if (e != hipSuccess) fprintf(stderr, "cooperative launch failed: %s (grid %d)\n", hipGetErrorString(e), grid_blocks);
}
```
